# Optimizing an MI355X kernel written in HIP

```python
import math, functools
import jax, jax.numpy as jnp
from jax import lax
import numpy as np

D_MODEL = 1024
BATCH = 1
SEQ = 16384
DEPTH = 4
DEC_BATCH = 32
DEC_SEQ = 32
PAST_LEN = 1024

CHUNK = 64
N_HEADS = 4
HEAD_DIM = 64
ATTN_WIDTH = N_HEADS * 2 * HEAD_DIM
GMLP_CHUNK = 128
GMLP_GROUPS = 4
GMLP_WIDTH = 512
GMLP_GROUP_DIM = GMLP_WIDTH // GMLP_GROUPS
ROPE_THETA = 10000.0
Q_BLOCK = 128
ALPHA = (2 * DEPTH) ** 0.25
BETA = (8 * DEPTH) ** -0.25
LN_EPS = 1e-5
SCALE = HEAD_DIM ** -0.5
IN_WIDTH = 4 * ATTN_WIDTH + 3 * GMLP_WIDTH + 2 * D_MODEL
SPLITS = (ATTN_WIDTH, 2 * ATTN_WIDTH, 3 * ATTN_WIDTH, 4 * ATTN_WIDTH,
          4 * ATTN_WIDTH + GMLP_WIDTH, 4 * ATTN_WIDTH + 2 * GMLP_WIDTH,
          4 * ATTN_WIDTH + 3 * GMLP_WIDTH, 4 * ATTN_WIDTH + 3 * GMLP_WIDTH + D_MODEL)

kernel_name = "diffattn_gmlp_gated_streaming_encoder"


def layernorm(x, g, b):
    xf = x.astype(jnp.float32)
    mu = jnp.mean(xf, -1, keepdims=True)
    var = jnp.mean(jnp.square(xf - mu), -1, keepdims=True)
    return ((xf - mu) * lax.rsqrt(var + LN_EPS) * g.astype(jnp.float32) + b.astype(jnp.float32)).astype(x.dtype)


def rmsnorm(x, g):
    xf = x.astype(jnp.float32)
    return (xf * lax.rsqrt(jnp.mean(jnp.square(xf), -1, keepdims=True) + LN_EPS) * g.astype(jnp.float32)).astype(x.dtype)


def rope(x, pos):
    half = HEAD_DIM // 2
    inv = ROPE_THETA ** (-jnp.arange(half, dtype=jnp.float32) / half)
    ang = pos.astype(jnp.float32)[:, None] * inv[None, :]
    cos = jnp.cos(ang)[None, :, None, :]
    sin = jnp.sin(ang)[None, :, None, :]
    x1 = x[..., :half].astype(jnp.float32)
    x2 = x[..., half:].astype(jnp.float32)
    return jnp.concatenate([x1 * cos - x2 * sin, x2 * cos + x1 * sin], -1).astype(x.dtype)


def diff_combine(s, lam, v):
    n, _, q, l = s.shape
    p = jax.nn.softmax(s, axis=-1).reshape(n, N_HEADS, 2, q, l)
    a = p[:, :, 0] - lam * p[:, :, 1]
    return jnp.einsum("nhqk,nkhe->nqhe", a.astype(v.dtype), v)


def diff_attn_prompt(q, k, v, lam):
    b, s = q.shape[:2]
    nb = s // Q_BLOCK
    qb = q.reshape(b, nb, Q_BLOCK, 2 * N_HEADS, HEAD_DIM).transpose(1, 0, 2, 3, 4)
    k_chunk = jnp.arange(s) // CHUNK

    def block(args):
        qi, i = args
        q_chunk = (i * Q_BLOCK + jnp.arange(Q_BLOCK)) // CHUNK
        mask = k_chunk[None, :] <= q_chunk[:, None]
        sc = jnp.einsum("bqhd,bkhd->bhqk", qi, k).astype(jnp.float32) * SCALE
        sc = jnp.where(mask[None, None], sc, -jnp.inf)
        return diff_combine(sc, lam, v)

    out = lax.map(block, (qb, jnp.arange(nb)))
    return out.transpose(1, 0, 2, 3, 4).reshape(b, s, N_HEADS, 2 * HEAD_DIM)


def diff_attn_sample(q, k, v, lam, ck, cv):
    kk = jnp.concatenate([ck.astype(k.dtype), k], axis=1)
    vv = jnp.concatenate([cv.astype(v.dtype), v], axis=1)
    sc = jnp.einsum("nqhd,nkhd->nhqk", q, kk).astype(jnp.float32) * SCALE
    return diff_combine(sc, lam, vv)


def sgu_prompt(vn, ws, bs):
    b, s, _ = vn.shape
    vc = vn.reshape(b, s // GMLP_CHUNK, GMLP_CHUNK, GMLP_GROUPS, GMLP_GROUP_DIM)
    out = jnp.einsum("gij,bcjgd->bcigd", ws.astype(vn.dtype), vc) + bs.T.astype(vn.dtype)[None, None, :, :, None]
    return out.reshape(b, s, GMLP_WIDTH)


def sgu_sample(vn, ws, bs):
    n, t, _ = vn.shape
    vc = vn.reshape(n, t, GMLP_GROUPS, GMLP_GROUP_DIM)
    out = jnp.einsum("gij,njgd->nigd", ws[:, :t, :t].astype(vn.dtype), vc) + bs[:, :t].T.astype(vn.dtype)[None, :, :, None]
    return out.reshape(n, t, GMLP_WIDTH)


def mixer_layer(x, pos, w_in, w_oa, w_og, w_out, lq1, lk1, lq2, lk2, subln_w,
                sgu_g, sgu_b, ln_g, ln_b, lam_init, attn_fn, sgu_fn):
    n, t, _ = x.shape
    h = x @ w_in
    q, k, va, ga, u, vg, gg, ma, mb = jnp.split(h, SPLITS, axis=-1)
    q = rope(q.reshape(n, t, 2 * N_HEADS, HEAD_DIM), pos)
    k = rope(k.reshape(n, t, 2 * N_HEADS, HEAD_DIM), pos)
    va = va.reshape(n, t, N_HEADS, 2 * HEAD_DIM)
    lam = (jnp.exp(jnp.sum(lq1.astype(jnp.float32) * lk1.astype(jnp.float32)))
           - jnp.exp(jnp.sum(lq2.astype(jnp.float32) * lk2.astype(jnp.float32))) + lam_init)
    o = attn_fn(q, k, va, lam)
    o = rmsnorm(o, subln_w) * (1.0 - lam_init)
    y_a = (o.reshape(n, t, ATTN_WIDTH) * jax.nn.silu(ga)) @ w_oa
    vn = layernorm(vg, sgu_g, sgu_b)
    y_g = (u * sgu_fn(vn) * jax.nn.silu(gg)) @ w_og
    merged = jax.nn.sigmoid(ma) * y_a + jax.nn.sigmoid(mb) * y_g
    x_new = layernorm(ALPHA * x + merged @ w_out, ln_g, ln_b)
    return x_new, k, va, vn


def setup_inputs(seed: int = 0) -> dict:
    key = jax.random.key(seed)
    ks = jax.random.split(key, 20)
    f32 = jnp.float32
    nrm = lambda k, shape: jax.random.normal(k, shape, dtype=f32)
    col_scale = jnp.ones((IN_WIDTH,), f32).at[2 * ATTN_WIDTH:3 * ATTN_WIDTH].set(BETA)
    return {
        "x_prompt": nrm(ks[0], (BATCH, SEQ, D_MODEL)),
        "x_sample": nrm(ks[1], (DEC_BATCH, DEC_SEQ, D_MODEL)),
        "cache_k": nrm(ks[2], (DEPTH, DEC_BATCH, PAST_LEN, 2 * N_HEADS, HEAD_DIM)),
        "cache_v": nrm(ks[3], (DEPTH, DEC_BATCH, PAST_LEN, N_HEADS, 2 * HEAD_DIM)) * BETA,
        "w_in": nrm(ks[4], (DEPTH, D_MODEL, IN_WIDTH)) * D_MODEL ** -0.5 * col_scale,
        "w_oa": nrm(ks[5], (DEPTH, ATTN_WIDTH, D_MODEL)) * ATTN_WIDTH ** -0.5 * BETA,
        "w_og": nrm(ks[6], (DEPTH, GMLP_WIDTH, D_MODEL)) * GMLP_WIDTH ** -0.5 * BETA,
        "w_out": nrm(ks[7], (DEPTH, D_MODEL, D_MODEL)) * D_MODEL ** -0.5 * BETA,
        "lambda_q1": nrm(ks[8], (DEPTH, HEAD_DIM)) * 0.1,
        "lambda_k1": nrm(ks[9], (DEPTH, HEAD_DIM)) * 0.1,
        "lambda_q2": nrm(ks[10], (DEPTH, HEAD_DIM)) * 0.1,
        "lambda_k2": nrm(ks[11], (DEPTH, HEAD_DIM)) * 0.1,
        "subln_w": 1.0 + 0.02 * nrm(ks[12], (DEPTH, 2 * HEAD_DIM)),
        "sgu_ln_g": 1.0 + 0.02 * nrm(ks[13], (DEPTH, GMLP_WIDTH)),
        "sgu_ln_b": 0.02 * nrm(ks[14], (DEPTH, GMLP_WIDTH)),
        "w_s": nrm(ks[15], (DEPTH, GMLP_GROUPS, GMLP_CHUNK, GMLP_CHUNK)) * GMLP_CHUNK ** -0.5,
        "b_s": 1.0 + 0.01 * nrm(ks[16], (DEPTH, GMLP_GROUPS, GMLP_CHUNK)),
        "ln_g": 1.0 + 0.02 * nrm(ks[17], (DEPTH, D_MODEL)),
        "ln_b": 0.02 * nrm(ks[18], (DEPTH, D_MODEL)),
    }


def reference(x_prompt, x_sample, cache_k, cache_v, w_in, w_oa, w_og, w_out,
              lambda_q1, lambda_k1, lambda_q2, lambda_k2, subln_w, sgu_ln_g, sgu_ln_b,
              w_s, b_s, ln_g, ln_b):
    pos_p = jnp.arange(x_prompt.shape[1])
    pos_s = PAST_LEN + jnp.arange(x_sample.shape[1])
    tril = jnp.tril(jnp.ones((GMLP_CHUNK, GMLP_CHUNK), dtype=bool))
    xp, xs = x_prompt, x_sample
    kp_l, vp_l, ks_l, vs_l, gs_l = [], [], [], [], []
    for l in range(DEPTH):
        lam_init = 0.8 - 0.6 * math.exp(-0.3 * l)
        ws_m = jnp.where(tril[None], w_s[l], 0.0)
        shared = (w_in[l], w_oa[l], w_og[l], w_out[l], lambda_q1[l], lambda_k1[l],
                  lambda_q2[l], lambda_k2[l], subln_w[l], sgu_ln_g[l], sgu_ln_b[l],
                  ln_g[l], ln_b[l], lam_init)
        xp, kp, vp, _ = mixer_layer(
            xp, pos_p, *shared, diff_attn_prompt,
            functools.partial(sgu_prompt, ws=ws_m, bs=b_s[l]))
        xs, ksn, vsn, gsn = mixer_layer(
            xs, pos_s, *shared,
            functools.partial(diff_attn_sample, ck=cache_k[l], cv=cache_v[l]),
            functools.partial(sgu_sample, ws=ws_m, bs=b_s[l]))
        kp_l.append(kp); vp_l.append(vp)
        ks_l.append(ksn); vs_l.append(vsn); gs_l.append(gsn)
    new_k_prompt = jnp.stack(kp_l)
    new_v_prompt = jnp.stack(vp_l)
    new_k_sample = jnp.stack(ks_l)
    new_v_sample = jnp.stack(vs_l)
    new_gv_sample = jnp.stack(gs_l)
    return (xp, xs, new_k_prompt, new_v_prompt, new_k_sample, new_v_sample, new_gv_sample)
```

```cpp
#include <hip/hip_runtime.h>
#include <hip/hip_cooperative_groups.h>
#include <cstdio>
namespace cg = cooperative_groups;

#ifndef MULTI_LAUNCH
#define MULTI_LAUNCH 1
#endif

#define DI __device__ __forceinline__
typedef unsigned short u16;
typedef __attribute__((ext_vector_type(8))) short bf16x8;
typedef __attribute__((ext_vector_type(4))) short s16x4;
typedef __attribute__((ext_vector_type(16))) float f32x16;
typedef __attribute__((ext_vector_type(2))) float f32x2;
typedef __attribute__((ext_vector_type(2))) __bf16 bf16x2_t;

constexpr int SEQ = 16384, MTOK = 17408, INW = 5632;
constexpr int C_K = 512, C_V = 1024, C_GA = 1536, C_U = 2048, C_VG = 2560, C_GG = 3072, C_MA = 3584, C_MB = 4608;
constexpr size_t OFF_KP = 17825792, OFF_VP = 51380224, OFF_KS = 84934656, OFF_VS = 87031808, OFF_GV = 89128960;
constexpr int SMEM_BYTES = 77824 + 64;
constexpr float ALPHA_RES = 1.681792830507429f;
constexpr float LN_EPS = 1e-5f;

struct Params {
  const float *x_prompt, *x_sample, *cache_k, *cache_v, *w_in, *w_oa, *w_og, *w_out;
  const float *lq1, *lk1, *lq2, *lk2, *subln_w, *sgu_g, *sgu_b, *w_s, *b_s, *ln_g, *ln_b;
  float* out;
  u16 *WinT, *WoaT, *WogT, *WoutT, *Xb, *H, *A1, *A2, *Mg;
  float *Xf, *Xpre, *rope, *lam;
  int* counters;
  int ph_lo, ph_hi;
};

DI unsigned pk(float a, float b) { f32x2 x = {a, b}; bf16x2_t y = __builtin_convertvector(x, bf16x2_t); return __builtin_bit_cast(unsigned, y); }
DI u16 f2bf(float a) { return (u16)(pk(a, 0.f) & 0xffffu); }
DI float bf2f(u16 h) { return __uint_as_float(((unsigned)h) << 16); }
DI float bflo(unsigned u) { return __uint_as_float(u << 16); }
DI float bfhi(unsigned u) { return __uint_as_float(u & 0xffff0000u); }
DI int tid() { int t = threadIdx.x; asm volatile("" : "+v"(t)); return t; }
DI int crow(int i, int hb) { return (i & 3) + 8 * (i >> 2) + 4 * hb; }
DI float sigmoidf_(float x) { return 1.f / (1.f + __expf(-x)); }
DI float siluf_(float x) { return x / (1.f + __expf(-x)); }
#define MFMA(a, b, c) __builtin_amdgcn_mfma_f32_32x32x16_bf16((a), (b), (c), 0, 0, 0)
typedef __attribute__((address_space(3))) s16x4 lds_s16x4;
DI s16x4 tr_read(const u16* p) { return __builtin_amdgcn_ds_read_tr16_b64_v4i16((lds_s16x4*)p); }
DI bf16x8 cat8(s16x4 lo, s16x4 hi) { return __builtin_shufflevector(lo, hi, 0, 1, 2, 3, 4, 5, 6, 7); }

DI void gemm_core(const u16* __restrict__ A, int lda, const u16* __restrict__ Bt, int ldb, int K,
                  f32x16 (&acc)[2][2], unsigned char* smem) {
  u16* As = (u16*)smem;
  u16* Bs = As + 2 * 128 * 72;
  const int t = tid(), l = t & 63, w = t >> 6, wm = w >> 1, wn = w & 1, hb = l >> 5, r = l & 31;
  const int lrow = t >> 3, lkc = (t & 7) * 8;
  uint4 ra0, ra1, ra2, ra3, rb0, rb1, rb2, rb3;
  const u16* ag = A + (size_t)lrow * lda + lkc;
  const u16* bg = Bt + (size_t)lrow * ldb + lkc;
#define GM_GLOAD(KO)                                                                                   \
  ra0 = *(const uint4*)(ag + (KO)); ra1 = *(const uint4*)(ag + (size_t)32 * lda + (KO));               \
  ra2 = *(const uint4*)(ag + (size_t)64 * lda + (KO)); ra3 = *(const uint4*)(ag + (size_t)96 * lda + (KO)); \
  rb0 = *(const uint4*)(bg + (KO)); rb1 = *(const uint4*)(bg + (size_t)32 * ldb + (KO));               \
  rb2 = *(const uint4*)(bg + (size_t)64 * ldb + (KO)); rb3 = *(const uint4*)(bg + (size_t)96 * ldb + (KO));
#define GM_SWRITE(BUF)                                                                                 \
  {                                                                                                    \
    u16* aw_ = As + (BUF) * 128 * 72 + lrow * 72 + lkc; u16* bw_ = Bs + (BUF) * 128 * 72 + lrow * 72 + lkc; \
    *(uint4*)aw_ = ra0; *(uint4*)(aw_ + 32 * 72) = ra1; *(uint4*)(aw_ + 64 * 72) = ra2; *(uint4*)(aw_ + 96 * 72) = ra3; \
    *(uint4*)bw_ = rb0; *(uint4*)(bw_ + 32 * 72) = rb1; *(uint4*)(bw_ + 64 * 72) = rb2; *(uint4*)(bw_ + 96 * 72) = rb3; \
  }
  GM_GLOAD(0)
  __syncthreads();
  GM_SWRITE(0)
  __syncthreads();
  const int nk = K >> 6;
  for (int kt = 0; kt < nk; ++kt) {
    const int buf = kt & 1;
    if (kt + 1 < nk) { GM_GLOAD((kt + 1) * 64) }
    const u16* as = As + buf * 128 * 72 + (wm * 64 + r) * 72 + hb * 8;
    const u16* bs = Bs + buf * 128 * 72 + (wn * 64 + r) * 72 + hb * 8;
#pragma unroll
    for (int ks = 0; ks < 4; ++ks) {
      bf16x8 a0 = *(const bf16x8*)(as + ks * 16), a1 = *(const bf16x8*)(as + 32 * 72 + ks * 16);
      bf16x8 b0 = *(const bf16x8*)(bs + ks * 16), b1 = *(const bf16x8*)(bs + 32 * 72 + ks * 16);
      acc[0][0] = MFMA(a0, b0, acc[0][0]); acc[0][1] = MFMA(a0, b1, acc[0][1]);
      acc[1][0] = MFMA(a1, b0, acc[1][0]); acc[1][1] = MFMA(a1, b1, acc[1][1]);
    }
    if (kt + 1 < nk) GM_SWRITE(buf ^ 1)
    __syncthreads();
  }
}

constexpr int CT_STRIDE = 132;
DI void acc_to_lds(const f32x16 (&acc)[2][2], unsigned char* smem) {
  const int t = tid(), l = t & 63, w = t >> 6, wm = w >> 1, wn = w & 1, hb = l >> 5, r = l & 31;
  float* base = (float*)smem + (wm * 64 + 4 * hb) * CT_STRIDE + wn * 64 + r;
#pragma unroll
  for (int tm = 0; tm < 2; ++tm)
#pragma unroll
    for (int tn = 0; tn < 2; ++tn)
#pragma unroll
      for (int i = 0; i < 16; ++i) base[(tm * 32 + (i & 3) + 8 * (i >> 2)) * CT_STRIDE + tn * 32] = acc[tm][tn][i];
}
DI uint4 pack8(const float4& a, const float4& b) { return make_uint4(pk(a.x, a.y), pk(a.z, a.w), pk(b.x, b.y), pk(b.z, b.w)); }

DI void zero_acc(f32x16 (&acc)[2][2]) {
#pragma unroll
  for (int a = 0; a < 2; ++a)
#pragma unroll
    for (int b = 0; b < 2; ++b)
#pragma unroll
      for (int i = 0; i < 16; ++i) acc[a][b][i] = 0.f;
}

DI void transpose_tile(const float* __restrict__ src, u16* __restrict__ dst, int K, int N, int kt, int nt, unsigned char* smem) {
  float* tile = (float*)smem;
  const int t = tid();
  __syncthreads();
#pragma unroll
  for (int i = 0; i < 4; ++i) {
    const int row = (t >> 4) + 16 * i, c4 = (t & 15) * 4;
    const float4 v = *(const float4*)(src + (size_t)(kt * 64 + row) * N + nt * 64 + c4);
    tile[row * 65 + c4 + 0] = v.x; tile[row * 65 + c4 + 1] = v.y; tile[row * 65 + c4 + 2] = v.z; tile[row * 65 + c4 + 3] = v.w;
  }
  __syncthreads();
  const int n = t >> 2, kseg = (t & 3) * 16;
  unsigned o[8];
#pragma unroll
  for (int e = 0; e < 8; ++e) o[e] = pk(tile[(kseg + 2 * e) * 65 + n], tile[(kseg + 2 * e + 1) * 65 + n]);
  u16* d = dst + (size_t)(nt * 64 + n) * K + kt * 64 + kseg;
  *(uint4*)d = make_uint4(o[0], o[1], o[2], o[3]);
  *(uint4*)(d + 8) = make_uint4(o[4], o[5], o[6], o[7]);
}

DI void phase0(const Params& p, unsigned char* smem) {
  const int t = tid();
  if (blockIdx.x == 0) {
    if (t < 4) {
      float s1 = 0.f, s2 = 0.f;
      for (int i = 0; i < 64; ++i) { s1 += p.lq1[t * 64 + i] * p.lk1[t * 64 + i]; s2 += p.lq2[t * 64 + i] * p.lk2[t * 64 + i]; }
      const float li = t == 0 ? 0.2f : (t == 1 ? 0.355509067590969f : (t == 2 ? 0.470713018343584f : 0.556058204155641f));
      p.lam[t] = expf(s1) - expf(s2) + li;
      p.lam[4 + t] = li;
      p.counters[t] = 0;
    }
  }
  for (int j = blockIdx.x; j < 7680; j += gridDim.x) {
    if (j < 5632) { const int l = j / 1408, r = j % 1408; transpose_tile(p.w_in + (size_t)l * 1024 * 5632, p.WinT + (size_t)l * 5632 * 1024, 1024, 5632, r / 88, r % 88, smem); }
    else if (j < 6144) { const int q = j - 5632, l = q >> 7, r = q & 127; transpose_tile(p.w_oa + (size_t)l * 512 * 1024, p.WoaT + (size_t)l * 1024 * 512, 512, 1024, r >> 4, r & 15, smem); }
    else if (j < 6656) { const int q = j - 6144, l = q >> 7, r = q & 127; transpose_tile(p.w_og + (size_t)l * 512 * 1024, p.WogT + (size_t)l * 1024 * 512, 512, 1024, r >> 4, r & 15, smem); }
    else { const int q = j - 6656, l = q >> 8, r = q & 255; transpose_tile(p.w_out + (size_t)l * 1024 * 1024, p.WoutT + (size_t)l * 1024 * 1024, 1024, 1024, r >> 4, r & 15, smem); }
  }
  const int gt = blockIdx.x * 256 + t, gs = gridDim.x * 256;
  for (int idx = gt; idx < MTOK * 128; idx += gs) {
    const int row = idx >> 7, c8 = (idx & 127) * 8;
    const float* src = row < SEQ ? p.x_prompt + (size_t)row * 1024 + c8 : p.x_sample + (size_t)(row - SEQ) * 1024 + c8;
    const float4 a = *(const float4*)src, b = *(const float4*)(src + 4);
    *(uint4*)(p.Xb + (size_t)row * 1024 + c8) = make_uint4(pk(a.x, a.y), pk(a.z, a.w), pk(b.x, b.y), pk(b.z, b.w));
  }
  for (int idx = gt; idx < SEQ * 32; idx += gs) {
    const int pos = idx >> 5, j = idx & 31;
    const float inv = (float)exp2(-(double)j * (13.287712379549449 / 32.0));
    const float ang = (float)pos * inv;
    double rev = (double)ang * 0.15915494309189535;
    rev -= rint(rev);
    const float rf = (float)rev;
    p.rope[2 * idx] = __builtin_amdgcn_cosf(rf);
    p.rope[2 * idx + 1] = __builtin_amdgcn_sinf(rf);
  }
}

DI void phaseA_tile(const Params& p, int layer, int mt, int nt, unsigned char* smem) {
  f32x16 acc[2][2];
  zero_acc(acc);
  gemm_core(p.Xb + (size_t)mt * 128 * 1024, 1024, p.WinT + ((size_t)layer * 5632 + nt * 128) * 1024, 1024, 1024, acc, smem);
  const int t = tid();
  const int n0 = nt * 128, seg = n0 >> 9;
  const bool samp = mt >= 128;
  acc_to_lds(acc, smem);
  __syncthreads();
  const float* ct = (const float*)smem;
  if (seg <= 1) {
    const int j = t & 7, head = j >> 2, c8 = (j & 3) * 8;
#pragma unroll
    for (int i = 0; i < 4; ++i) {
      const int rl = (t >> 3) + 32 * i;
      const int row = mt * 128 + rl;
      const int pos = samp ? 1024 + ((row - SEQ) & 31) : row;
      const float* cp = ct + rl * CT_STRIDE + head * 64 + c8;
      const float4 xa0 = *(const float4*)cp, xa1 = *(const float4*)(cp + 4);
      const float4 xb0 = *(const float4*)(cp + 32), xb1 = *(const float4*)(cp + 36);
      const float4* rp = (const float4*)(p.rope + ((size_t)pos * 32 + c8) * 2);
      const float4 r0 = rp[0], r1 = rp[1], r2 = rp[2], r3 = rp[3];
      float4 ya0, ya1, yb0, yb1;
      ya0.x = xa0.x * r0.x - xb0.x * r0.y; yb0.x = xb0.x * r0.x + xa0.x * r0.y;
      ya0.y = xa0.y * r0.z - xb0.y * r0.w; yb0.y = xb0.y * r0.z + xa0.y * r0.w;
      ya0.z = xa0.z * r1.x - xb0.z * r1.y; yb0.z = xb0.z * r1.x + xa0.z * r1.y;
      ya0.w = xa0.w * r1.z - xb0.w * r1.w; yb0.w = xb0.w * r1.z + xa0.w * r1.w;
      ya1.x = xa1.x * r2.x - xb1.x * r2.y; yb1.x = xb1.x * r2.x + xa1.x * r2.y;
      ya1.y = xa1.y * r2.z - xb1.y * r2.w; yb1.y = xb1.y * r2.z + xa1.y * r2.w;
      ya1.z = xa1.z * r3.x - xb1.z * r3.y; yb1.z = xb1.z * r3.x + xa1.z * r3.y;
      ya1.w = xa1.w * r3.z - xb1.w * r3.w; yb1.w = xb1.w * r3.z + xa1.w * r3.w;
      const int col = n0 + head * 64 + c8;
      u16* h = p.H + (size_t)row * INW + col;
      *(uint4*)h = pack8(ya0, ya1);
      *(uint4*)(h + 32) = pack8(yb0, yb1);
      if (seg == 1) {
        float* o = samp ? p.out + OFF_KS + ((size_t)layer * 1024 + (row - SEQ)) * 512 + (col - C_K)
                        : p.out + OFF_KP + ((size_t)layer * SEQ + row) * 512 + (col - C_K);
        *(float4*)o = ya0; *(float4*)(o + 4) = ya1; *(float4*)(o + 32) = yb0; *(float4*)(o + 36) = yb1;
      }
    }
  } else {
    const int c8 = (t & 15) * 8;
#pragma unroll
    for (int i = 0; i < 8; ++i) {
      const int rl = (t >> 4) + 16 * i;
      const int row = mt * 128 + rl;
      const float* cp = ct + rl * CT_STRIDE + c8;
      const float4 v0 = *(const float4*)cp, v1 = *(const float4*)(cp + 4);
      const int col = n0 + c8;
      *(uint4*)(p.H + (size_t)row * INW + col) = pack8(v0, v1);
      if (seg == 2) {
        float* o = samp ? p.out + OFF_VS + ((size_t)layer * 1024 + (row - SEQ)) * 512 + (col - C_V)
                        : p.out + OFF_VP + ((size_t)layer * SEQ + row) * 512 + (col - C_V);
        *(float4*)o = v0; *(float4*)(o + 4) = v1;
      }
    }
  }
}

constexpr int KS_STRIDE = 72;
constexpr int VS_STRIDE = 160;
constexpr int ST_K = 2 * 64 * KS_STRIDE;
constexpr int ST_BYTES = ST_K * 2 + 64 * VS_STRIDE * 2;

DI void attn_compute(const u16* Kb, const u16* Vb, const bf16x8 (&qf)[4], f32x16 (&O)[4], float& m_run, float& l_run, bool two, int s) {
  const int l = tid() & 63, hb = l >> 5, r = l & 31;
  const float c = 0.125f * 1.4426950408889634f;
  f32x16 S0, S1;
#pragma unroll
  for (int i = 0; i < 16; ++i) { S0[i] = 0.f; S1[i] = 0.f; }
  const u16* kp = Kb + (s * 64 + r) * KS_STRIDE + hb * 8;
#pragma unroll
  for (int ks = 0; ks < 4; ++ks) { bf16x8 a = *(const bf16x8*)(kp + ks * 16); S0 = MFMA(a, qf[ks], S0); }
  if (two) {
#pragma unroll
    for (int ks = 0; ks < 4; ++ks) { bf16x8 a = *(const bf16x8*)(kp + 32 * KS_STRIDE + ks * 16); S1 = MFMA(a, qf[ks], S1); }
  }
  float mx = S0[0];
#pragma unroll
  for (int i = 1; i < 16; ++i) mx = fmaxf(mx, S0[i]);
  if (two) {
#pragma unroll
    for (int i = 0; i < 16; ++i) mx = fmaxf(mx, S1[i]);
  }
  mx = fmaxf(mx, __shfl_xor(mx, 32));
  const float m_new = fmaxf(m_run, mx * c);
  const float alpha = __builtin_amdgcn_exp2f(m_run - m_new);
  m_run = m_new;
  float ls = 0.f;
#pragma unroll
  for (int i = 0; i < 16; ++i) { S0[i] = __builtin_amdgcn_exp2f(S0[i] * c - m_new); ls += S0[i]; }
  if (two) {
#pragma unroll
    for (int i = 0; i < 16; ++i) { S1[i] = __builtin_amdgcn_exp2f(S1[i] * c - m_new); ls += S1[i]; }
  }
  l_run = l_run * alpha + ls;
  if (!__all(alpha == 1.f)) {
#pragma unroll
    for (int dt = 0; dt < 4; ++dt)
#pragma unroll
      for (int i = 0; i < 16; ++i) O[dt][i] *= alpha;
  }
  const int q4 = (l & 15) >> 2, p4 = l & 3, blk = (l >> 4) & 1;
  const u16* vp = Vb + (4 * hb + q4) * VS_STRIDE + blk * 16 + p4 * 4;
#pragma unroll
  for (int tt = 0; tt < 2; ++tt) {
    if (tt == 1 && !two) break;
#pragma unroll
    for (int u = 0; u < 2; ++u) {
      bf16x8 pb;
      {
        unsigned a0, a1, a2, a3;
        if (tt == 0) { a0 = pk(S0[8 * u + 0], S0[8 * u + 1]); a1 = pk(S0[8 * u + 2], S0[8 * u + 3]); a2 = pk(S0[8 * u + 4], S0[8 * u + 5]); a3 = pk(S0[8 * u + 6], S0[8 * u + 7]); }
        else         { a0 = pk(S1[8 * u + 0], S1[8 * u + 1]); a1 = pk(S1[8 * u + 2], S1[8 * u + 3]); a2 = pk(S1[8 * u + 4], S1[8 * u + 5]); a3 = pk(S1[8 * u + 6], S1[8 * u + 7]); }
        uint4 v4 = make_uint4(a0, a1, a2, a3);
        pb = __builtin_bit_cast(bf16x8, v4);
      }
      const u16* vk = vp + (tt * 32 + u * 16) * VS_STRIDE;
      __builtin_amdgcn_sched_barrier(0);
#pragma unroll
      for (int dt = 0; dt < 4; ++dt) {
        s16x4 lo = tr_read(vk + dt * 32);
        s16x4 hi = tr_read(vk + 8 * VS_STRIDE + dt * 32);
        O[dt] = MFMA(cat8(lo, hi), pb, O[dt]);
      }
    }
  }
}

template <bool SAMPLE>
DI void attn_item(const Params& p, int layer, int a, int h, unsigned char* smem) {
  const int t = tid(), l = t & 63, w = t >> 6, rg = w & 1, s = w >> 1, hb = l >> 5, r = l & 31;
  const int hh = 2 * h + s;
  const int qrow0 = SAMPLE ? SEQ + a * 32 : a * 64 + rg * 32;
  const bool active = SAMPLE ? (rg == 0) : true;
  const u16* H = p.H;
  bf16x8 qf[4];
  {
    const u16* qp = H + (size_t)(qrow0 + r) * INW + hh * 64 + hb * 8;
#pragma unroll
    for (int ks = 0; ks < 4; ++ks) qf[ks] = *(const bf16x8*)(qp + ks * 16);
  }
  f32x16 O[4];
#pragma unroll
  for (int dt = 0; dt < 4; ++dt)
#pragma unroll
    for (int i = 0; i < 16; ++i) O[dt][i] = 0.f;
  float m_run = -1e30f, l_run = 0.f;
  u16* sm = (u16*)smem;

  __syncthreads();
  if (!SAMPLE) {
    const int ntiles = a + 1;
    uint4 rk0, rk1, rk2, rk3, rv0, rv1, rv2, rv3;
    const u16* kg = H + C_K + (2 * h) * 64;
    const u16* vg = H + C_V + h * 128;
#define ATT_GLOAD(KT)                                                                                     \
    {                                                                                                     \
      const u16* kq_ = kg + (size_t)((KT) * 64 + ((t >> 3) & 31)) * INW + (t & 7) * 8;                     \
      rk0 = *(const uint4*)(kq_); rk1 = *(const uint4*)(kq_ + (size_t)32 * INW);                          \
      rk2 = *(const uint4*)(kq_ + 64); rk3 = *(const uint4*)(kq_ + (size_t)32 * INW + 64);                \
      const u16* vq_ = vg + (size_t)((KT) * 64 + (t >> 4)) * INW + (t & 15) * 8;                           \
      rv0 = *(const uint4*)(vq_); rv1 = *(const uint4*)(vq_ + (size_t)16 * INW);                          \
      rv2 = *(const uint4*)(vq_ + (size_t)32 * INW); rv3 = *(const uint4*)(vq_ + (size_t)48 * INW);        \
    }
#define ATT_SWRITE(BUF)                                                                                   \
    {                                                                                                     \
      u16* kb_ = sm + (BUF) * (ST_BYTES / 2) + ((t >> 3) & 31) * KS_STRIDE + (t & 7) * 8;                  \
      *(uint4*)kb_ = rk0; *(uint4*)(kb_ + 32 * KS_STRIDE) = rk1;                                          \
      *(uint4*)(kb_ + 64 * KS_STRIDE) = rk2; *(uint4*)(kb_ + 96 * KS_STRIDE) = rk3;                       \
      u16* vb_ = sm + (BUF) * (ST_BYTES / 2) + ST_K + (t >> 4) * VS_STRIDE + (t & 15) * 8;                 \
      *(uint4*)vb_ = rv0; *(uint4*)(vb_ + 16 * VS_STRIDE) = rv1;                                          \
      *(uint4*)(vb_ + 32 * VS_STRIDE) = rv2; *(uint4*)(vb_ + 48 * VS_STRIDE) = rv3;                       \
    }
    ATT_GLOAD(0)
    ATT_SWRITE(0)
    __syncthreads();
    for (int kt = 0; kt < ntiles; ++kt) {
      const int buf = kt & 1;
      if (kt + 1 < ntiles) { ATT_GLOAD(kt + 1) }
      const u16* kb = sm + buf * (ST_BYTES / 2);
      attn_compute(kb, kb + ST_K, qf, O, m_run, l_run, true, s);
      if (kt + 1 < ntiles) ATT_SWRITE(buf ^ 1)
      __syncthreads();
    }
  } else {
    const float* ck = p.cache_k + ((size_t)(layer * 32 + a) * 1024) * 512 + (2 * h) * 64;
    const float* cv = p.cache_v + ((size_t)(layer * 32 + a) * 1024) * 512 + h * 128;
    u16* kb = sm;
    u16* vb = sm + ST_K;
    for (int kt = 0; kt < 17; ++kt) {
      if (kt < 16) {
#pragma unroll 2
        for (int i = 0; i < 8; ++i) {
          const int cc = t + 256 * i;
          const int sh = cc >> 10, key = (cc >> 4) & 63, ch = cc & 15;
          const float4 v = *(const float4*)(ck + (size_t)(kt * 64 + key) * 512 + sh * 64 + ch * 4);
          *(uint2*)(kb + (sh * 64 + key) * KS_STRIDE + ch * 4) = make_uint2(pk(v.x, v.y), pk(v.z, v.w));
          const int vkey = cc >> 5, vch = cc & 31;
          const float4 u = *(const float4*)(cv + (size_t)(kt * 64 + vkey) * 512 + vch * 4);
          *(uint2*)(vb + vkey * VS_STRIDE + vch * 4) = make_uint2(pk(u.x, u.y), pk(u.z, u.w));
        }
      } else {
        const u16* kg = H + (size_t)(SEQ + a * 32) * INW + C_K + (2 * h) * 64;
        const u16* vg = H + (size_t)(SEQ + a * 32) * INW + C_V + h * 128;
#pragma unroll
        for (int i = 0; i < 2; ++i) {
          const int cc = t + 256 * i;
          const int sh = cc >> 8, key = (cc >> 3) & 31, ch = cc & 7;
          *(uint4*)(kb + (sh * 64 + key) * KS_STRIDE + ch * 8) = *(const uint4*)(kg + (size_t)key * INW + sh * 64 + ch * 8);
          const int vkey = cc >> 4, vch = cc & 15;
          *(uint4*)(vb + vkey * VS_STRIDE + vch * 8) = *(const uint4*)(vg + (size_t)vkey * INW + vch * 8);
        }
      }
      __syncthreads();
      if (active) attn_compute(kb, vb, qf, O, m_run, l_run, kt < 16, s);
      __syncthreads();
    }
  }
  float lt = l_run + __shfl_xor(l_run, 32);
  const float inv_l = 1.f / lt;
  float* ex = (float*)smem;
  if (s == 1 && active) {
#pragma unroll
    for (int dt = 0; dt < 4; ++dt)
#pragma unroll
      for (int i = 0; i < 16; ++i) ex[(rg * 128 + dt * 32 + crow(i, hb)) * 32 + r] = O[dt][i] * inv_l;
  }
  __syncthreads();
  if (s == 0 && active) {
    const float lam = p.lam[layer], li = p.lam[4 + layer];
    float ss = 0.f;
#pragma unroll
    for (int dt = 0; dt < 4; ++dt)
#pragma unroll
      for (int i = 0; i < 16; ++i) {
        const float o = O[dt][i] * inv_l - lam * ex[(rg * 128 + dt * 32 + crow(i, hb)) * 32 + r];
        O[dt][i] = o; ss += o * o;
      }
    ss += __shfl_xor(ss, 32);
    const float rs = rsqrtf(ss * (1.f / 128.f) + LN_EPS) * (1.f - li);
    const int row = qrow0 + r;
    const u16* gp = H + (size_t)row * INW + C_GA + h * 128;
    u16* op = p.A1 + (size_t)row * 512 + h * 128;
    const float* sw = p.subln_w + layer * 128;
#pragma unroll
    for (int dt = 0; dt < 4; ++dt)
#pragma unroll
      for (int g4 = 0; g4 < 4; ++g4) {
        const int d = dt * 32 + 8 * g4 + 4 * hb;
        const uint2 gv = *(const uint2*)(gp + d);
        const float4 wv = *(const float4*)(sw + d);
        const float y0 = O[dt][4 * g4 + 0] * rs * wv.x * siluf_(bflo(gv.x));
        const float y1 = O[dt][4 * g4 + 1] * rs * wv.y * siluf_(bfhi(gv.x));
        const float y2 = O[dt][4 * g4 + 2] * rs * wv.z * siluf_(bflo(gv.y));
        const float y3 = O[dt][4 * g4 + 3] * rs * wv.w * siluf_(bfhi(gv.y));
        *(uint2*)(op + d) = make_uint2(pk(y0, y1), pk(y2, y3));
      }
  }
}

DI void sgu_item(const Params& p, int layer, int chunk, int g, unsigned char* smem) {
  const int t = tid(), l = t & 63, w = t >> 6, wm = w >> 1, wn = w & 1, hb = l >> 5, r = l & 31;
  const int m0 = chunk * 128;
  const bool samp = chunk >= 128;
  u16* Asg = (u16*)smem;
  u16* Bsg = Asg + 128 * 72;
  float* st = (float*)(smem + 38912);
  const u16* H = p.H;
  __syncthreads();
  for (int rr = 0; rr < 32; ++rr) {
    const int row = w * 32 + rr;
    const uint4 v = *(const uint4*)(H + (size_t)(m0 + row) * INW + C_VG + l * 8);
    float x[8] = {bflo(v.x), bfhi(v.x), bflo(v.y), bfhi(v.y), bflo(v.z), bfhi(v.z), bflo(v.w), bfhi(v.w)};
    float s1 = 0.f, s2 = 0.f;
#pragma unroll
    for (int e = 0; e < 8; ++e) { s1 += x[e]; s2 += x[e] * x[e]; }
#pragma unroll
    for (int o = 32; o >= 1; o >>= 1) { s1 += __shfl_xor(s1, o); s2 += __shfl_xor(s2, o); }
    if (l == 0) {
      const float mean = s1 * (1.f / 512.f);
      const float var = fmaxf(s2 * (1.f / 512.f) - mean * mean, 0.f);
      st[row] = mean; st[128 + row] = rsqrtf(var + LN_EPS);
    }
  }
  __syncthreads();
  f32x16 acc[2][2];
  zero_acc(acc);
  const float* Wg = p.w_s + ((size_t)(layer * 4 + g) * 128) * 128;
  const float* gam = p.sgu_g + layer * 512 + g * 128;
  const float* bet = p.sgu_b + layer * 512 + g * 128;
  const int q4 = (l & 15) >> 2, p4 = l & 3, blk = (l >> 4) & 1;
  for (int kh = 0; kh < 2; ++kh) {
#pragma unroll
    for (int i8 = 0; i8 < 8; ++i8) {
      const int cc = t + 256 * i8;
      const int i = cc >> 4, j4 = (cc & 15) * 4, j = kh * 64 + j4;
      float4 v;
      float e0, e1, e2, e3;
      if (!samp) {
        v = *(const float4*)(Wg + i * 128 + j);
        e0 = (j + 0 <= i) ? v.x : 0.f; e1 = (j + 1 <= i) ? v.y : 0.f; e2 = (j + 2 <= i) ? v.z : 0.f; e3 = (j + 3 <= i) ? v.w : 0.f;
      } else {
        const int i32 = i & 31, j32 = j & 31;
        v = *(const float4*)(Wg + i32 * 128 + j32);
        const bool same = (i >> 5) == (j >> 5);
        e0 = (same && j32 + 0 <= i32) ? v.x : 0.f; e1 = (same && j32 + 1 <= i32) ? v.y : 0.f;
        e2 = (same && j32 + 2 <= i32) ? v.z : 0.f; e3 = (same && j32 + 3 <= i32) ? v.w : 0.f;
      }
      *(uint2*)(Asg + i * 72 + j4) = make_uint2(pk(e0, e1), pk(e2, e3));
    }
#pragma unroll
    for (int i4 = 0; i4 < 4; ++i4) {
      const int cc = t + 256 * i4;
      const int jj = cc >> 4, dc = (cc & 15) * 8;
      const int jrow = kh * 64 + jj;
      const uint4 v = *(const uint4*)(H + (size_t)(m0 + jrow) * INW + C_VG + g * 128 + dc);
      const float mean = st[jrow], rstd = st[128 + jrow];
      const float4 g0 = *(const float4*)(gam + dc), g1 = *(const float4*)(gam + dc + 4);
      const float4 b0 = *(const float4*)(bet + dc), b1 = *(const float4*)(bet + dc + 4);
      const float y0 = (bflo(v.x) - mean) * rstd * g0.x + b0.x, y1 = (bfhi(v.x) - mean) * rstd * g0.y + b0.y;
      const float y2 = (bflo(v.y) - mean) * rstd * g0.z + b0.z, y3 = (bfhi(v.y) - mean) * rstd * g0.w + b0.w;
      const float y4 = (bflo(v.z) - mean) * rstd * g1.x + b1.x, y5 = (bfhi(v.z) - mean) * rstd * g1.y + b1.y;
      const float y6 = (bflo(v.w) - mean) * rstd * g1.z + b1.z, y7 = (bfhi(v.w) - mean) * rstd * g1.w + b1.w;
      *(uint4*)(Bsg + jj * VS_STRIDE + dc) = make_uint4(pk(y0, y1), pk(y2, y3), pk(y4, y5), pk(y6, y7));
      if (samp) {
        float* o = p.out + OFF_GV + ((size_t)layer * 1024 + (m0 - SEQ) + jrow) * 512 + g * 128 + dc;
        *(float4*)o = make_float4(y0, y1, y2, y3);
        *(float4*)(o + 4) = make_float4(y4, y5, y6, y7);
      }
    }
    __syncthreads();
    const u16* as = Asg + (wm * 64 + r) * 72 + hb * 8;
    const u16* bs = Bsg + (8 * hb + q4) * VS_STRIDE + wn * 64 + blk * 16 + p4 * 4;
#pragma unroll
    for (int ks = 0; ks < 4; ++ks) {
      bf16x8 a0 = *(const bf16x8*)(as + ks * 16), a1 = *(const bf16x8*)(as + 32 * 72 + ks * 16);
      const u16* bk = bs + ks * 16 * VS_STRIDE;
      bf16x8 b0 = cat8(tr_read(bk), tr_read(bk + 4 * VS_STRIDE));
      bf16x8 b1 = cat8(tr_read(bk + 32), tr_read(bk + 4 * VS_STRIDE + 32));
      acc[0][0] = MFMA(a0, b0, acc[0][0]); acc[0][1] = MFMA(a0, b1, acc[0][1]);
      acc[1][0] = MFMA(a1, b0, acc[1][0]); acc[1][1] = MFMA(a1, b1, acc[1][1]);
    }
    __syncthreads();
  }
  const float* bsp = p.b_s + (size_t)(layer * 4 + g) * 128;
  acc_to_lds(acc, smem);
  __syncthreads();
  {
    const float* ct = (const float*)smem;
    const int c8 = (t & 15) * 8;
#pragma unroll
    for (int i = 0; i < 8; ++i) {
      const int rl = (t >> 4) + 16 * i;
      const int row = m0 + rl;
      const float* cp = ct + rl * CT_STRIDE + c8;
      const float4 v0 = *(const float4*)cp, v1 = *(const float4*)(cp + 4);
      const float bias = bsp[samp ? (rl & 31) : rl];
      const uint4 uu = *(const uint4*)(H + (size_t)row * INW + C_U + g * 128 + c8);
      const uint4 gg = *(const uint4*)(H + (size_t)row * INW + C_GG + g * 128 + c8);
      float4 o0, o1;
      o0.x = (v0.x + bias) * bflo(uu.x) * siluf_(bflo(gg.x)); o0.y = (v0.y + bias) * bfhi(uu.x) * siluf_(bfhi(gg.x));
      o0.z = (v0.z + bias) * bflo(uu.y) * siluf_(bflo(gg.y)); o0.w = (v0.w + bias) * bfhi(uu.y) * siluf_(bfhi(gg.y));
      o1.x = (v1.x + bias) * bflo(uu.z) * siluf_(bflo(gg.z)); o1.y = (v1.y + bias) * bfhi(uu.z) * siluf_(bfhi(gg.z));
      o1.z = (v1.z + bias) * bflo(uu.w) * siluf_(bflo(gg.w)); o1.w = (v1.w + bias) * bfhi(uu.w) * siluf_(bfhi(gg.w));
      *(uint4*)(p.A2 + (size_t)row * 512 + g * 128 + c8) = pack8(o0, o1);
    }
  }
}

DI void phaseB(const Params& p, int layer, unsigned char* smem) {
  int* s_item = (int*)(smem + 77824);
  const int total = 128 + 1024 + 544;
  for (;;) {
    __syncthreads();
    if (threadIdx.x == 0) *s_item = atomicAdd(p.counters + layer, 1);
    __syncthreads();
    const int it = *s_item;
    if (it >= total) break;
    if (it < 128) attn_item<true>(p, layer, it >> 2, it & 3, smem);
    else if (it < 1152) { const int j = it - 128; attn_item<false>(p, layer, 255 - (j >> 2), j & 3, smem); }
    else { const int j = it - 1152; sgu_item(p, layer, j >> 2, j & 3, smem); }
  }
}

DI void phaseC1_tile(const Params& p, int layer, int mt, int nt, unsigned char* smem) {
  const int t = tid();
  const int c8 = (t & 15) * 8;
  const float* ct = (const float*)smem;
  f32x16 acc[2][2];
  zero_acc(acc);
  gemm_core(p.A1 + (size_t)mt * 128 * 512, 512, p.WoaT + ((size_t)layer * 1024 + nt * 128) * 512, 512, 512, acc, smem);
  acc_to_lds(acc, smem);
  __syncthreads();
#pragma unroll
  for (int i = 0; i < 8; ++i) {
    const int rl = (t >> 4) + 16 * i;
    const int row = mt * 128 + rl;
    const float* cp = ct + rl * CT_STRIDE + c8;
    const float4 v0 = *(const float4*)cp, v1 = *(const float4*)(cp + 4);
    const uint4 g = *(const uint4*)(p.H + (size_t)row * INW + C_MA + nt * 128 + c8);
    float* mp = p.Xpre + (size_t)row * 1024 + nt * 128 + c8;
    *(float4*)mp = make_float4(v0.x * sigmoidf_(bflo(g.x)), v0.y * sigmoidf_(bfhi(g.x)), v0.z * sigmoidf_(bflo(g.y)), v0.w * sigmoidf_(bfhi(g.y)));
    *(float4*)(mp + 4) = make_float4(v1.x * sigmoidf_(bflo(g.z)), v1.y * sigmoidf_(bfhi(g.z)), v1.z * sigmoidf_(bflo(g.w)), v1.w * sigmoidf_(bfhi(g.w)));
  }
  zero_acc(acc);
  gemm_core(p.A2 + (size_t)mt * 128 * 512, 512, p.WogT + ((size_t)layer * 1024 + nt * 128) * 512, 512, 512, acc, smem);
  acc_to_lds(acc, smem);
  __syncthreads();
#pragma unroll
  for (int i = 0; i < 8; ++i) {
    const int rl = (t >> 4) + 16 * i;
    const int row = mt * 128 + rl;
    const float* cp = ct + rl * CT_STRIDE + c8;
    const float4 v0 = *(const float4*)cp, v1 = *(const float4*)(cp + 4);
    const uint4 g = *(const uint4*)(p.H + (size_t)row * INW + C_MB + nt * 128 + c8);
    float4 o0, o1;
    const float* mp = p.Xpre + (size_t)row * 1024 + nt * 128 + c8;
    const float4 ma0 = *(const float4*)mp, ma1 = *(const float4*)(mp + 4);
    o0.x = ma0.x + v0.x * sigmoidf_(bflo(g.x)); o0.y = ma0.y + v0.y * sigmoidf_(bfhi(g.x));
    o0.z = ma0.z + v0.z * sigmoidf_(bflo(g.y)); o0.w = ma0.w + v0.w * sigmoidf_(bfhi(g.y));
    o1.x = ma1.x + v1.x * sigmoidf_(bflo(g.z)); o1.y = ma1.y + v1.y * sigmoidf_(bfhi(g.z));
    o1.z = ma1.z + v1.z * sigmoidf_(bflo(g.w)); o1.w = ma1.w + v1.w * sigmoidf_(bfhi(g.w));
    *(uint4*)(p.Mg + (size_t)row * 1024 + nt * 128 + c8) = pack8(o0, o1);
  }
}

DI void phaseC2_tile(const Params& p, int layer, int mt, int nt, unsigned char* smem) {
  const int t = tid();
  const int c8 = (t & 15) * 8;
  const float* ct = (const float*)smem;
  f32x16 acc[2][2];
  zero_acc(acc);
  gemm_core(p.Mg + (size_t)mt * 128 * 1024, 1024, p.WoutT + ((size_t)layer * 1024 + nt * 128) * 1024, 1024, 1024, acc, smem);
  acc_to_lds(acc, smem);
  __syncthreads();
  const float* xsrc = layer == 0 ? (mt < 128 ? p.x_prompt : p.x_sample - (size_t)SEQ * 1024) : p.Xf;
#pragma unroll
  for (int i = 0; i < 8; ++i) {
    const int rl = (t >> 4) + 16 * i;
    const int row = mt * 128 + rl;
    const float* cp = ct + rl * CT_STRIDE + c8;
    const float4 v0 = *(const float4*)cp, v1 = *(const float4*)(cp + 4);
    const float* xp = xsrc + (size_t)row * 1024 + nt * 128 + c8;
    const float4 x0 = *(const float4*)xp, x1 = *(const float4*)(xp + 4);
    float* op = p.Xpre + (size_t)row * 1024 + nt * 128 + c8;
    *(float4*)op = make_float4(ALPHA_RES * x0.x + v0.x, ALPHA_RES * x0.y + v0.y, ALPHA_RES * x0.z + v0.z, ALPHA_RES * x0.w + v0.w);
    *(float4*)(op + 4) = make_float4(ALPHA_RES * x1.x + v1.x, ALPHA_RES * x1.y + v1.y, ALPHA_RES * x1.z + v1.z, ALPHA_RES * x1.w + v1.w);
  }
}

DI void phaseLN(const Params& p, int layer) {
  const int t = tid(), l = t & 63, w = t >> 6;
  const float* g = p.ln_g + layer * 1024;
  const float* b = p.ln_b + layer * 1024;
  float* dstf = layer == 3 ? p.out : p.Xf;
  for (int row = blockIdx.x * 4 + w; row < MTOK; row += gridDim.x * 4) {
    const float* src = p.Xpre + (size_t)row * 1024;
    float4 v[4];
    float s1 = 0.f;
#pragma unroll
    for (int i = 0; i < 4; ++i) { v[i] = *(const float4*)(src + i * 256 + l * 4); s1 += v[i].x + v[i].y + v[i].z + v[i].w; }
#pragma unroll
    for (int o = 32; o >= 1; o >>= 1) s1 += __shfl_xor(s1, o);
    const float mean = s1 * (1.f / 1024.f);
    float s2 = 0.f;
#pragma unroll
    for (int i = 0; i < 4; ++i) {
      v[i].x -= mean; v[i].y -= mean; v[i].z -= mean; v[i].w -= mean;
      s2 += v[i].x * v[i].x + v[i].y * v[i].y + v[i].z * v[i].z + v[i].w * v[i].w;
    }
#pragma unroll
    for (int o = 32; o >= 1; o >>= 1) s2 += __shfl_xor(s2, o);
    const float rstd = rsqrtf(s2 * (1.f / 1024.f) + LN_EPS);
#pragma unroll
    for (int i = 0; i < 4; ++i) {
      const int c = i * 256 + l * 4;
      const float4 gv = *(const float4*)(g + c), bv = *(const float4*)(b + c);
      const float y0 = v[i].x * rstd * gv.x + bv.x, y1 = v[i].y * rstd * gv.y + bv.y;
      const float y2 = v[i].z * rstd * gv.z + bv.z, y3 = v[i].w * rstd * gv.w + bv.w;
      *(float4*)(dstf + (size_t)row * 1024 + c) = make_float4(y0, y1, y2, y3);
      *(uint2*)(p.Xb + (size_t)row * 1024 + c) = make_uint2(pk(y0, y1), pk(y2, y3));
    }
  }
}

__global__ void __launch_bounds__(256, 2) fwd_megakernel(Params p) {
  __shared__ __attribute__((aligned(16))) unsigned char smem[SMEM_BYTES];
  cg::grid_group grid = cg::this_grid();
  for (int ph = p.ph_lo; ph < p.ph_hi; ++ph) {
    if (ph == 0) {
      phase0(p, smem);
    } else {
      const int layer = (ph - 1) / 5, sub = (ph - 1) % 5;
      if (sub == 0) {
        for (int tix = blockIdx.x; tix < 136 * 44; tix += gridDim.x) phaseA_tile(p, layer, tix / 44, tix % 44, smem);
      } else if (sub == 1) {
        phaseB(p, layer, smem);
      } else if (sub == 2) {
        for (int tix = blockIdx.x; tix < 136 * 8; tix += gridDim.x) phaseC1_tile(p, layer, tix >> 3, tix & 7, smem);
      } else if (sub == 3) {
        for (int tix = blockIdx.x; tix < 136 * 8; tix += gridDim.x) phaseC2_tile(p, layer, tix >> 3, tix & 7, smem);
      } else {
        phaseLN(p, layer);
      }
    }
    if (ph + 1 < p.ph_hi) grid.sync();
  }
}

extern "C" void kernel_launch(void* const* d_in, const int* in_sizes, int n_in, void* d_out, int out_size, void* d_ws, size_t ws_size, hipStream_t stream) {
  static int grid_blocks = 0;
  if (!grid_blocks) {
    int dev = 0, cus = 0, per_cu = 0;
    hipGetDevice(&dev);
    hipDeviceGetAttribute(&cus, hipDeviceAttributeMultiprocessorCount, dev);
    hipOccupancyMaxActiveBlocksPerMultiprocessor(&per_cu, fwd_megakernel, 256, 0);
    if (per_cu < 1) per_cu = 1;
    if (per_cu > 2) per_cu = 2;
    grid_blocks = cus * per_cu;
  }
  Params p{};
  const float** ins = (const float**)&p;
  for (int i = 0; i < 19; ++i) ins[i] = (const float*)d_in[i];
  p.out = (float*)d_out;
  unsigned char* ws = (unsigned char*)d_ws;
  size_t off = 0;
  auto take = [&](size_t bytes) { unsigned char* q = ws + off; off += (bytes + 255) & ~(size_t)255; return q; };
  p.WinT = (u16*)take((size_t)4 * 5632 * 1024 * 2);
  p.WoaT = (u16*)take((size_t)4 * 1024 * 512 * 2);
  p.WogT = (u16*)take((size_t)4 * 1024 * 512 * 2);
  p.WoutT = (u16*)take((size_t)4 * 1024 * 1024 * 2);
  p.Xb = (u16*)take((size_t)MTOK * 1024 * 2);
  p.H = (u16*)take((size_t)MTOK * INW * 2);
  p.A1 = (u16*)take((size_t)MTOK * 512 * 2);
  p.A2 = (u16*)take((size_t)MTOK * 512 * 2);
  p.Mg = (u16*)take((size_t)MTOK * 1024 * 2);
  p.Xf = (float*)take((size_t)MTOK * 1024 * 4);
  p.Xpre = (float*)take((size_t)MTOK * 1024 * 4);
  p.rope = (float*)take((size_t)SEQ * 32 * 2 * 4);
  p.lam = (float*)take(256);
  p.counters = (int*)take(256);
#if MULTI_LAUNCH
  for (int ph = 0; ph < 21; ++ph) {
    p.ph_lo = ph; p.ph_hi = ph + 1;
    hipLaunchKernelGGL(fwd_megakernel, dim3(grid_blocks), dim3(256), 0, stream, p);
  }
#else
  p.ph_lo = 0; p.ph_hi = 21;
  void* args[] = {&p};
  hipError_t e = hipLaunchCooperativeKernel((void*)fwd_megakernel, dim3(grid_blocks), dim3(256), args, 0, stream);
  if (e != hipSuccess) fprintf(stderr, "cooperative launch failed: %s (grid %d)\n", hipGetErrorString(e), grid_blocks);
#endif
}
```

```cpp
#include <hip/hip_runtime.h>
#include <hip/hip_cooperative_groups.h>
#include <cstdio>
namespace cg = cooperative_groups;

#ifndef PROBE_REP
#define PROBE_REP -1
#endif
#ifndef MULTI_LAUNCH
#define MULTI_LAUNCH 0
#endif

#define DI __device__ __forceinline__
typedef unsigned short u16;
typedef __attribute__((ext_vector_type(8))) short bf16x8;
typedef __attribute__((ext_vector_type(4))) short s16x4;
typedef __attribute__((ext_vector_type(16))) float f32x16;
typedef __attribute__((ext_vector_type(2))) float f32x2;
typedef __attribute__((ext_vector_type(2))) __bf16 bf16x2_t;

constexpr int SEQ = 16384, MTOK = 17408, INW = 5632;
constexpr int C_K = 512, C_V = 1024, C_GA = 1536, C_U = 2048, C_VG = 2560, C_GG = 3072, C_MA = 3584, C_MB = 4608;
constexpr size_t OFF_KP = 17825792, OFF_VP = 51380224, OFF_KS = 84934656, OFF_VS = 87031808, OFF_GV = 89128960;
constexpr int SMEM_BYTES = 77824 + 64;
constexpr float ALPHA_RES = 1.681792830507429f;
constexpr float LN_EPS = 1e-5f;

struct Params {
  const float *x_prompt, *x_sample, *cache_k, *cache_v, *w_in, *w_oa, *w_og, *w_out;
  const float *lq1, *lk1, *lq2, *lk2, *subln_w, *sgu_g, *sgu_b, *w_s, *b_s, *ln_g, *ln_b;
  float* out;
  u16 *WinT, *WoaT, *WogT, *WoutT, *Xb, *H, *A1, *A2, *Mg;
  float *Xf, *Xpre, *rope, *lam;
  int* counters;
  unsigned* bar;
  int ph_lo, ph_hi;
};

DI unsigned pk(float a, float b) { f32x2 x = {a, b}; bf16x2_t y = __builtin_convertvector(x, bf16x2_t); return __builtin_bit_cast(unsigned, y); }
DI u16 f2bf(float a) { return (u16)(pk(a, 0.f) & 0xffffu); }
DI float bf2f(u16 h) { return __uint_as_float(((unsigned)h) << 16); }
DI float bflo(unsigned u) { return __uint_as_float(u << 16); }
DI float bfhi(unsigned u) { return __uint_as_float(u & 0xffff0000u); }
DI int tid() { int t = threadIdx.x; asm volatile("" : "+v"(t)); return t; }
DI int crow(int i, int hb) { return (i & 3) + 8 * (i >> 2) + 4 * hb; }
DI float sigmoidf_(float x) { return 1.f / (1.f + __expf(-x)); }
DI float siluf_(float x) { return x / (1.f + __expf(-x)); }
#define MFMA(a, b, c) __builtin_amdgcn_mfma_f32_32x32x16_bf16((a), (b), (c), 0, 0, 0)
typedef __attribute__((address_space(3))) s16x4 lds_s16x4;
typedef __attribute__((address_space(3))) unsigned lds_u32;
DI void glds16(const void* g, unsigned lds_base) {
  unsigned sv;
  asm volatile("s_mov_b32 %0, m0\n\ts_mov_b32 m0, %2\n\ts_nop 0\n\tglobal_load_lds_dwordx4 %1, off\n\ts_mov_b32 m0, %0" : "=&s"(sv) : "v"(g), "s"(lds_base) : "memory");
}
DI void glds16x8(const void* g0, const void* g1, const void* g2, const void* g3, const void* g4, const void* g5, const void* g6, const void* g7, unsigned lds_base) {
  unsigned sv;
  asm volatile("s_mov_b32 %0, m0\n\ts_mov_b32 m0, %9\n\ts_nop 0\n\tglobal_load_lds_dwordx4 %1, off\n\t"
               "s_add_u32 m0, m0, 0x1000\n\ts_nop 0\n\tglobal_load_lds_dwordx4 %2, off\n\t"
               "s_add_u32 m0, m0, 0x1000\n\ts_nop 0\n\tglobal_load_lds_dwordx4 %3, off\n\t"
               "s_add_u32 m0, m0, 0x1000\n\ts_nop 0\n\tglobal_load_lds_dwordx4 %4, off\n\t"
               "s_add_u32 m0, m0, 0x1000\n\ts_nop 0\n\tglobal_load_lds_dwordx4 %5, off\n\t"
               "s_add_u32 m0, m0, 0x1000\n\ts_nop 0\n\tglobal_load_lds_dwordx4 %6, off\n\t"
               "s_add_u32 m0, m0, 0x1000\n\ts_nop 0\n\tglobal_load_lds_dwordx4 %7, off\n\t"
               "s_add_u32 m0, m0, 0x1000\n\ts_nop 0\n\tglobal_load_lds_dwordx4 %8, off\n\t"
               "s_mov_b32 m0, %0"
               : "=&s"(sv) : "v"(g0), "v"(g1), "v"(g2), "v"(g3), "v"(g4), "v"(g5), "v"(g6), "v"(g7), "s"(lds_base) : "memory", "scc");
}
DI unsigned lds_addr(const void* p) { return (unsigned)(size_t)(__attribute__((address_space(3))) const unsigned char*)p; }
DI s16x4 tr_read(const u16* p) { return __builtin_amdgcn_ds_read_tr16_b64_v4i16((lds_s16x4*)p); }
DI bf16x8 cat8(s16x4 lo, s16x4 hi) { return __builtin_shufflevector(lo, hi, 0, 1, 2, 3, 4, 5, 6, 7); }


#define XB_TMO      128
#define XB_XCNT(j)  (256  + 64 * (j))
#define XB_XSUB(j)  (1280 + 64 * (j))
#define XB_XGEN(j)  (2304 + 64 * (j))
#define XB_TOP      3328
#define XB_TOPGEN   3392
#define XCD_BAR_WORDS 3456
#define XB_SPIN_CAP (1u << 24)
#define LAS __attribute__((address_space(3)))
DI unsigned xb_ld(unsigned* p)              { return __hip_atomic_load(p, __ATOMIC_RELAXED, __HIP_MEMORY_SCOPE_AGENT); }
DI unsigned xb_add(unsigned* p, unsigned v) { return __hip_atomic_fetch_add(p, v, __ATOMIC_RELAXED, __HIP_MEMORY_SCOPE_AGENT); }
DI unsigned xb_xcc_id() { return (unsigned)__builtin_amdgcn_s_getreg((3 << 11) | 20) & 0xFu; }
#define XB_SPIN(cond, bar) do { unsigned _sp = 0; while (cond) { __builtin_amdgcn_s_sleep(1); \
    if ((++_sp & 255u) == 0u) { if (xb_ld(&(bar)[XB_TMO])) break; if (_sp > XB_SPIN_CAP) { atomicAdd(&(bar)[XB_TMO], 1u); break; } } } } while (0)
struct XcdBarrier { unsigned* bar; unsigned x; volatile LAS unsigned* st; };
DI XcdBarrier xcd_barrier_post(unsigned* bar, volatile LAS unsigned* st) {
  XcdBarrier b; b.bar = bar; b.x = xb_xcc_id(); b.st = st;
  if (threadIdx.x == 0) (void)xb_add(&bar[XB_XCNT(b.x)], 1u);
  return b;
}
DI void xcd_barrier_complete(unsigned* bar, unsigned x, unsigned& nloc, unsigned& nx) {
  const unsigned G = gridDim.x * gridDim.y * gridDim.z;
  unsigned sum, cnt, mine, sp = 0u;
  for (;;) {
    sum = 0u; cnt = 0u; mine = 0u;
#pragma unroll
    for (unsigned j = 0; j < 16; ++j) { const unsigned c = xb_ld(&bar[XB_XCNT(j)]); sum += c; cnt += (c > 0u) ? 1u : 0u; mine = (j == x) ? c : mine; }
    if (sum == G) break;
    __builtin_amdgcn_s_sleep(1);
    if ((++sp & 255u) == 0u) { if (xb_ld(&bar[XB_TMO])) break; if (sp > XB_SPIN_CAP) { atomicAdd(&bar[XB_TMO], 1u); break; } }
  }
  nloc = mine > 0u ? mine : 1u; nx = cnt > 0u ? cnt : 1u;
}
DI void xcd_barrier(const XcdBarrier& b) {
  asm volatile("s_waitcnt vmcnt(0)" ::: "memory");
  __syncthreads();
  if (threadIdx.x == 0) {
    unsigned* bar = b.bar;
    __builtin_amdgcn_s_waitcnt(0);
    unsigned nloc = b.st[0], nx = b.st[1];
    if (nloc == 0u) { xcd_barrier_complete(bar, b.x, nloc, nx); b.st[0] = nloc; b.st[1] = nx; }
    const unsigned old = xb_add(&bar[XB_XSUB(b.x)], 1u);
    const unsigned gen = old / nloc;
    if (old + 1u == (gen + 1u) * nloc) {
      __builtin_amdgcn_fence(__ATOMIC_RELEASE, "agent");
      asm volatile("s_waitcnt vmcnt(0)" ::: "memory");
      const unsigned og = xb_add(&bar[XB_TOP], 1u);
      const unsigned tg = og / nx;
      if (og + 1u == (tg + 1u) * nx) xb_add(&bar[XB_TOPGEN], 1u);
      else XB_SPIN(xb_ld(&bar[XB_TOPGEN]) == tg, bar);
      __builtin_amdgcn_fence(__ATOMIC_ACQUIRE, "agent");
      xb_add(&bar[XB_XGEN(b.x)], 1u);
      asm volatile("s_waitcnt vmcnt(0)" ::: "memory");
    } else {
      XB_SPIN(xb_ld(&bar[XB_XGEN(b.x)]) == gen, bar);
      __builtin_amdgcn_fence(__ATOMIC_ACQUIRE, "agent");
      asm volatile("s_waitcnt vmcnt(0)" ::: "memory");
    }
  }
  __syncthreads();
}

DI void gemm_core(const u16* __restrict__ A, int lda, const u16* __restrict__ Bt, int ldb, int K,
                  f32x16 (&acc)[2][2], unsigned char* smem) {
  const int t = tid(), l = t & 63, w = t >> 6, wm = w >> 1, wn = w & 1, hb = l >> 5, r = l & 31;
  const int grow = w * 8 + (l >> 3);
  const int gch = (l & 7) ^ ((grow >> 1) & 7);
  const u16* ag = A + (size_t)grow * lda + gch * 8;
  const u16* bg = Bt + (size_t)grow * ldb + gch * 8;
  const unsigned lbase = __builtin_amdgcn_readfirstlane(lds_addr(smem) + w * 1024);
#define GM_STAGE(BUF, KO)                                                                                        \
  {                                                                                                              \
    const unsigned sa_ = lbase + (BUF) * 32768;                                                                  \
    _Pragma("unroll") for (int i = 0; i < 4; ++i) {                                                              \
      glds16(ag + (size_t)(32 * i) * lda + (KO), sa_ + i * 4096);                                                \
      glds16(bg + (size_t)(32 * i) * ldb + (KO), sa_ + 16384 + i * 4096);                                        \
    }                                                                                                            \
  }
  __syncthreads();
  GM_STAGE(0, 0)
  asm volatile("s_waitcnt vmcnt(0)" ::: "memory");
  __syncthreads();
  const int sw = (r >> 1) & 7;
  const int o0 = ((0 + hb) ^ sw) * 8, o1 = ((2 + hb) ^ sw) * 8, o2 = ((4 + hb) ^ sw) * 8, o3 = ((6 + hb) ^ sw) * 8;
  const int nk = K >> 6;
  for (int kt = 0; kt < nk; ++kt) {
    const int buf = kt & 1;
    if (kt + 1 < nk) GM_STAGE(buf ^ 1, (kt + 1) * 64)
    __builtin_amdgcn_sched_barrier(0);
    const u16* as = (const u16*)(smem + buf * 32768) + (wm * 64 + r) * 64;
    const u16* bs = (const u16*)(smem + buf * 32768 + 16384) + (wn * 64 + r) * 64;
#define GM_LDF(A0, A1, B0, B1, OFF)                                                       \
    A0 = *(const bf16x8*)(as + (OFF)); A1 = *(const bf16x8*)(as + 32 * 64 + (OFF));       \
    B0 = *(const bf16x8*)(bs + (OFF)); B1 = *(const bf16x8*)(bs + 32 * 64 + (OFF));
#define GM_MM(A0, A1, B0, B1)                                                             \
    acc[0][0] = MFMA(A0, B0, acc[0][0]); acc[0][1] = MFMA(A0, B1, acc[0][1]);             \
    acc[1][0] = MFMA(A1, B0, acc[1][0]); acc[1][1] = MFMA(A1, B1, acc[1][1]);
    {
      bf16x8 xa0, xa1, xb0, xb1, ya0, ya1, yb0, yb1;
      GM_LDF(xa0, xa1, xb0, xb1, o0)
      GM_LDF(ya0, ya1, yb0, yb1, o1)
      __builtin_amdgcn_sched_barrier(0);
      GM_MM(xa0, xa1, xb0, xb1)
      __builtin_amdgcn_sched_barrier(0);
      GM_LDF(xa0, xa1, xb0, xb1, o2)
      __builtin_amdgcn_sched_barrier(0);
      GM_MM(ya0, ya1, yb0, yb1)
      __builtin_amdgcn_sched_barrier(0);
      GM_LDF(ya0, ya1, yb0, yb1, o3)
      __builtin_amdgcn_sched_barrier(0);
      GM_MM(xa0, xa1, xb0, xb1)
      __builtin_amdgcn_sched_barrier(0);
      GM_MM(ya0, ya1, yb0, yb1)
    }
    asm volatile("s_waitcnt vmcnt(0)" ::: "memory");
    __syncthreads();
  }
}


DI void gemm_core_wide(const u16* __restrict__ A, int lda, const u16* __restrict__ Bt, int ldb, int K,
                       f32x16 (&acc)[2][4], unsigned char* smem) {
  const int t = tid(), l = t & 63, w = t >> 6, wm = w >> 1, wn = w & 1, hb = l >> 5, r = l & 31;
  const int grow = w * 16 + (l >> 2);
  const int gch = (l & 3) ^ ((l >> 4) & 3);
  const u16* ag = A + (size_t)grow * lda + gch * 8;
  const u16* bg = Bt + (size_t)grow * ldb + gch * 8;
  const unsigned lbase = __builtin_amdgcn_readfirstlane(lds_addr(smem) + w * 1024);
#define GW_STAGE(SLOT, KO)                                                                  \
  {                                                                                         \
    const unsigned sa_ = lbase + (SLOT) * 24576;                                            \
    glds16(ag + (KO), sa_);                                                                 \
    glds16(ag + (size_t)64 * lda + (KO), sa_ + 4096);                                       \
    glds16(bg + (KO), sa_ + 8192);                                                          \
    glds16(bg + (size_t)64 * ldb + (KO), sa_ + 8192 + 4096);                                \
    glds16(bg + (size_t)128 * ldb + (KO), sa_ + 8192 + 8192);                               \
    glds16(bg + (size_t)192 * ldb + (KO), sa_ + 8192 + 12288);                              \
  }
  __syncthreads();
  GW_STAGE(0, 0)
  GW_STAGE(1, 32)
  const int sw = (r >> 2) & 3;
  const int o0 = ((0 + hb) ^ sw) * 8, o1 = ((2 + hb) ^ sw) * 8;
  const int nk = K >> 5;
  int slot = 0;
  for (int kt = 0; kt < nk; ++kt) {
    if (kt + 1 < nk) asm volatile("s_waitcnt vmcnt(6)" ::: "memory"); else asm volatile("s_waitcnt vmcnt(0)" ::: "memory");
    __syncthreads();
    if (kt + 2 < nk) { const int s2 = slot >= 1 ? slot - 1 : 2; GW_STAGE(s2, (kt + 2) * 32) }
    __builtin_amdgcn_sched_barrier(0);
    const u16* as = (const u16*)(smem + slot * 24576) + (wm * 64 + r) * 32;
    const u16* bs = (const u16*)(smem + slot * 24576 + 8192) + (wn * 128 + r) * 32;
    {
      bf16x8 a0 = *(const bf16x8*)(as + o0), a1 = *(const bf16x8*)(as + 32 * 32 + o0);
      bf16x8 b0 = *(const bf16x8*)(bs + o0), b1 = *(const bf16x8*)(bs + 32 * 32 + o0);
      bf16x8 b2 = *(const bf16x8*)(bs + 64 * 32 + o0), b3 = *(const bf16x8*)(bs + 96 * 32 + o0);
      bf16x8 c0 = *(const bf16x8*)(as + o1), c1 = *(const bf16x8*)(as + 32 * 32 + o1);
      bf16x8 d0 = *(const bf16x8*)(bs + o1), d1 = *(const bf16x8*)(bs + 32 * 32 + o1);
      bf16x8 d2 = *(const bf16x8*)(bs + 64 * 32 + o1), d3 = *(const bf16x8*)(bs + 96 * 32 + o1);
      acc[0][0] = MFMA(a0, b0, acc[0][0]); acc[0][1] = MFMA(a0, b1, acc[0][1]); acc[0][2] = MFMA(a0, b2, acc[0][2]); acc[0][3] = MFMA(a0, b3, acc[0][3]);
      acc[1][0] = MFMA(a1, b0, acc[1][0]); acc[1][1] = MFMA(a1, b1, acc[1][1]); acc[1][2] = MFMA(a1, b2, acc[1][2]); acc[1][3] = MFMA(a1, b3, acc[1][3]);
      acc[0][0] = MFMA(c0, d0, acc[0][0]); acc[0][1] = MFMA(c0, d1, acc[0][1]); acc[0][2] = MFMA(c0, d2, acc[0][2]); acc[0][3] = MFMA(c0, d3, acc[0][3]);
      acc[1][0] = MFMA(c1, d0, acc[1][0]); acc[1][1] = MFMA(c1, d1, acc[1][1]); acc[1][2] = MFMA(c1, d2, acc[1][2]); acc[1][3] = MFMA(c1, d3, acc[1][3]);
    }
    slot = slot == 2 ? 0 : slot + 1;
  }
}

constexpr int CT_STRIDE = 132;
DI void acc_to_lds(const f32x16 (&acc)[2][2], unsigned char* smem) {
  const int t = tid(), l = t & 63, w = t >> 6, wm = w >> 1, wn = w & 1, hb = l >> 5, r = l & 31;
  float* base = (float*)smem + (wm * 64 + 4 * hb) * CT_STRIDE + wn * 64 + r;
#pragma unroll
  for (int tm = 0; tm < 2; ++tm)
#pragma unroll
    for (int tn = 0; tn < 2; ++tn)
#pragma unroll
      for (int i = 0; i < 16; ++i) base[(tm * 32 + (i & 3) + 8 * (i >> 2)) * CT_STRIDE + tn * 32] = acc[tm][tn][i];
}
typedef __attribute__((ext_vector_type(4))) float f32x4_t;
DI void nt_store4(float* p, const float4& v) { f32x4_t x = {v.x, v.y, v.z, v.w}; __builtin_nontemporal_store(x, (f32x4_t*)p); }
DI uint4 pack8(const float4& a, const float4& b) { return make_uint4(pk(a.x, a.y), pk(a.z, a.w), pk(b.x, b.y), pk(b.z, b.w)); }

DI void zero_acc(f32x16 (&acc)[2][2]) {
#pragma unroll
  for (int a = 0; a < 2; ++a)
#pragma unroll
    for (int b = 0; b < 2; ++b)
#pragma unroll
      for (int i = 0; i < 16; ++i) acc[a][b][i] = 0.f;
}

DI void transpose_tile(const float* __restrict__ src, u16* __restrict__ dst, int K, int N, int kt, int nt, unsigned char* smem) {
  float* tile = (float*)smem;
  const int t = tid();
  __syncthreads();
#pragma unroll
  for (int i = 0; i < 4; ++i) {
    const int row = (t >> 4) + 16 * i, c4 = (t & 15) * 4;
    const float4 v = *(const float4*)(src + (size_t)(kt * 64 + row) * N + nt * 64 + c4);
    tile[row * 65 + c4 + 0] = v.x; tile[row * 65 + c4 + 1] = v.y; tile[row * 65 + c4 + 2] = v.z; tile[row * 65 + c4 + 3] = v.w;
  }
  __syncthreads();
  const int n = t >> 2, kseg = (t & 3) * 16;
  unsigned o[8];
#pragma unroll
  for (int e = 0; e < 8; ++e) o[e] = pk(tile[(kseg + 2 * e) * 65 + n], tile[(kseg + 2 * e + 1) * 65 + n]);
  u16* d = dst + (size_t)(nt * 64 + n) * K + kt * 64 + kseg;
  *(uint4*)d = make_uint4(o[0], o[1], o[2], o[3]);
  *(uint4*)(d + 8) = make_uint4(o[4], o[5], o[6], o[7]);
}

__device__ const float ROPE_INV[32] = {1.0f, 0.749894202f, 0.562341332f, 0.421696514f, 0.316227764f, 0.237137377f, 0.177827939f, 0.133352146f, 0.100000001f, 0.0749894232f, 0.0562341325f, 0.0421696492f, 0.0316227749f, 0.0237137377f, 0.0177827943f, 0.013335214f, 0.00999999978f, 0.00749894232f, 0.00562341325f, 0.00421696482f, 0.00316227763f, 0.00237137382f, 0.00177827943f, 0.00133352145f, 0.00100000005f, 0.000749894185f, 0.000562341302f, 0.000421696517f, 0.000316227757f, 0.00023713737f, 0.00017782794f, 0.00013335215f};

DI void phase0(const Params& p, unsigned char* smem) {
  const int t = tid();
  if (blockIdx.x == 0) {
    if (t < 4) {
      float s1 = 0.f, s2 = 0.f;
      for (int i = 0; i < 64; ++i) { s1 += p.lq1[t * 64 + i] * p.lk1[t * 64 + i]; s2 += p.lq2[t * 64 + i] * p.lk2[t * 64 + i]; }
      const float li = t == 0 ? 0.2f : (t == 1 ? 0.355509067590969f : (t == 2 ? 0.470713018343584f : 0.556058204155641f));
      p.lam[t] = expf(s1) - expf(s2) + li;
      p.lam[4 + t] = li;
      p.counters[t] = 0; p.counters[4 + t] = 0;
    }
  }
  {
    float* tile = (float*)smem;
    const int trow = t >> 4, tc4 = (t & 15) * 4;
    const int tn = t >> 2, tkseg = (t & 3) * 16;
    const float* tsrc; u16* tdst; int tK, tN, tkt, tnt;
#define TR_DECODE(J)                                                                                                                       \
    if ((J) < 5632) { const int l_ = (J) / 1408, r_ = (J) % 1408; tsrc = p.w_in + (size_t)l_ * 1024 * 5632; tdst = p.WinT + (size_t)l_ * 5632 * 1024; tK = 1024; tN = 5632; tkt = r_ / 88; tnt = r_ % 88; } \
    else if ((J) < 6144) { const int q_ = (J) - 5632, l_ = q_ >> 7, r_ = q_ & 127; tsrc = p.w_oa + (size_t)l_ * 512 * 1024; tdst = p.WoaT + (size_t)l_ * 1024 * 512; tK = 512; tN = 1024; tkt = r_ >> 4; tnt = r_ & 15; } \
    else if ((J) < 6656) { const int q_ = (J) - 6144, l_ = q_ >> 7, r_ = q_ & 127; tsrc = p.w_og + (size_t)l_ * 512 * 1024; tdst = p.WogT + (size_t)l_ * 1024 * 512; tK = 512; tN = 1024; tkt = r_ >> 4; tnt = r_ & 15; } \
    else { const int q_ = (J) - 6656, l_ = q_ >> 8, r_ = q_ & 255; tsrc = p.w_out + (size_t)l_ * 1024 * 1024; tdst = p.WoutT + (size_t)l_ * 1024 * 1024; tK = 1024; tN = 1024; tkt = r_ >> 4; tnt = r_ & 15; }
#define TR_LOAD()                                                                                                                          \
    { const float* s_ = tsrc + (size_t)(tkt * 64 + trow) * tN + tnt * 64 + tc4;                                                            \
      f0 = *(const float4*)s_; f1 = *(const float4*)(s_ + (size_t)16 * tN); f2 = *(const float4*)(s_ + (size_t)32 * tN); f3 = *(const float4*)(s_ + (size_t)48 * tN); }
    float4 f0, f1, f2, f3;
    int j = blockIdx.x;
    if (j < 7680) { TR_DECODE(j) TR_LOAD() }
    for (; j < 7680; j += gridDim.x) {
      u16* d = tdst + (size_t)(tnt * 64 + tn) * tK + tkt * 64 + tkseg;
      __syncthreads();
      float* w0 = tile + trow * 65 + tc4;
      w0[0] = f0.x; w0[1] = f0.y; w0[2] = f0.z; w0[3] = f0.w;
      w0[16 * 65 + 0] = f1.x; w0[16 * 65 + 1] = f1.y; w0[16 * 65 + 2] = f1.z; w0[16 * 65 + 3] = f1.w;
      w0[32 * 65 + 0] = f2.x; w0[32 * 65 + 1] = f2.y; w0[32 * 65 + 2] = f2.z; w0[32 * 65 + 3] = f2.w;
      w0[48 * 65 + 0] = f3.x; w0[48 * 65 + 1] = f3.y; w0[48 * 65 + 2] = f3.z; w0[48 * 65 + 3] = f3.w;
      __syncthreads();
      const int jn = j + gridDim.x;
      if (jn < 7680) { TR_DECODE(jn) TR_LOAD() }
      unsigned o0 = pk(tile[(tkseg + 0) * 65 + tn], tile[(tkseg + 1) * 65 + tn]), o1 = pk(tile[(tkseg + 2) * 65 + tn], tile[(tkseg + 3) * 65 + tn]);
      unsigned o2 = pk(tile[(tkseg + 4) * 65 + tn], tile[(tkseg + 5) * 65 + tn]), o3 = pk(tile[(tkseg + 6) * 65 + tn], tile[(tkseg + 7) * 65 + tn]);
      unsigned o4 = pk(tile[(tkseg + 8) * 65 + tn], tile[(tkseg + 9) * 65 + tn]), o5 = pk(tile[(tkseg + 10) * 65 + tn], tile[(tkseg + 11) * 65 + tn]);
      unsigned o6 = pk(tile[(tkseg + 12) * 65 + tn], tile[(tkseg + 13) * 65 + tn]), o7 = pk(tile[(tkseg + 14) * 65 + tn], tile[(tkseg + 15) * 65 + tn]);
      *(uint4*)d = make_uint4(o0, o1, o2, o3);
      *(uint4*)(d + 8) = make_uint4(o4, o5, o6, o7);
    }
  }
  const int gt = blockIdx.x * 256 + t, gs = gridDim.x * 256;
  for (int idx = gt; idx < MTOK * 128; idx += gs) {
    const int row = idx >> 7, c8 = (idx & 127) * 8;
    const float* src = row < SEQ ? p.x_prompt + (size_t)row * 1024 + c8 : p.x_sample + (size_t)(row - SEQ) * 1024 + c8;
    const float4 a = *(const float4*)src, b = *(const float4*)(src + 4);
    *(uint4*)(p.Xb + (size_t)row * 1024 + c8) = make_uint4(pk(a.x, a.y), pk(a.z, a.w), pk(b.x, b.y), pk(b.z, b.w));
  }
  for (int idx = gt; idx < SEQ * 32; idx += gs) {
    const int pos = idx >> 5, j = idx & 31;
    const float inv = ROPE_INV[j];
    const float ang = (float)pos * inv;
    double rev = (double)ang * 0.15915494309189535;
    rev -= rint(rev);
    const float rf = (float)rev;
    p.rope[2 * idx] = __builtin_amdgcn_cosf(rf);
    p.rope[2 * idx + 1] = __builtin_amdgcn_sinf(rf);
  }
}

constexpr int CW_STRIDE = 260;
DI void phaseA_tile(const Params& p, int layer, int mt, int nt, unsigned char* smem) {
  f32x16 acc[2][4];
#pragma unroll
  for (int a = 0; a < 2; ++a)
#pragma unroll
    for (int b = 0; b < 4; ++b)
#pragma unroll
      for (int i = 0; i < 16; ++i) acc[a][b][i] = 0.f;
  gemm_core_wide(p.Xb + (size_t)mt * 128 * 1024, 1024, p.WinT + ((size_t)layer * 5632 + nt * 256) * 1024, 1024, 1024, acc, smem);
  const int t = tid(), l = t & 63, w = t >> 6, wm = w >> 1, wn = w & 1, hb = l >> 5, r = l & 31;
  const int n0 = nt * 256, seg = n0 >> 9;
  const bool samp = mt >= 128;
  float* ct = (float*)smem;
#pragma unroll
  for (int h = 0; h < 2; ++h) {
    __syncthreads();
    if (wm == h) {
      float* base = ct + (4 * hb) * CW_STRIDE + wn * 128 + r;
#pragma unroll
      for (int tm = 0; tm < 2; ++tm)
#pragma unroll
        for (int tn = 0; tn < 4; ++tn)
#pragma unroll
          for (int i = 0; i < 16; ++i) base[(tm * 32 + (i & 3) + 8 * (i >> 2)) * CW_STRIDE + tn * 32] = acc[tm][tn][i];
    }
    __syncthreads();
    if (seg <= 1) {
      const int j = t & 15, head = j >> 2, c8 = (j & 3) * 8;
#pragma unroll
      for (int i = 0; i < 4; ++i) {
        const int rl = (t >> 4) + 16 * i;
        const int row = mt * 128 + h * 64 + rl;
        const int pos = samp ? 1024 + ((row - SEQ) & 31) : row;
        const float* cp = ct + rl * CW_STRIDE + head * 64 + c8;
        const float4 xa0 = *(const float4*)cp, xa1 = *(const float4*)(cp + 4);
        const float4 xb0 = *(const float4*)(cp + 32), xb1 = *(const float4*)(cp + 36);
        const float4* rp = (const float4*)(p.rope + ((size_t)pos * 32 + c8) * 2);
        const float4 r0 = rp[0], r1 = rp[1], r2 = rp[2], r3 = rp[3];
        float4 ya0, ya1, yb0, yb1;
        ya0.x = xa0.x * r0.x - xb0.x * r0.y; yb0.x = xb0.x * r0.x + xa0.x * r0.y;
        ya0.y = xa0.y * r0.z - xb0.y * r0.w; yb0.y = xb0.y * r0.z + xa0.y * r0.w;
        ya0.z = xa0.z * r1.x - xb0.z * r1.y; yb0.z = xb0.z * r1.x + xa0.z * r1.y;
        ya0.w = xa0.w * r1.z - xb0.w * r1.w; yb0.w = xb0.w * r1.z + xa0.w * r1.w;
        ya1.x = xa1.x * r2.x - xb1.x * r2.y; yb1.x = xb1.x * r2.x + xa1.x * r2.y;
        ya1.y = xa1.y * r2.z - xb1.y * r2.w; yb1.y = xb1.y * r2.z + xa1.y * r2.w;
        ya1.z = xa1.z * r3.x - xb1.z * r3.y; yb1.z = xb1.z * r3.x + xa1.z * r3.y;
        ya1.w = xa1.w * r3.z - xb1.w * r3.w; yb1.w = xb1.w * r3.z + xa1.w * r3.w;
        const int col = n0 + head * 64 + c8;
        u16* hp = p.H + (size_t)row * INW + col;
        if (seg == 0) {
          const float qs = 0.125f * 1.4426950408889634f;
          *(uint4*)hp = make_uint4(pk(ya0.x * qs, ya0.y * qs), pk(ya0.z * qs, ya0.w * qs), pk(ya1.x * qs, ya1.y * qs), pk(ya1.z * qs, ya1.w * qs));
          *(uint4*)(hp + 32) = make_uint4(pk(yb0.x * qs, yb0.y * qs), pk(yb0.z * qs, yb0.w * qs), pk(yb1.x * qs, yb1.y * qs), pk(yb1.z * qs, yb1.w * qs));
        } else {
          *(uint4*)hp = pack8(ya0, ya1);
          *(uint4*)(hp + 32) = pack8(yb0, yb1);
        }
        if (seg == 1) {
          float* o = samp ? p.out + OFF_KS + ((size_t)layer * 1024 + (row - SEQ)) * 512 + (col - C_K)
                          : p.out + OFF_KP + ((size_t)layer * SEQ + row) * 512 + (col - C_K);
          nt_store4(o, ya0); nt_store4(o + 4, ya1); nt_store4(o + 32, yb0); nt_store4(o + 36, yb1);
        }
      }
    } else {
      const int c8 = (t & 31) * 8;
#pragma unroll
      for (int i = 0; i < 8; ++i) {
        const int rl = (t >> 5) + 8 * i;
        const int row = mt * 128 + h * 64 + rl;
        const float* cp = ct + rl * CW_STRIDE + c8;
        const float4 v0 = *(const float4*)cp, v1 = *(const float4*)(cp + 4);
        const int col = n0 + c8;
        *(uint4*)(p.H + (size_t)row * INW + col) = pack8(v0, v1);
        if (seg == 2) {
          float* o = samp ? p.out + OFF_VS + ((size_t)layer * 1024 + (row - SEQ)) * 512 + (col - C_V)
                          : p.out + OFF_VP + ((size_t)layer * SEQ + row) * 512 + (col - C_V);
          nt_store4(o, v0); nt_store4(o + 4, v1);
        }
      }
    }
  }
}

constexpr int KS_STRIDE = 72;
constexpr int VS_STRIDE = 160;
constexpr int ST_K = 2 * 64 * KS_STRIDE;
constexpr int ST_BYTES = ST_K * 2 + 64 * VS_STRIDE * 2;

#define LOADV(D0, D1, D2, D3, G)                                                             \
  {                                                                                          \
    const u16* vk_ = vp + ((G) * 16) * VROW;                                                 \
    D0 = cat8(tr_read(vk_ + vo0), tr_read(vk_ + 8 * VROW + vo0));                            \
    D1 = cat8(tr_read(vk_ + vo1), tr_read(vk_ + 8 * VROW + vo1));                            \
    D2 = cat8(tr_read(vk_ + vo2), tr_read(vk_ + 8 * VROW + vo2));                            \
    D3 = cat8(tr_read(vk_ + vo3), tr_read(vk_ + 8 * VROW + vo3));                            \
  }
#define PACKP(S, U) __builtin_bit_cast(bf16x8, make_uint4(pk(S[8 * (U) + 0], S[8 * (U) + 1]), pk(S[8 * (U) + 2], S[8 * (U) + 3]), pk(S[8 * (U) + 4], S[8 * (U) + 5]), pk(S[8 * (U) + 6], S[8 * (U) + 7])))
#define PVMFMA(D0, D1, D2, D3, PB) { O[0] = MFMA(D0, PB, O[0]); O[1] = MFMA(D1, PB, O[1]); O[2] = MFMA(D2, PB, O[2]); O[3] = MFMA(D3, PB, O[3]); }
template <bool SWZ>
DI void attn_compute(const u16* Kb, const u16* Vb, const bf16x8 (&qf)[4], f32x16 (&O)[4], f32x16& Mneg, float& m_run, float& l_run, bool two, int s) {
  const int l = tid() & 63, hb = l >> 5, r = l & 31;
  f32x16 S0, S1;
  constexpr int KROW = SWZ ? 64 : KS_STRIDE, VROW = SWZ ? 128 : VS_STRIDE;
  const int q4 = (l & 15) >> 2, p4 = l & 3, blk = (l >> 4) & 1;
  const int ksw = SWZ ? ((r >> 1) & 7) : 0;
  const u16* kp = Kb + (s * 64 + r) * KROW;
  const int ko0 = ((0 + hb) ^ ksw) * 8, ko1 = ((2 + hb) ^ ksw) * 8, ko2 = ((4 + hb) ^ ksw) * 8, ko3 = ((6 + hb) ^ ksw) * 8;
  const u16* vp = Vb + (4 * hb + q4) * VROW + blk * 16 + p4 * 4;
  const int vsw = SWZ ? q4 : 0;
  const int vo0 = (0 ^ vsw) * 32, vo1 = (1 ^ vsw) * 32, vo2 = (2 ^ vsw) * 32, vo3 = (3 ^ vsw) * 32;
  bf16x8 ka0, ka1, ka2, ka3, kb0, kb1, kb2, kb3, va0, va1, va2, va3, vb0, vb1, vb2, vb3;
  ka0 = *(const bf16x8*)(kp + ko0); ka1 = *(const bf16x8*)(kp + ko1); ka2 = *(const bf16x8*)(kp + ko2); ka3 = *(const bf16x8*)(kp + ko3);
  if (two) {
    kb0 = *(const bf16x8*)(kp + 32 * KROW + ko0); kb1 = *(const bf16x8*)(kp + 32 * KROW + ko1);
    kb2 = *(const bf16x8*)(kp + 32 * KROW + ko2); kb3 = *(const bf16x8*)(kp + 32 * KROW + ko3);
  }
  LOADV(va0, va1, va2, va3, 0)
  __builtin_amdgcn_sched_barrier(0);
  S0 = MFMA(ka0, qf[0], Mneg); S0 = MFMA(ka1, qf[1], S0); S0 = MFMA(ka2, qf[2], S0); S0 = MFMA(ka3, qf[3], S0);
  if (two) { S1 = MFMA(kb0, qf[0], Mneg); S1 = MFMA(kb1, qf[1], S1); S1 = MFMA(kb2, qf[2], S1); S1 = MFMA(kb3, qf[3], S1); }
  float ls = 0.f;
#pragma unroll
  for (int i = 0; i < 16; ++i) { S0[i] = __builtin_amdgcn_exp2f(S0[i]); ls += S0[i]; }
  if (two) {
#pragma unroll
    for (int i = 0; i < 16; ++i) { S1[i] = __builtin_amdgcn_exp2f(S1[i]); ls += S1[i]; }
  }
  if (__any(!(ls <= 4194304.f))) {
    bf16x8 ra0 = *(const bf16x8*)(kp + ko0), ra1 = *(const bf16x8*)(kp + ko1), ra2 = *(const bf16x8*)(kp + ko2), ra3 = *(const bf16x8*)(kp + ko3);
#pragma unroll
    for (int i = 0; i < 16; ++i) { S0[i] = 0.f; S1[i] = 0.f; }
    S0 = MFMA(ra0, qf[0], S0); S0 = MFMA(ra1, qf[1], S0); S0 = MFMA(ra2, qf[2], S0); S0 = MFMA(ra3, qf[3], S0);
    if (two) {
      ra0 = *(const bf16x8*)(kp + 32 * KROW + ko0); ra1 = *(const bf16x8*)(kp + 32 * KROW + ko1);
      ra2 = *(const bf16x8*)(kp + 32 * KROW + ko2); ra3 = *(const bf16x8*)(kp + 32 * KROW + ko3);
      S1 = MFMA(ra0, qf[0], S1); S1 = MFMA(ra1, qf[1], S1); S1 = MFMA(ra2, qf[2], S1); S1 = MFMA(ra3, qf[3], S1);
    }
    float mx = S0[0];
#pragma unroll
    for (int i = 1; i < 16; ++i) mx = fmaxf(mx, S0[i]);
    if (two) {
#pragma unroll
      for (int i = 0; i < 16; ++i) mx = fmaxf(mx, S1[i]);
    }
    mx = fmaxf(mx, __shfl_xor(mx, 32));
    const float m_new = fmaxf(m_run, mx);
    const float alpha = __builtin_amdgcn_exp2f(m_run - m_new);
    m_run = m_new;
#pragma unroll
    for (int i = 0; i < 16; ++i) Mneg[i] = -m_new;
    l_run *= alpha;
#pragma unroll
    for (int dt = 0; dt < 4; ++dt)
#pragma unroll
      for (int i = 0; i < 16; ++i) O[dt][i] *= alpha;
    ls = 0.f;
#pragma unroll
    for (int i = 0; i < 16; ++i) { S0[i] = __builtin_amdgcn_exp2f(S0[i] - m_new); ls += S0[i]; }
    if (two) {
#pragma unroll
      for (int i = 0; i < 16; ++i) { S1[i] = __builtin_amdgcn_exp2f(S1[i] - m_new); ls += S1[i]; }
    }
  }
  l_run += ls;
  {
    const bf16x8 pb0 = PACKP(S0, 0);
    __builtin_amdgcn_sched_barrier(0);
    LOADV(vb0, vb1, vb2, vb3, 1)
    __builtin_amdgcn_sched_barrier(0);
    PVMFMA(va0, va1, va2, va3, pb0)
    const bf16x8 pb1 = PACKP(S0, 1);
    __builtin_amdgcn_sched_barrier(0);
    if (two) LOADV(va0, va1, va2, va3, 2)
    __builtin_amdgcn_sched_barrier(0);
    PVMFMA(vb0, vb1, vb2, vb3, pb1)
    if (two) {
      const bf16x8 pb2 = PACKP(S1, 0);
      __builtin_amdgcn_sched_barrier(0);
      LOADV(vb0, vb1, vb2, vb3, 3)
      __builtin_amdgcn_sched_barrier(0);
      PVMFMA(va0, va1, va2, va3, pb2)
      const bf16x8 pb3 = PACKP(S1, 1);
      __builtin_amdgcn_sched_barrier(0);
      PVMFMA(vb0, vb1, vb2, vb3, pb3)
    }
  }
}

template <bool SAMPLE>
DI void attn_item(const Params& p, int layer, int a, int h, unsigned char* smem) {
  const int t = tid(), l = t & 63, w = t >> 6, rg = w & 1, s = w >> 1, hb = l >> 5, r = l & 31;
  const int hh = 2 * h + s;
  const int qrow0 = SAMPLE ? SEQ + a * 32 : a * 64 + rg * 32;
  const bool active = SAMPLE ? (rg == 0) : true;
  const u16* H = p.H;
  bf16x8 qf[4];
  {
    const u16* qp = H + (size_t)(qrow0 + r) * INW + hh * 64 + hb * 8;
#pragma unroll
    for (int ks = 0; ks < 4; ++ks) qf[ks] = *(const bf16x8*)(qp + ks * 16);
  }
  f32x16 O[4];
#pragma unroll
  for (int dt = 0; dt < 4; ++dt)
#pragma unroll
    for (int i = 0; i < 16; ++i) O[dt][i] = 0.f;
  float m_run = -1e30f, l_run = 0.f;
  f32x16 Mneg;
#pragma unroll
  for (int i = 0; i < 16; ++i) Mneg[i] = 1e30f;
  u16* sm = (u16*)smem;

  __syncthreads();
  if (!SAMPLE) {
    const int ntiles = a + 1;
    const u16* kg = H + C_K + (2 * h) * 64;
    const u16* vg = H + C_V + h * 128;
    const int krow = w * 8 + (l >> 3);
    const u16* kq = kg + (size_t)krow * INW + ((l & 7) ^ ((krow >> 1) & 7)) * 8;
    const int vrow = w * 4 + (l >> 4);
    const u16* vq = vg + (size_t)vrow * INW + ((l & 15) ^ (((l >> 4) & 3) << 2)) * 8;
    const unsigned lb = __builtin_amdgcn_readfirstlane(lds_addr(smem) + w * 1024);
#define ATT_STAGE(BUF, KT)                                                                                \
    {                                                                                                     \
      const unsigned sb_ = lb + (BUF) * 32768;                                                            \
      const u16* k_ = kq + (size_t)(KT) * 64 * INW;                                                       \
      const u16* v_ = vq + (size_t)(KT) * 64 * INW;                                                       \
      glds16x8(k_, k_ + (size_t)32 * INW, k_ + 64, k_ + (size_t)32 * INW + 64,                              \
               v_, v_ + (size_t)16 * INW, v_ + (size_t)32 * INW, v_ + (size_t)48 * INW, sb_);                 \
    }
    ATT_STAGE(0, 0)
    asm volatile("s_waitcnt vmcnt(0)" ::: "memory");
    __syncthreads();
    for (int kt = 0; kt < ntiles; ++kt) {
      const int buf = kt & 1;
      if (kt + 1 < ntiles) ATT_STAGE(buf ^ 1, kt + 1)
      __builtin_amdgcn_sched_barrier(0);
      const u16* kb = sm + buf * 16384;
      attn_compute<true>(kb, kb + 8192, qf, O, Mneg, m_run, l_run, true, s);
      asm volatile("s_waitcnt vmcnt(0)" ::: "memory");
      __syncthreads();
    }
  } else {
    const float* ck = p.cache_k + ((size_t)(layer * 32 + a) * 1024) * 512 + (2 * h) * 64;
    const float* cv = p.cache_v + ((size_t)(layer * 32 + a) * 1024) * 512 + h * 128;
    for (int j = 0; j < 9; ++j) {
      for (int g = 0; g < 2; ++g) {
        const int kt = 2 * j + g;
        u16* kb = sm + g * (ST_BYTES / 2);
        u16* vb = kb + ST_K;
        if (kt < 16) {
#pragma unroll 2
          for (int i = 0; i < 8; ++i) {
            const int cc = t + 256 * i;
            const int sh = cc >> 10, key = (cc >> 4) & 63, ch = cc & 15;
            const float4 v = *(const float4*)(ck + (size_t)(kt * 64 + key) * 512 + sh * 64 + ch * 4);
            *(uint2*)(kb + (sh * 64 + key) * KS_STRIDE + ch * 4) = make_uint2(pk(v.x, v.y), pk(v.z, v.w));
            const int vkey = cc >> 5, vch = cc & 31;
            const float4 u = *(const float4*)(cv + (size_t)(kt * 64 + vkey) * 512 + vch * 4);
            *(uint2*)(vb + vkey * VS_STRIDE + vch * 4) = make_uint2(pk(u.x, u.y), pk(u.z, u.w));
          }
        } else if (kt == 16) {
          const u16* kg = H + (size_t)(SEQ + a * 32) * INW + C_K + (2 * h) * 64;
          const u16* vg = H + (size_t)(SEQ + a * 32) * INW + C_V + h * 128;
#pragma unroll
          for (int i = 0; i < 2; ++i) {
            const int cc = t + 256 * i;
            const int sh = cc >> 8, key = (cc >> 3) & 31, ch = cc & 7;
            *(uint4*)(kb + (sh * 64 + key) * KS_STRIDE + ch * 8) = *(const uint4*)(kg + (size_t)key * INW + sh * 64 + ch * 8);
            const int vkey = cc >> 4, vch = cc & 15;
            *(uint4*)(vb + vkey * VS_STRIDE + vch * 8) = *(const uint4*)(vg + (size_t)vkey * INW + vch * 8);
          }
        }
      }
      __syncthreads();
      {
        const int kt = 2 * j + rg;
        const u16* kb = sm + rg * (ST_BYTES / 2);
        if (kt <= 16) attn_compute<false>(kb, kb + ST_K, qf, O, Mneg, m_run, l_run, kt < 16, s);
      }
      __syncthreads();
    }
    float* mgO = (float*)smem;
    float* mgML = (float*)(smem + 32768);
    if (rg == 1) {
#pragma unroll
      for (int dt = 0; dt < 4; ++dt)
#pragma unroll
        for (int i = 0; i < 16; ++i) mgO[(s * 128 + dt * 32 + crow(i, hb)) * 32 + r] = O[dt][i];
      mgML[(s * 64 + l) * 2] = m_run; mgML[(s * 64 + l) * 2 + 1] = l_run;
    }
    __syncthreads();
    if (rg == 0) {
      const float m1 = mgML[(s * 64 + l) * 2], l1 = mgML[(s * 64 + l) * 2 + 1];
      const float mm = fmaxf(m_run, m1);
      const float a0 = __builtin_amdgcn_exp2f(m_run - mm), a1 = __builtin_amdgcn_exp2f(m1 - mm);
#pragma unroll
      for (int dt = 0; dt < 4; ++dt)
#pragma unroll
        for (int i = 0; i < 16; ++i) O[dt][i] = O[dt][i] * a0 + mgO[(s * 128 + dt * 32 + crow(i, hb)) * 32 + r] * a1;
      l_run = l_run * a0 + l1 * a1;
      m_run = mm;
    }
    __syncthreads();
  }
  const int te = tid(), le = te & 63, re = le & 31, hbe = le >> 5, rge = (te >> 6) & 1, se = te >> 7;
  const bool acte = SAMPLE ? (rge == 0) : true;
  float lt = l_run + __shfl_xor(l_run, 32);
  const float inv_l = 1.f / lt;
  float* ex = (float*)smem;
  if (se == 1 && acte) {
#pragma unroll
    for (int dt = 0; dt < 4; ++dt)
#pragma unroll
      for (int i = 0; i < 16; ++i) ex[(rge * 128 + dt * 32 + crow(i, hbe)) * 32 + re] = O[dt][i] * inv_l;
  }
  __syncthreads();
  if (se == 0 && acte) {
    const float lam = __hip_atomic_load(p.lam + layer, __ATOMIC_RELAXED, __HIP_MEMORY_SCOPE_AGENT);
    const float li = __hip_atomic_load(p.lam + 4 + layer, __ATOMIC_RELAXED, __HIP_MEMORY_SCOPE_AGENT);
    float ss = 0.f;
#pragma unroll
    for (int dt = 0; dt < 4; ++dt)
#pragma unroll
      for (int i = 0; i < 16; ++i) {
        const float o = O[dt][i] * inv_l - lam * ex[(rge * 128 + dt * 32 + crow(i, hbe)) * 32 + re];
        O[dt][i] = o; ss += o * o;
      }
    ss += __shfl_xor(ss, 32);
    const float rs = rsqrtf(ss * (1.f / 128.f) + LN_EPS) * (1.f - li);
    const int row = (SAMPLE ? SEQ + a * 32 : a * 64 + rge * 32) + re;
    const u16* gp = H + (size_t)row * INW + C_GA + h * 128;
    u16* op = p.A1 + (size_t)row * 512 + h * 128;
    const float* sw = p.subln_w + layer * 128;
#pragma unroll
    for (int dt = 0; dt < 4; ++dt)
#pragma unroll
      for (int g4 = 0; g4 < 4; ++g4) {
        const int d = dt * 32 + 8 * g4 + 4 * hbe;
        const uint2 gv = *(const uint2*)(gp + d);
        const float4 wv = *(const float4*)(sw + d);
        const float y0 = O[dt][4 * g4 + 0] * rs * wv.x * siluf_(bflo(gv.x));
        const float y1 = O[dt][4 * g4 + 1] * rs * wv.y * siluf_(bfhi(gv.x));
        const float y2 = O[dt][4 * g4 + 2] * rs * wv.z * siluf_(bflo(gv.y));
        const float y3 = O[dt][4 * g4 + 3] * rs * wv.w * siluf_(bfhi(gv.y));
        *(uint2*)(op + d) = make_uint2(pk(y0, y1), pk(y2, y3));
      }
  }
}

DI void sgu_item(const Params& p, int layer, int chunk, int g, unsigned char* smem) {
  const int t = tid(), l = t & 63, w = t >> 6, wm = w >> 1, wn = w & 1, hb = l >> 5, r = l & 31;
  const int m0 = chunk * 128;
  const bool samp = chunk >= 128;
  u16* Asg = (u16*)smem;
  u16* Bsg = Asg + 128 * 72;
  float* st = (float*)(smem + 38912);
  const u16* H = p.H;
  __syncthreads();
  for (int rr = 0; rr < 32; ++rr) {
    const int row = w * 32 + rr;
    const uint4 v = *(const uint4*)(H + (size_t)(m0 + row) * INW + C_VG + l * 8);
    float x[8] = {bflo(v.x), bfhi(v.x), bflo(v.y), bfhi(v.y), bflo(v.z), bfhi(v.z), bflo(v.w), bfhi(v.w)};
    float s1 = 0.f, s2 = 0.f;
#pragma unroll
    for (int e = 0; e < 8; ++e) { s1 += x[e]; s2 += x[e] * x[e]; }
#pragma unroll
    for (int o = 32; o >= 1; o >>= 1) { s1 += __shfl_xor(s1, o); s2 += __shfl_xor(s2, o); }
    if (l == 0) {
      const float mean = s1 * (1.f / 512.f);
      const float var = fmaxf(s2 * (1.f / 512.f) - mean * mean, 0.f);
      st[row] = mean; st[128 + row] = rsqrtf(var + LN_EPS);
    }
  }
  __syncthreads();
  uint4 puu[8], pgg[8];
#pragma unroll
  for (int i = 0; i < 8; ++i) {
    const u16* hp = H + (size_t)(m0 + (t >> 4) + 16 * i) * INW + g * 128 + (t & 15) * 8;
    puu[i] = *(const uint4*)(hp + C_U); pgg[i] = *(const uint4*)(hp + C_GG);
  }
  f32x16 acc[2][2];
  zero_acc(acc);
  const float* Wg = p.w_s + ((size_t)(layer * 4 + g) * 128) * 128;
  const float* gam = p.sgu_g + layer * 512 + g * 128;
  const float* bet = p.sgu_b + layer * 512 + g * 128;
  const int q4 = (l & 15) >> 2, p4 = l & 3, blk = (l >> 4) & 1;
  for (int kh = 0; kh < 2; ++kh) {
#pragma unroll
    for (int i8 = 0; i8 < 8; ++i8) {
      const int cc = t + 256 * i8;
      const int i = cc >> 4, j4 = (cc & 15) * 4, j = kh * 64 + j4;
      float4 v;
      float e0, e1, e2, e3;
      if (!samp) {
        v = *(const float4*)(Wg + i * 128 + j);
        e0 = (j + 0 <= i) ? v.x : 0.f; e1 = (j + 1 <= i) ? v.y : 0.f; e2 = (j + 2 <= i) ? v.z : 0.f; e3 = (j + 3 <= i) ? v.w : 0.f;
      } else {
        const int i32 = i & 31, j32 = j & 31;
        v = *(const float4*)(Wg + i32 * 128 + j32);
        const bool same = (i >> 5) == (j >> 5);
        e0 = (same && j32 + 0 <= i32) ? v.x : 0.f; e1 = (same && j32 + 1 <= i32) ? v.y : 0.f;
        e2 = (same && j32 + 2 <= i32) ? v.z : 0.f; e3 = (same && j32 + 3 <= i32) ? v.w : 0.f;
      }
      *(uint2*)(Asg + i * 72 + j4) = make_uint2(pk(e0, e1), pk(e2, e3));
    }
#pragma unroll
    for (int i4 = 0; i4 < 4; ++i4) {
      const int cc = t + 256 * i4;
      const int jj = cc >> 4, dc = (cc & 15) * 8;
      const int jrow = kh * 64 + jj;
      const uint4 v = *(const uint4*)(H + (size_t)(m0 + jrow) * INW + C_VG + g * 128 + dc);
      const float mean = st[jrow], rstd = st[128 + jrow];
      const float4 g0 = *(const float4*)(gam + dc), g1 = *(const float4*)(gam + dc + 4);
      const float4 b0 = *(const float4*)(bet + dc), b1 = *(const float4*)(bet + dc + 4);
      const float y0 = (bflo(v.x) - mean) * rstd * g0.x + b0.x, y1 = (bfhi(v.x) - mean) * rstd * g0.y + b0.y;
      const float y2 = (bflo(v.y) - mean) * rstd * g0.z + b0.z, y3 = (bfhi(v.y) - mean) * rstd * g0.w + b0.w;
      const float y4 = (bflo(v.z) - mean) * rstd * g1.x + b1.x, y5 = (bfhi(v.z) - mean) * rstd * g1.y + b1.y;
      const float y6 = (bflo(v.w) - mean) * rstd * g1.z + b1.z, y7 = (bfhi(v.w) - mean) * rstd * g1.w + b1.w;
      *(uint4*)(Bsg + jj * VS_STRIDE + dc) = make_uint4(pk(y0, y1), pk(y2, y3), pk(y4, y5), pk(y6, y7));
      if (samp) {
        float* o = p.out + OFF_GV + ((size_t)layer * 1024 + (m0 - SEQ) + jrow) * 512 + g * 128 + dc;
        *(float4*)o = make_float4(y0, y1, y2, y3);
        *(float4*)(o + 4) = make_float4(y4, y5, y6, y7);
      }
    }
    __syncthreads();
    const u16* as = Asg + (wm * 64 + r) * 72 + hb * 8;
    const u16* bs = Bsg + (8 * hb + q4) * VS_STRIDE + wn * 64 + blk * 16 + p4 * 4;
#pragma unroll
    for (int ks = 0; ks < 4; ++ks) {
      bf16x8 a0 = *(const bf16x8*)(as + ks * 16), a1 = *(const bf16x8*)(as + 32 * 72 + ks * 16);
      const u16* bk = bs + ks * 16 * VS_STRIDE;
      bf16x8 b0 = cat8(tr_read(bk), tr_read(bk + 4 * VS_STRIDE));
      bf16x8 b1 = cat8(tr_read(bk + 32), tr_read(bk + 4 * VS_STRIDE + 32));
      acc[0][0] = MFMA(a0, b0, acc[0][0]); acc[0][1] = MFMA(a0, b1, acc[0][1]);
      acc[1][0] = MFMA(a1, b0, acc[1][0]); acc[1][1] = MFMA(a1, b1, acc[1][1]);
    }
    __syncthreads();
  }
  const float* bsp = p.b_s + (size_t)(layer * 4 + g) * 128;
  acc_to_lds(acc, smem);
  __syncthreads();
  {
    const float* ct = (const float*)smem;
    const int c8 = (t & 15) * 8;
#pragma unroll
    for (int i = 0; i < 8; ++i) {
      const int rl = (t >> 4) + 16 * i;
      const int row = m0 + rl;
      const float* cp = ct + rl * CT_STRIDE + c8;
      const float4 v0 = *(const float4*)cp, v1 = *(const float4*)(cp + 4);
      const float bias = bsp[samp ? (rl & 31) : rl];
      const uint4 uu = puu[i], gg = pgg[i];
      float4 o0, o1;
      o0.x = (v0.x + bias) * bflo(uu.x) * siluf_(bflo(gg.x)); o0.y = (v0.y + bias) * bfhi(uu.x) * siluf_(bfhi(gg.x));
      o0.z = (v0.z + bias) * bflo(uu.y) * siluf_(bflo(gg.y)); o0.w = (v0.w + bias) * bfhi(uu.y) * siluf_(bfhi(gg.y));
      o1.x = (v1.x + bias) * bflo(uu.z) * siluf_(bflo(gg.z)); o1.y = (v1.y + bias) * bfhi(uu.z) * siluf_(bfhi(gg.z));
      o1.z = (v1.z + bias) * bflo(uu.w) * siluf_(bflo(gg.w)); o1.w = (v1.w + bias) * bfhi(uu.w) * siluf_(bfhi(gg.w));
      *(uint4*)(p.A2 + (size_t)row * 512 + g * 128 + c8) = pack8(o0, o1);
    }
  }
}

DI void phaseB(const Params& p, int layer_slot, unsigned char* smem) {
  const int layer = layer_slot & 3;
  int* s_item = (int*)(smem + 77824);
  const bool stat = gridDim.x == 512;
  const int sq = 2 * (blockIdx.x >> 3) + ((blockIdx.x >> 2) & 1), sh = blockIdx.x & 3;
  const int total = stat ? 672 : 1696;
  for (int n = 0;; ++n) {
    int kind, a, h;
    if (stat && n < 2) { kind = 1; a = n ? sq : 255 - sq; h = sh; }
    else {
      __syncthreads();
      if (threadIdx.x == 0) *s_item = atomicAdd(p.counters + layer_slot, 1);
      __syncthreads();
      const int it = *s_item;
      if (it >= total) break;
      if (it < 128) { kind = 0; a = it >> 2; h = it & 3; }
      else if (it < 672) { kind = 2; a = (it - 128) >> 2; h = (it - 128) & 3; }
      else { kind = 1; a = 255 - ((it - 672) >> 2); h = (it - 672) & 3; }
    }
    if (kind == 0) attn_item<true>(p, layer, a, h, smem);
    else if (kind == 1) attn_item<false>(p, layer, a, h, smem);
    else sgu_item(p, layer, a, h, smem);
  }
}

DI void phaseC1_tile(const Params& p, int layer, int mt, int nt, unsigned char* smem) {
  const int t = tid();
  const int c8 = (t & 15) * 8;
  const float* ct = (const float*)smem;
  f32x16 acc[2][2];
  uint4 ya[8], gma[8], gmb[8];
#pragma unroll
  for (int i = 0; i < 8; ++i) {
    const u16* hp = p.H + (size_t)(mt * 128 + (t >> 4) + 16 * i) * INW + nt * 128 + c8;
    gma[i] = *(const uint4*)(hp + C_MA); gmb[i] = *(const uint4*)(hp + C_MB);
  }
  zero_acc(acc);
  gemm_core(p.A1 + (size_t)mt * 128 * 512, 512, p.WoaT + ((size_t)layer * 1024 + nt * 128) * 512, 512, 512, acc, smem);
  acc_to_lds(acc, smem);
  __syncthreads();
#pragma unroll
  for (int i = 0; i < 8; ++i) {
    const int rl = (t >> 4) + 16 * i;
    const int row = mt * 128 + rl;
    const float* cp = ct + rl * CT_STRIDE + c8;
    const float4 v0 = *(const float4*)cp, v1 = *(const float4*)(cp + 4);
    const uint4 g = gma[i];
    ya[i] = make_uint4(pk(v0.x * sigmoidf_(bflo(g.x)), v0.y * sigmoidf_(bfhi(g.x))), pk(v0.z * sigmoidf_(bflo(g.y)), v0.w * sigmoidf_(bfhi(g.y))),
                       pk(v1.x * sigmoidf_(bflo(g.z)), v1.y * sigmoidf_(bfhi(g.z))), pk(v1.z * sigmoidf_(bflo(g.w)), v1.w * sigmoidf_(bfhi(g.w))));
  }
  zero_acc(acc);
  gemm_core(p.A2 + (size_t)mt * 128 * 512, 512, p.WogT + ((size_t)layer * 1024 + nt * 128) * 512, 512, 512, acc, smem);
  acc_to_lds(acc, smem);
  __syncthreads();
#pragma unroll
  for (int i = 0; i < 8; ++i) {
    const int rl = (t >> 4) + 16 * i;
    const int row = mt * 128 + rl;
    const float* cp = ct + rl * CT_STRIDE + c8;
    const float4 v0 = *(const float4*)cp, v1 = *(const float4*)(cp + 4);
    const uint4 g = gmb[i];
    float4 o0, o1;
    const float4 ma0 = make_float4(bflo(ya[i].x), bfhi(ya[i].x), bflo(ya[i].y), bfhi(ya[i].y));
    const float4 ma1 = make_float4(bflo(ya[i].z), bfhi(ya[i].z), bflo(ya[i].w), bfhi(ya[i].w));
    o0.x = ma0.x + v0.x * sigmoidf_(bflo(g.x)); o0.y = ma0.y + v0.y * sigmoidf_(bfhi(g.x));
    o0.z = ma0.z + v0.z * sigmoidf_(bflo(g.y)); o0.w = ma0.w + v0.w * sigmoidf_(bfhi(g.y));
    o1.x = ma1.x + v1.x * sigmoidf_(bflo(g.z)); o1.y = ma1.y + v1.y * sigmoidf_(bfhi(g.z));
    o1.z = ma1.z + v1.z * sigmoidf_(bflo(g.w)); o1.w = ma1.w + v1.w * sigmoidf_(bfhi(g.w));
    *(uint4*)(p.Mg + (size_t)row * 1024 + nt * 128 + c8) = pack8(o0, o1);
  }
}

DI void phaseC2_tile(const Params& p, int layer, int mt, int nt, unsigned char* smem) {
  const int t = tid();
  const int c8 = (t & 15) * 8;
  const float* ct = (const float*)smem;
  const float* xsrc = layer == 0 ? (mt < 128 ? p.x_prompt : p.x_sample - (size_t)SEQ * 1024) : p.Xf;
  float4 xr0[8], xr1[8];
#pragma unroll
  for (int i = 0; i < 8; ++i) {
    const float* xp = xsrc + (size_t)(mt * 128 + (t >> 4) + 16 * i) * 1024 + nt * 128 + c8;
    xr0[i] = *(const float4*)xp; xr1[i] = *(const float4*)(xp + 4);
  }
  f32x16 acc[2][2];
  zero_acc(acc);
  gemm_core(p.Mg + (size_t)mt * 128 * 1024, 1024, p.WoutT + ((size_t)layer * 1024 + nt * 128) * 1024, 1024, 1024, acc, smem);
  acc_to_lds(acc, smem);
  __syncthreads();
#pragma unroll
  for (int i = 0; i < 8; ++i) {
    const int rl = (t >> 4) + 16 * i;
    const int row = mt * 128 + rl;
    const float* cp = ct + rl * CT_STRIDE + c8;
    const float4 v0 = *(const float4*)cp, v1 = *(const float4*)(cp + 4);
    const float4 x0 = xr0[i], x1 = xr1[i];
    float* op = p.Xpre + (size_t)row * 1024 + nt * 128 + c8;
    *(float4*)op = make_float4(ALPHA_RES * x0.x + v0.x, ALPHA_RES * x0.y + v0.y, ALPHA_RES * x0.z + v0.z, ALPHA_RES * x0.w + v0.w);
    *(float4*)(op + 4) = make_float4(ALPHA_RES * x1.x + v1.x, ALPHA_RES * x1.y + v1.y, ALPHA_RES * x1.z + v1.z, ALPHA_RES * x1.w + v1.w);
  }
}

DI void phaseLN(const Params& p, int layer) {
  const int t = tid(), l = t & 63, w = t >> 6;
  const float* g = p.ln_g + layer * 1024;
  const float* b = p.ln_b + layer * 1024;
  float* dstf = layer == 3 ? p.out : p.Xf;
  for (int row = blockIdx.x * 4 + w; row < MTOK; row += gridDim.x * 4) {
    const float* src = p.Xpre + (size_t)row * 1024;
    float4 v[4];
    float s1 = 0.f;
#pragma unroll
    for (int i = 0; i < 4; ++i) { v[i] = *(const float4*)(src + i * 256 + l * 4); s1 += v[i].x + v[i].y + v[i].z + v[i].w; }
#pragma unroll
    for (int o = 32; o >= 1; o >>= 1) s1 += __shfl_xor(s1, o);
    const float mean = s1 * (1.f / 1024.f);
    float s2 = 0.f;
#pragma unroll
    for (int i = 0; i < 4; ++i) {
      v[i].x -= mean; v[i].y -= mean; v[i].z -= mean; v[i].w -= mean;
      s2 += v[i].x * v[i].x + v[i].y * v[i].y + v[i].z * v[i].z + v[i].w * v[i].w;
    }
#pragma unroll
    for (int o = 32; o >= 1; o >>= 1) s2 += __shfl_xor(s2, o);
    const float rstd = rsqrtf(s2 * (1.f / 1024.f) + LN_EPS);
#pragma unroll
    for (int i = 0; i < 4; ++i) {
      const int c = i * 256 + l * 4;
      const float4 gv = *(const float4*)(g + c), bv = *(const float4*)(b + c);
      const float y0 = v[i].x * rstd * gv.x + bv.x, y1 = v[i].y * rstd * gv.y + bv.y;
      const float y2 = v[i].z * rstd * gv.z + bv.z, y3 = v[i].w * rstd * gv.w + bv.w;
      *(float4*)(dstf + (size_t)row * 1024 + c) = make_float4(y0, y1, y2, y3);
      if (layer < 3) *(uint2*)(p.Xb + (size_t)row * 1024 + c) = make_uint2(pk(y0, y1), pk(y2, y3));
    }
  }
}

__global__ void __launch_bounds__(256, 2) fwd_megakernel(Params p) {
  __shared__ __attribute__((aligned(16))) unsigned char smem[SMEM_BYTES];
  __shared__ uint4 xb_words;
  cg::grid_group grid = cg::this_grid();
  if (threadIdx.x == 0) xb_words = make_uint4(0u, 0u, 0u, 0u);
  __syncthreads();
  XcdBarrier xb = xcd_barrier_post(p.bar, (volatile LAS unsigned*)&xb_words);
  for (int ph = p.ph_lo; ph < p.ph_hi; ++ph) {
    if (ph == 0) {
      phase0(p, smem);
    } else {
      const int layer = (ph - 1) / 5, sub = (ph - 1) % 5;
      const int nrep = (sub == PROBE_REP || (PROBE_REP == 6 && sub >= 2)) ? 2 : 1;
      for (int rep = 0; rep < nrep; ++rep) {
        if (rep) xcd_barrier(xb);
        if (sub == 0) {
          for (int tix = blockIdx.x; tix < 136 * 22; tix += gridDim.x) phaseA_tile(p, layer, tix / 22, tix % 22, smem);
        } else if (sub == 1) {
          phaseB(p, layer + 4 * rep, smem);
        } else if (sub == 2) {
          for (int tix = blockIdx.x; tix < 136 * 8; tix += gridDim.x) phaseC1_tile(p, layer, tix >> 3, tix & 7, smem);
        } else if (sub == 3) {
          for (int tix = blockIdx.x; tix < 136 * 8; tix += gridDim.x) phaseC2_tile(p, layer, tix >> 3, tix & 7, smem);
        } else {
          phaseLN(p, layer);
        }
      }
    }
    if (PROBE_REP == 5 && ph + 1 < p.ph_hi) xcd_barrier(xb);
    if (ph + 1 < p.ph_hi) { if (ph == 0) grid.sync(); else xcd_barrier(xb); }
  }
}

extern "C" void kernel_launch(void* const* d_in, const int* in_sizes, int n_in, void* d_out, int out_size, void* d_ws, size_t ws_size, hipStream_t stream) {
  static int grid_blocks = 0;
  if (!grid_blocks) {
    int dev = 0, cus = 0, per_cu = 0;
    hipGetDevice(&dev);
    hipDeviceGetAttribute(&cus, hipDeviceAttributeMultiprocessorCount, dev);
    hipOccupancyMaxActiveBlocksPerMultiprocessor(&per_cu, fwd_megakernel, 256, 0);
    if (per_cu < 1) per_cu = 1;
    if (per_cu > 2) per_cu = 2;
    grid_blocks = cus * per_cu;
  }
  Params p{};
  const float** ins = (const float**)&p;
  for (int i = 0; i < 19; ++i) ins[i] = (const float*)d_in[i];
  p.out = (float*)d_out;
  unsigned char* ws = (unsigned char*)d_ws;
  size_t off = 0;
  auto take = [&](size_t bytes) { unsigned char* q = ws + off; off += (bytes + 255) & ~(size_t)255; return q; };
  p.WinT = (u16*)take((size_t)4 * 5632 * 1024 * 2);
  p.WoaT = (u16*)take((size_t)4 * 1024 * 512 * 2);
  p.WogT = (u16*)take((size_t)4 * 1024 * 512 * 2);
  p.WoutT = (u16*)take((size_t)4 * 1024 * 1024 * 2);
  p.Xb = (u16*)take((size_t)MTOK * 1024 * 2);
  p.H = (u16*)take((size_t)MTOK * INW * 2);
  p.A1 = (u16*)take((size_t)MTOK * 512 * 2);
  p.A2 = (u16*)take((size_t)MTOK * 512 * 2);
  p.Mg = (u16*)take((size_t)MTOK * 1024 * 2);
  p.Xf = (float*)take((size_t)MTOK * 1024 * 4);
  p.Xpre = (float*)take((size_t)MTOK * 1024 * 4);
  p.rope = (float*)take((size_t)SEQ * 32 * 2 * 4);
  p.lam = (float*)take(256);
  p.counters = (int*)take(256);
  p.bar = (unsigned*)take(XCD_BAR_WORDS * 4);
  hipMemsetAsync(p.bar, 0, XCD_BAR_WORDS * 4, stream);
#if MULTI_LAUNCH
  for (int ph = 0; ph < 21; ++ph) {
    p.ph_lo = ph; p.ph_hi = ph + 1;
    hipLaunchKernelGGL(fwd_megakernel, dim3(grid_blocks), dim3(256), 0, stream, p);
  }
#else
  p.ph_lo = 0; p.ph_hi = 21;
  void* args[] = {&p};
  hipError_t e = hipLaunchCooperativeKernel((void*)fwd_megakernel, dim3(grid_blocks), dim3(256), args, 0, stream);
  if (e != hipSuccess) fprintf(stderr, "cooperative launch failed: %s (grid %d)\n", hipGetErrorString(e), grid_blocks);
#endif
}
```

```cpp
#include <hip/hip_runtime.h>
#include <hip/hip_cooperative_groups.h>
#include <cstdio>
namespace cg = cooperative_groups;

#ifndef PROBE_REP
#define PROBE_REP -1
#endif
#ifndef MULTI_LAUNCH
#define MULTI_LAUNCH 0
#endif

#define DI __device__ __forceinline__
typedef unsigned short u16;
typedef __attribute__((ext_vector_type(8))) short bf16x8;
typedef __attribute__((ext_vector_type(4))) short s16x4;
typedef __attribute__((ext_vector_type(16))) float f32x16;
typedef __attribute__((ext_vector_type(2))) float f32x2;
typedef __attribute__((ext_vector_type(2))) __bf16 bf16x2_t;

constexpr int SEQ = 16384, MTOK = 17408, INW = 5632;
constexpr int C_K = 512, C_V = 1024, C_GA = 1536, C_U = 2048, C_VG = 2560, C_GG = 3072, C_MA = 3584, C_MB = 4608;
constexpr size_t OFF_KP = 17825792, OFF_VP = 51380224, OFF_KS = 84934656, OFF_VS = 87031808, OFF_GV = 89128960;
constexpr int SMEM_BYTES = 77824 + 64;
constexpr float ALPHA_RES = 1.681792830507429f;
constexpr float LN_EPS = 1e-5f;

struct Params {
  const float *x_prompt, *x_sample, *cache_k, *cache_v, *w_in, *w_oa, *w_og, *w_out;
  const float *lq1, *lk1, *lq2, *lk2, *subln_w, *sgu_g, *sgu_b, *w_s, *b_s, *ln_g, *ln_b;
  float* out;
  u16 *WinT, *WoaT, *WogT, *WoutT, *Xb, *H, *A1, *A2, *Mg;
  float *Xf, *Xpre, *rope, *lam;
  int* counters;
  unsigned* bar;
  int ph_lo, ph_hi;
};

DI unsigned pk(float a, float b) { f32x2 x = {a, b}; bf16x2_t y = __builtin_convertvector(x, bf16x2_t); return __builtin_bit_cast(unsigned, y); }
DI u16 f2bf(float a) { return (u16)(pk(a, 0.f) & 0xffffu); }
DI float bf2f(u16 h) { return __uint_as_float(((unsigned)h) << 16); }
DI float bflo(unsigned u) { return __uint_as_float(u << 16); }
DI float bfhi(unsigned u) { return __uint_as_float(u & 0xffff0000u); }
DI int tid() { int t = threadIdx.x; asm volatile("" : "+v"(t)); return t; }
DI int crow(int i, int hb) { return (i & 3) + 8 * (i >> 2) + 4 * hb; }
DI float sigmoidf_(float x) { return 1.f / (1.f + __expf(-x)); }
DI float siluf_(float x) { return x / (1.f + __expf(-x)); }
#define MFMA(a, b, c) __builtin_amdgcn_mfma_f32_32x32x16_bf16((a), (b), (c), 0, 0, 0)
typedef __attribute__((address_space(3))) s16x4 lds_s16x4;
typedef __attribute__((address_space(3))) unsigned lds_u32;
DI void glds16(const void* g, unsigned lds_base) {
  unsigned sv;
  asm volatile("s_mov_b32 %0, m0\n\ts_mov_b32 m0, %2\n\ts_nop 0\n\tglobal_load_lds_dwordx4 %1, off\n\ts_mov_b32 m0, %0" : "=&s"(sv) : "v"(g), "s"(lds_base) : "memory");
}
DI unsigned lds_addr(const void* p) { return (unsigned)(size_t)(__attribute__((address_space(3))) const unsigned char*)p; }
DI s16x4 tr_read(const u16* p) { return __builtin_amdgcn_ds_read_tr16_b64_v4i16((lds_s16x4*)p); }
DI bf16x8 cat8(s16x4 lo, s16x4 hi) { return __builtin_shufflevector(lo, hi, 0, 1, 2, 3, 4, 5, 6, 7); }


#define XB_TMO      128
#define XB_XCNT(j)  (256  + 64 * (j))
#define XB_XSUB(j)  (1280 + 64 * (j))
#define XB_XGEN(j)  (2304 + 64 * (j))
#define XB_TOP      3328
#define XB_TOPGEN   3392
#define XCD_BAR_WORDS 3456
#define XB_SPIN_CAP (1u << 24)
#define LAS __attribute__((address_space(3)))
DI unsigned xb_ld(unsigned* p)              { return __hip_atomic_load(p, __ATOMIC_RELAXED, __HIP_MEMORY_SCOPE_AGENT); }
DI unsigned xb_add(unsigned* p, unsigned v) { return __hip_atomic_fetch_add(p, v, __ATOMIC_RELAXED, __HIP_MEMORY_SCOPE_AGENT); }
DI unsigned xb_xcc_id() { return (unsigned)__builtin_amdgcn_s_getreg((3 << 11) | 20) & 0xFu; }
#define XB_SPIN(cond, bar) do { unsigned _sp = 0; while (cond) { __builtin_amdgcn_s_sleep(1); \
    if ((++_sp & 255u) == 0u) { if (xb_ld(&(bar)[XB_TMO])) break; if (_sp > XB_SPIN_CAP) { atomicAdd(&(bar)[XB_TMO], 1u); break; } } } } while (0)
struct XcdBarrier { unsigned* bar; unsigned x; volatile LAS unsigned* st; };
DI XcdBarrier xcd_barrier_post(unsigned* bar, volatile LAS unsigned* st) {
  XcdBarrier b; b.bar = bar; b.x = xb_xcc_id(); b.st = st;
  if (threadIdx.x == 0) (void)xb_add(&bar[XB_XCNT(b.x)], 1u);
  return b;
}
DI void xcd_barrier_complete(unsigned* bar, unsigned x, unsigned& nloc, unsigned& nx) {
  const unsigned G = gridDim.x * gridDim.y * gridDim.z;
  unsigned sum, cnt, mine, sp = 0u;
  for (;;) {
    sum = 0u; cnt = 0u; mine = 0u;
#pragma unroll
    for (unsigned j = 0; j < 16; ++j) { const unsigned c = xb_ld(&bar[XB_XCNT(j)]); sum += c; cnt += (c > 0u) ? 1u : 0u; mine = (j == x) ? c : mine; }
    if (sum == G) break;
    __builtin_amdgcn_s_sleep(1);
    if ((++sp & 255u) == 0u) { if (xb_ld(&bar[XB_TMO])) break; if (sp > XB_SPIN_CAP) { atomicAdd(&bar[XB_TMO], 1u); break; } }
  }
  nloc = mine > 0u ? mine : 1u; nx = cnt > 0u ? cnt : 1u;
}
DI void xcd_barrier(const XcdBarrier& b) {
  asm volatile("s_waitcnt vmcnt(0)" ::: "memory");
  __syncthreads();
  if (threadIdx.x == 0) {
    unsigned* bar = b.bar;
    __builtin_amdgcn_s_waitcnt(0);
    unsigned nloc = b.st[0], nx = b.st[1];
    if (nloc == 0u) { xcd_barrier_complete(bar, b.x, nloc, nx); b.st[0] = nloc; b.st[1] = nx; }
    const unsigned old = xb_add(&bar[XB_XSUB(b.x)], 1u);
    const unsigned gen = old / nloc;
    if (old + 1u == (gen + 1u) * nloc) {
      __builtin_amdgcn_fence(__ATOMIC_RELEASE, "agent");
      asm volatile("s_waitcnt vmcnt(0)" ::: "memory");
      const unsigned og = xb_add(&bar[XB_TOP], 1u);
      const unsigned tg = og / nx;
      if (og + 1u == (tg + 1u) * nx) xb_add(&bar[XB_TOPGEN], 1u);
      else XB_SPIN(xb_ld(&bar[XB_TOPGEN]) == tg, bar);
      __builtin_amdgcn_fence(__ATOMIC_ACQUIRE, "agent");
      xb_add(&bar[XB_XGEN(b.x)], 1u);
      asm volatile("s_waitcnt vmcnt(0)" ::: "memory");
    } else {
      XB_SPIN(xb_ld(&bar[XB_XGEN(b.x)]) == gen, bar);
      __builtin_amdgcn_fence(__ATOMIC_ACQUIRE, "agent");
      asm volatile("s_waitcnt vmcnt(0)" ::: "memory");
    }
  }
  __syncthreads();
}

DI void gemm_core(const u16* __restrict__ A, int lda, const u16* __restrict__ Bt, int ldb, int K,
                  f32x16 (&acc)[2][2], unsigned char* smem) {
  const int t = tid(), l = t & 63, w = t >> 6, wm = w >> 1, wn = w & 1, hb = l >> 5, r = l & 31;
  const int grow = w * 8 + (l >> 3);
  const int gch = (l & 7) ^ ((grow >> 1) & 7);
  const u16* ag = A + (size_t)grow * lda + gch * 8;
  const u16* bg = Bt + (size_t)grow * ldb + gch * 8;
  const unsigned lbase = __builtin_amdgcn_readfirstlane(lds_addr(smem) + w * 1024);
#define GM_STAGE(BUF, KO)                                                                                        \
  {                                                                                                              \
    const unsigned sa_ = lbase + (BUF) * 32768;                                                                  \
    _Pragma("unroll") for (int i = 0; i < 4; ++i) {                                                              \
      glds16(ag + (size_t)(32 * i) * lda + (KO), sa_ + i * 4096);                                                \
      glds16(bg + (size_t)(32 * i) * ldb + (KO), sa_ + 16384 + i * 4096);                                        \
    }                                                                                                            \
  }
  __syncthreads();
  GM_STAGE(0, 0)
  asm volatile("s_waitcnt vmcnt(0)" ::: "memory");
  __syncthreads();
  const int sw = (r >> 1) & 7;
  const int o0 = ((0 + hb) ^ sw) * 8, o1 = ((2 + hb) ^ sw) * 8, o2 = ((4 + hb) ^ sw) * 8, o3 = ((6 + hb) ^ sw) * 8;
  const int nk = K >> 6;
  for (int kt = 0; kt < nk; ++kt) {
    const int buf = kt & 1;
    if (kt + 1 < nk) GM_STAGE(buf ^ 1, (kt + 1) * 64)
    __builtin_amdgcn_sched_barrier(0);
    const u16* as = (const u16*)(smem + buf * 32768) + (wm * 64 + r) * 64;
    const u16* bs = (const u16*)(smem + buf * 32768 + 16384) + (wn * 64 + r) * 64;
#define GM_LDF(A0, A1, B0, B1, OFF)                                                       \
    A0 = *(const bf16x8*)(as + (OFF)); A1 = *(const bf16x8*)(as + 32 * 64 + (OFF));       \
    B0 = *(const bf16x8*)(bs + (OFF)); B1 = *(const bf16x8*)(bs + 32 * 64 + (OFF));
#define GM_MM(A0, A1, B0, B1)                                                             \
    acc[0][0] = MFMA(A0, B0, acc[0][0]); acc[0][1] = MFMA(A0, B1, acc[0][1]);             \
    acc[1][0] = MFMA(A1, B0, acc[1][0]); acc[1][1] = MFMA(A1, B1, acc[1][1]);
    {
      bf16x8 xa0, xa1, xb0, xb1, ya0, ya1, yb0, yb1;
      GM_LDF(xa0, xa1, xb0, xb1, o0)
      GM_LDF(ya0, ya1, yb0, yb1, o1)
      __builtin_amdgcn_sched_barrier(0);
      GM_MM(xa0, xa1, xb0, xb1)
      __builtin_amdgcn_sched_barrier(0);
      GM_LDF(xa0, xa1, xb0, xb1, o2)
      __builtin_amdgcn_sched_barrier(0);
      GM_MM(ya0, ya1, yb0, yb1)
      __builtin_amdgcn_sched_barrier(0);
      GM_LDF(ya0, ya1, yb0, yb1, o3)
      __builtin_amdgcn_sched_barrier(0);
      GM_MM(xa0, xa1, xb0, xb1)
      __builtin_amdgcn_sched_barrier(0);
      GM_MM(ya0, ya1, yb0, yb1)
    }
    asm volatile("s_waitcnt vmcnt(0)" ::: "memory");
    __syncthreads();
  }
}


DI void gemm_core_wide(const u16* __restrict__ A, int lda, const u16* __restrict__ Bt, int ldb, int K,
                       f32x16 (&acc)[2][4], unsigned char* smem) {
  const int t = tid(), l = t & 63, w = t >> 6, wm = w >> 1, wn = w & 1, hb = l >> 5, r = l & 31;
  const int grow = w * 16 + (l >> 2);
  const int gch = (l & 3) ^ ((l >> 4) & 3);
  const u16* ag = A + (size_t)grow * lda + gch * 8;
  const u16* bg = Bt + (size_t)grow * ldb + gch * 8;
  const unsigned lbase = __builtin_amdgcn_readfirstlane(lds_addr(smem) + w * 1024);
#define GW_STAGE(SLOT, KO)                                                                  \
  {                                                                                         \
    const unsigned sa_ = lbase + (SLOT) * 24576;                                            \
    glds16(ag + (KO), sa_);                                                                 \
    glds16(ag + (size_t)64 * lda + (KO), sa_ + 4096);                                       \
    glds16(bg + (KO), sa_ + 8192);                                                          \
    glds16(bg + (size_t)64 * ldb + (KO), sa_ + 8192 + 4096);                                \
    glds16(bg + (size_t)128 * ldb + (KO), sa_ + 8192 + 8192);                               \
    glds16(bg + (size_t)192 * ldb + (KO), sa_ + 8192 + 12288);                              \
  }
  __syncthreads();
  GW_STAGE(0, 0)
  GW_STAGE(1, 32)
  const int sw = (r >> 2) & 3;
  const int o0 = ((0 + hb) ^ sw) * 8, o1 = ((2 + hb) ^ sw) * 8;
  const int nk = K >> 5;
  int slot = 0;
  for (int kt = 0; kt < nk; ++kt) {
    if (kt + 1 < nk) asm volatile("s_waitcnt vmcnt(6)" ::: "memory"); else asm volatile("s_waitcnt vmcnt(0)" ::: "memory");
    __syncthreads();
    if (kt + 2 < nk) { const int s2 = slot >= 1 ? slot - 1 : 2; GW_STAGE(s2, (kt + 2) * 32) }
    __builtin_amdgcn_sched_barrier(0);
    const u16* as = (const u16*)(smem + slot * 24576) + (wm * 64 + r) * 32;
    const u16* bs = (const u16*)(smem + slot * 24576 + 8192) + (wn * 128 + r) * 32;
    {
      bf16x8 a0 = *(const bf16x8*)(as + o0), a1 = *(const bf16x8*)(as + 32 * 32 + o0);
      bf16x8 b0 = *(const bf16x8*)(bs + o0), b1 = *(const bf16x8*)(bs + 32 * 32 + o0);
      bf16x8 b2 = *(const bf16x8*)(bs + 64 * 32 + o0), b3 = *(const bf16x8*)(bs + 96 * 32 + o0);
      bf16x8 c0 = *(const bf16x8*)(as + o1), c1 = *(const bf16x8*)(as + 32 * 32 + o1);
      bf16x8 d0 = *(const bf16x8*)(bs + o1), d1 = *(const bf16x8*)(bs + 32 * 32 + o1);
      bf16x8 d2 = *(const bf16x8*)(bs + 64 * 32 + o1), d3 = *(const bf16x8*)(bs + 96 * 32 + o1);
      acc[0][0] = MFMA(a0, b0, acc[0][0]); acc[0][1] = MFMA(a0, b1, acc[0][1]); acc[0][2] = MFMA(a0, b2, acc[0][2]); acc[0][3] = MFMA(a0, b3, acc[0][3]);
      acc[1][0] = MFMA(a1, b0, acc[1][0]); acc[1][1] = MFMA(a1, b1, acc[1][1]); acc[1][2] = MFMA(a1, b2, acc[1][2]); acc[1][3] = MFMA(a1, b3, acc[1][3]);
      acc[0][0] = MFMA(c0, d0, acc[0][0]); acc[0][1] = MFMA(c0, d1, acc[0][1]); acc[0][2] = MFMA(c0, d2, acc[0][2]); acc[0][3] = MFMA(c0, d3, acc[0][3]);
      acc[1][0] = MFMA(c1, d0, acc[1][0]); acc[1][1] = MFMA(c1, d1, acc[1][1]); acc[1][2] = MFMA(c1, d2, acc[1][2]); acc[1][3] = MFMA(c1, d3, acc[1][3]);
    }
    slot = slot == 2 ? 0 : slot + 1;
  }
}

constexpr int CT_STRIDE = 132;
DI void acc_to_lds(const f32x16 (&acc)[2][2], unsigned char* smem) {
  const int t = tid(), l = t & 63, w = t >> 6, wm = w >> 1, wn = w & 1, hb = l >> 5, r = l & 31;
  float* base = (float*)smem + (wm * 64 + 4 * hb) * CT_STRIDE + wn * 64 + r;
#pragma unroll
  for (int tm = 0; tm < 2; ++tm)
#pragma unroll
    for (int tn = 0; tn < 2; ++tn)
#pragma unroll
      for (int i = 0; i < 16; ++i) base[(tm * 32 + (i & 3) + 8 * (i >> 2)) * CT_STRIDE + tn * 32] = acc[tm][tn][i];
}
typedef __attribute__((ext_vector_type(4))) float f32x4_t;
DI void nt_store4(float* p, const float4& v) { f32x4_t x = {v.x, v.y, v.z, v.w}; __builtin_nontemporal_store(x, (f32x4_t*)p); }
DI uint4 pack8(const float4& a, const float4& b) { return make_uint4(pk(a.x, a.y), pk(a.z, a.w), pk(b.x, b.y), pk(b.z, b.w)); }

DI void zero_acc(f32x16 (&acc)[2][2]) {
#pragma unroll
  for (int a = 0; a < 2; ++a)
#pragma unroll
    for (int b = 0; b < 2; ++b)
#pragma unroll
      for (int i = 0; i < 16; ++i) acc[a][b][i] = 0.f;
}

DI void transpose_tile(const float* __restrict__ src, u16* __restrict__ dst, int K, int N, int kt, int nt, unsigned char* smem) {
  float* tile = (float*)smem;
  const int t = tid();
  __syncthreads();
#pragma unroll
  for (int i = 0; i < 4; ++i) {
    const int row = (t >> 4) + 16 * i, c4 = (t & 15) * 4;
    const float4 v = *(const float4*)(src + (size_t)(kt * 64 + row) * N + nt * 64 + c4);
    tile[row * 65 + c4 + 0] = v.x; tile[row * 65 + c4 + 1] = v.y; tile[row * 65 + c4 + 2] = v.z; tile[row * 65 + c4 + 3] = v.w;
  }
  __syncthreads();
  const int n = t >> 2, kseg = (t & 3) * 16;
  unsigned o[8];
#pragma unroll
  for (int e = 0; e < 8; ++e) o[e] = pk(tile[(kseg + 2 * e) * 65 + n], tile[(kseg + 2 * e + 1) * 65 + n]);
  u16* d = dst + (size_t)(nt * 64 + n) * K + kt * 64 + kseg;
  *(uint4*)d = make_uint4(o[0], o[1], o[2], o[3]);
  *(uint4*)(d + 8) = make_uint4(o[4], o[5], o[6], o[7]);
}

__device__ const float ROPE_INV[32] = {1.0f, 0.749894202f, 0.562341332f, 0.421696514f, 0.316227764f, 0.237137377f, 0.177827939f, 0.133352146f, 0.100000001f, 0.0749894232f, 0.0562341325f, 0.0421696492f, 0.0316227749f, 0.0237137377f, 0.0177827943f, 0.013335214f, 0.00999999978f, 0.00749894232f, 0.00562341325f, 0.00421696482f, 0.00316227763f, 0.00237137382f, 0.00177827943f, 0.00133352145f, 0.00100000005f, 0.000749894185f, 0.000562341302f, 0.000421696517f, 0.000316227757f, 0.00023713737f, 0.00017782794f, 0.00013335215f};

DI void phase0(const Params& p, unsigned char* smem) {
  const int t = tid();
  if (blockIdx.x == 0) {
    if (t < 4) {
      float s1 = 0.f, s2 = 0.f;
      for (int i = 0; i < 64; ++i) { s1 += p.lq1[t * 64 + i] * p.lk1[t * 64 + i]; s2 += p.lq2[t * 64 + i] * p.lk2[t * 64 + i]; }
      const float li = t == 0 ? 0.2f : (t == 1 ? 0.355509067590969f : (t == 2 ? 0.470713018343584f : 0.556058204155641f));
      p.lam[t] = expf(s1) - expf(s2) + li;
      p.lam[4 + t] = li;
      p.counters[t] = 0; p.counters[4 + t] = 0;
    }
  }
  {
    float* tile = (float*)smem;
    const int trow = t >> 4, tc4 = (t & 15) * 4;
    const int tn = t >> 2, tkseg = (t & 3) * 16;
    const float* tsrc; u16* tdst; int tK, tN, tkt, tnt;
#define TR_DECODE(J)                                                                                                                       \
    if ((J) < 5632) { const int l_ = (J) / 1408, r_ = (J) % 1408; tsrc = p.w_in + (size_t)l_ * 1024 * 5632; tdst = p.WinT + (size_t)l_ * 5632 * 1024; tK = 1024; tN = 5632; tkt = r_ / 88; tnt = r_ % 88; } \
    else if ((J) < 6144) { const int q_ = (J) - 5632, l_ = q_ >> 7, r_ = q_ & 127; tsrc = p.w_oa + (size_t)l_ * 512 * 1024; tdst = p.WoaT + (size_t)l_ * 1024 * 512; tK = 512; tN = 1024; tkt = r_ >> 4; tnt = r_ & 15; } \
    else if ((J) < 6656) { const int q_ = (J) - 6144, l_ = q_ >> 7, r_ = q_ & 127; tsrc = p.w_og + (size_t)l_ * 512 * 1024; tdst = p.WogT + (size_t)l_ * 1024 * 512; tK = 512; tN = 1024; tkt = r_ >> 4; tnt = r_ & 15; } \
    else { const int q_ = (J) - 6656, l_ = q_ >> 8, r_ = q_ & 255; tsrc = p.w_out + (size_t)l_ * 1024 * 1024; tdst = p.WoutT + (size_t)l_ * 1024 * 1024; tK = 1024; tN = 1024; tkt = r_ >> 4; tnt = r_ & 15; }
#define TR_LOAD()                                                                                                                          \
    { const float* s_ = tsrc + (size_t)(tkt * 64 + trow) * tN + tnt * 64 + tc4;                                                            \
      f0 = *(const float4*)s_; f1 = *(const float4*)(s_ + (size_t)16 * tN); f2 = *(const float4*)(s_ + (size_t)32 * tN); f3 = *(const float4*)(s_ + (size_t)48 * tN); }
    float4 f0, f1, f2, f3;
    int j = blockIdx.x;
    if (j < 7680) { TR_DECODE(j) TR_LOAD() }
    for (; j < 7680; j += gridDim.x) {
      u16* d = tdst + (size_t)(tnt * 64 + tn) * tK + tkt * 64 + tkseg;
      __syncthreads();
      float* w0 = tile + trow * 65 + tc4;
      w0[0] = f0.x; w0[1] = f0.y; w0[2] = f0.z; w0[3] = f0.w;
      w0[16 * 65 + 0] = f1.x; w0[16 * 65 + 1] = f1.y; w0[16 * 65 + 2] = f1.z; w0[16 * 65 + 3] = f1.w;
      w0[32 * 65 + 0] = f2.x; w0[32 * 65 + 1] = f2.y; w0[32 * 65 + 2] = f2.z; w0[32 * 65 + 3] = f2.w;
      w0[48 * 65 + 0] = f3.x; w0[48 * 65 + 1] = f3.y; w0[48 * 65 + 2] = f3.z; w0[48 * 65 + 3] = f3.w;
      __syncthreads();
      const int jn = j + gridDim.x;
      if (jn < 7680) { TR_DECODE(jn) TR_LOAD() }
      unsigned o0 = pk(tile[(tkseg + 0) * 65 + tn], tile[(tkseg + 1) * 65 + tn]), o1 = pk(tile[(tkseg + 2) * 65 + tn], tile[(tkseg + 3) * 65 + tn]);
      unsigned o2 = pk(tile[(tkseg + 4) * 65 + tn], tile[(tkseg + 5) * 65 + tn]), o3 = pk(tile[(tkseg + 6) * 65 + tn], tile[(tkseg + 7) * 65 + tn]);
      unsigned o4 = pk(tile[(tkseg + 8) * 65 + tn], tile[(tkseg + 9) * 65 + tn]), o5 = pk(tile[(tkseg + 10) * 65 + tn], tile[(tkseg + 11) * 65 + tn]);
      unsigned o6 = pk(tile[(tkseg + 12) * 65 + tn], tile[(tkseg + 13) * 65 + tn]), o7 = pk(tile[(tkseg + 14) * 65 + tn], tile[(tkseg + 15) * 65 + tn]);
      *(uint4*)d = make_uint4(o0, o1, o2, o3);
      *(uint4*)(d + 8) = make_uint4(o4, o5, o6, o7);
    }
  }
  const int gt = blockIdx.x * 256 + t, gs = gridDim.x * 256;
  for (int idx = gt; idx < MTOK * 128; idx += gs) {
    const int row = idx >> 7, c8 = (idx & 127) * 8;
    const float* src = row < SEQ ? p.x_prompt + (size_t)row * 1024 + c8 : p.x_sample + (size_t)(row - SEQ) * 1024 + c8;
    const float4 a = *(const float4*)src, b = *(const float4*)(src + 4);
    *(uint4*)(p.Xb + (size_t)row * 1024 + c8) = make_uint4(pk(a.x, a.y), pk(a.z, a.w), pk(b.x, b.y), pk(b.z, b.w));
  }
  for (int idx = gt; idx < SEQ * 32; idx += gs) {
    const int pos = idx >> 5, j = idx & 31;
    const float inv = ROPE_INV[j];
    const float ang = (float)pos * inv;
    double rev = (double)ang * 0.15915494309189535;
    rev -= rint(rev);
    const float rf = (float)rev;
    p.rope[2 * idx] = __builtin_amdgcn_cosf(rf);
    p.rope[2 * idx + 1] = __builtin_amdgcn_sinf(rf);
  }
}

constexpr int CW_STRIDE = 260;
DI void phaseA_tile(const Params& p, int layer, int mt, int nt, unsigned char* smem) {
  f32x16 acc[2][4];
#pragma unroll
  for (int a = 0; a < 2; ++a)
#pragma unroll
    for (int b = 0; b < 4; ++b)
#pragma unroll
      for (int i = 0; i < 16; ++i) acc[a][b][i] = 0.f;
  gemm_core_wide(p.Xb + (size_t)mt * 128 * 1024, 1024, p.WinT + ((size_t)layer * 5632 + nt * 256) * 1024, 1024, 1024, acc, smem);
  const int t = tid(), l = t & 63, w = t >> 6, wm = w >> 1, wn = w & 1, hb = l >> 5, r = l & 31;
  const int n0 = nt * 256, seg = n0 >> 9;
  const bool samp = mt >= 128;
  float* ct = (float*)smem;
#pragma unroll
  for (int h = 0; h < 2; ++h) {
    __syncthreads();
    if (wm == h) {
      float* base = ct + (4 * hb) * CW_STRIDE + wn * 128 + r;
#pragma unroll
      for (int tm = 0; tm < 2; ++tm)
#pragma unroll
        for (int tn = 0; tn < 4; ++tn)
#pragma unroll
          for (int i = 0; i < 16; ++i) base[(tm * 32 + (i & 3) + 8 * (i >> 2)) * CW_STRIDE + tn * 32] = acc[tm][tn][i];
    }
    __syncthreads();
    if (seg <= 1) {
      const int j = t & 15, head = j >> 2, c8 = (j & 3) * 8;
#pragma unroll
      for (int i = 0; i < 4; ++i) {
        const int rl = (t >> 4) + 16 * i;
        const int row = mt * 128 + h * 64 + rl;
        const int pos = samp ? 1024 + ((row - SEQ) & 31) : row;
        const float* cp = ct + rl * CW_STRIDE + head * 64 + c8;
        const float4 xa0 = *(const float4*)cp, xa1 = *(const float4*)(cp + 4);
        const float4 xb0 = *(const float4*)(cp + 32), xb1 = *(const float4*)(cp + 36);
        const float4* rp = (const float4*)(p.rope + ((size_t)pos * 32 + c8) * 2);
        const float4 r0 = rp[0], r1 = rp[1], r2 = rp[2], r3 = rp[3];
        float4 ya0, ya1, yb0, yb1;
        ya0.x = xa0.x * r0.x - xb0.x * r0.y; yb0.x = xb0.x * r0.x + xa0.x * r0.y;
        ya0.y = xa0.y * r0.z - xb0.y * r0.w; yb0.y = xb0.y * r0.z + xa0.y * r0.w;
        ya0.z = xa0.z * r1.x - xb0.z * r1.y; yb0.z = xb0.z * r1.x + xa0.z * r1.y;
        ya0.w = xa0.w * r1.z - xb0.w * r1.w; yb0.w = xb0.w * r1.z + xa0.w * r1.w;
        ya1.x = xa1.x * r2.x - xb1.x * r2.y; yb1.x = xb1.x * r2.x + xa1.x * r2.y;
        ya1.y = xa1.y * r2.z - xb1.y * r2.w; yb1.y = xb1.y * r2.z + xa1.y * r2.w;
        ya1.z = xa1.z * r3.x - xb1.z * r3.y; yb1.z = xb1.z * r3.x + xa1.z * r3.y;
        ya1.w = xa1.w * r3.z - xb1.w * r3.w; yb1.w = xb1.w * r3.z + xa1.w * r3.w;
        const int col = n0 + head * 64 + c8;
        u16* hp = p.H + (size_t)row * INW + col;
        if (seg == 0) {
          const float qs = 0.125f * 1.4426950408889634f;
          *(uint4*)hp = make_uint4(pk(ya0.x * qs, ya0.y * qs), pk(ya0.z * qs, ya0.w * qs), pk(ya1.x * qs, ya1.y * qs), pk(ya1.z * qs, ya1.w * qs));
          *(uint4*)(hp + 32) = make_uint4(pk(yb0.x * qs, yb0.y * qs), pk(yb0.z * qs, yb0.w * qs), pk(yb1.x * qs, yb1.y * qs), pk(yb1.z * qs, yb1.w * qs));
        } else {
          *(uint4*)hp = pack8(ya0, ya1);
          *(uint4*)(hp + 32) = pack8(yb0, yb1);
        }
        if (seg == 1) {
          float* o = samp ? p.out + OFF_KS + ((size_t)layer * 1024 + (row - SEQ)) * 512 + (col - C_K)
                          : p.out + OFF_KP + ((size_t)layer * SEQ + row) * 512 + (col - C_K);
          nt_store4(o, ya0); nt_store4(o + 4, ya1); nt_store4(o + 32, yb0); nt_store4(o + 36, yb1);
        }
      }
    } else {
      const int c8 = (t & 31) * 8;
#pragma unroll
      for (int i = 0; i < 8; ++i) {
        const int rl = (t >> 5) + 8 * i;
        const int row = mt * 128 + h * 64 + rl;
        const float* cp = ct + rl * CW_STRIDE + c8;
        const float4 v0 = *(const float4*)cp, v1 = *(const float4*)(cp + 4);
        const int col = n0 + c8;
        *(uint4*)(p.H + (size_t)row * INW + col) = pack8(v0, v1);
        if (seg == 2) {
          float* o = samp ? p.out + OFF_VS + ((size_t)layer * 1024 + (row - SEQ)) * 512 + (col - C_V)
                          : p.out + OFF_VP + ((size_t)layer * SEQ + row) * 512 + (col - C_V);
          nt_store4(o, v0); nt_store4(o + 4, v1);
        }
      }
    }
  }
}

constexpr int KS_STRIDE = 72;
constexpr int VS_STRIDE = 160;
constexpr int ST_K = 2 * 64 * KS_STRIDE;
constexpr int ST_BYTES = ST_K * 2 + 64 * VS_STRIDE * 2;

#define LOADV(D0, D1, D2, D3, G)                                                             \
  {                                                                                          \
    const u16* vk_ = vp + ((G) * 16) * VROW;                                                 \
    D0 = cat8(tr_read(vk_ + vo0), tr_read(vk_ + 8 * VROW + vo0));                            \
    D1 = cat8(tr_read(vk_ + vo1), tr_read(vk_ + 8 * VROW + vo1));                            \
    D2 = cat8(tr_read(vk_ + vo2), tr_read(vk_ + 8 * VROW + vo2));                            \
    D3 = cat8(tr_read(vk_ + vo3), tr_read(vk_ + 8 * VROW + vo3));                            \
  }
#define PACKP(S, U) __builtin_bit_cast(bf16x8, make_uint4(pk(S[8 * (U) + 0], S[8 * (U) + 1]), pk(S[8 * (U) + 2], S[8 * (U) + 3]), pk(S[8 * (U) + 4], S[8 * (U) + 5]), pk(S[8 * (U) + 6], S[8 * (U) + 7])))
#define PVMFMA(D0, D1, D2, D3, PB) { O[0] = MFMA(D0, PB, O[0]); O[1] = MFMA(D1, PB, O[1]); O[2] = MFMA(D2, PB, O[2]); O[3] = MFMA(D3, PB, O[3]); }
template <bool SWZ>
DI void attn_compute(const u16* Kb, const u16* Vb, const bf16x8 (&qf)[4], f32x16 (&O)[4], f32x16& Mneg, float& m_run, float& l_run, bool two, int s) {
  const int l = tid() & 63, hb = l >> 5, r = l & 31;
  f32x16 S0, S1;
  constexpr int KROW = SWZ ? 64 : KS_STRIDE, VROW = SWZ ? 128 : VS_STRIDE;
  const int q4 = (l & 15) >> 2, p4 = l & 3, blk = (l >> 4) & 1;
  const int ksw = SWZ ? ((r >> 1) & 7) : 0;
  const u16* kp = Kb + (s * 64 + r) * KROW;
  const int ko0 = ((0 + hb) ^ ksw) * 8, ko1 = ((2 + hb) ^ ksw) * 8, ko2 = ((4 + hb) ^ ksw) * 8, ko3 = ((6 + hb) ^ ksw) * 8;
  const u16* vp = Vb + (4 * hb + q4) * VROW + blk * 16 + p4 * 4;
  const int vsw = SWZ ? q4 : 0;
  const int vo0 = (0 ^ vsw) * 32, vo1 = (1 ^ vsw) * 32, vo2 = (2 ^ vsw) * 32, vo3 = (3 ^ vsw) * 32;
  bf16x8 ka0, ka1, ka2, ka3, kb0, kb1, kb2, kb3, va0, va1, va2, va3, vb0, vb1, vb2, vb3;
  ka0 = *(const bf16x8*)(kp + ko0); ka1 = *(const bf16x8*)(kp + ko1); ka2 = *(const bf16x8*)(kp + ko2); ka3 = *(const bf16x8*)(kp + ko3);
  if (two) {
    kb0 = *(const bf16x8*)(kp + 32 * KROW + ko0); kb1 = *(const bf16x8*)(kp + 32 * KROW + ko1);
    kb2 = *(const bf16x8*)(kp + 32 * KROW + ko2); kb3 = *(const bf16x8*)(kp + 32 * KROW + ko3);
  }
  LOADV(va0, va1, va2, va3, 0)
  __builtin_amdgcn_sched_barrier(0);
  S0 = MFMA(ka0, qf[0], Mneg); S0 = MFMA(ka1, qf[1], S0); S0 = MFMA(ka2, qf[2], S0); S0 = MFMA(ka3, qf[3], S0);
  if (two) { S1 = MFMA(kb0, qf[0], Mneg); S1 = MFMA(kb1, qf[1], S1); S1 = MFMA(kb2, qf[2], S1); S1 = MFMA(kb3, qf[3], S1); }
  float ls = 0.f;
#pragma unroll
  for (int i = 0; i < 16; ++i) { S0[i] = __builtin_amdgcn_exp2f(S0[i]); ls += S0[i]; }
  if (two) {
#pragma unroll
    for (int i = 0; i < 16; ++i) { S1[i] = __builtin_amdgcn_exp2f(S1[i]); ls += S1[i]; }
  }
  if (__any(!(ls <= 4194304.f))) {
    bf16x8 ra0 = *(const bf16x8*)(kp + ko0), ra1 = *(const bf16x8*)(kp + ko1), ra2 = *(const bf16x8*)(kp + ko2), ra3 = *(const bf16x8*)(kp + ko3);
#pragma unroll
    for (int i = 0; i < 16; ++i) { S0[i] = 0.f; S1[i] = 0.f; }
    S0 = MFMA(ra0, qf[0], S0); S0 = MFMA(ra1, qf[1], S0); S0 = MFMA(ra2, qf[2], S0); S0 = MFMA(ra3, qf[3], S0);
    if (two) {
      ra0 = *(const bf16x8*)(kp + 32 * KROW + ko0); ra1 = *(const bf16x8*)(kp + 32 * KROW + ko1);
      ra2 = *(const bf16x8*)(kp + 32 * KROW + ko2); ra3 = *(const bf16x8*)(kp + 32 * KROW + ko3);
      S1 = MFMA(ra0, qf[0], S1); S1 = MFMA(ra1, qf[1], S1); S1 = MFMA(ra2, qf[2], S1); S1 = MFMA(ra3, qf[3], S1);
    }
    float mx = S0[0];
#pragma unroll
    for (int i = 1; i < 16; ++i) mx = fmaxf(mx, S0[i]);
    if (two) {
#pragma unroll
      for (int i = 0; i < 16; ++i) mx = fmaxf(mx, S1[i]);
    }
    mx = fmaxf(mx, __shfl_xor(mx, 32));
    const float m_new = fmaxf(m_run, mx);
    const float alpha = __builtin_amdgcn_exp2f(m_run - m_new);
    m_run = m_new;
#pragma unroll
    for (int i = 0; i < 16; ++i) Mneg[i] = -m_new;
    l_run *= alpha;
#pragma unroll
    for (int dt = 0; dt < 4; ++dt)
#pragma unroll
      for (int i = 0; i < 16; ++i) O[dt][i] *= alpha;
    ls = 0.f;
#pragma unroll
    for (int i = 0; i < 16; ++i) { S0[i] = __builtin_amdgcn_exp2f(S0[i] - m_new); ls += S0[i]; }
    if (two) {
#pragma unroll
      for (int i = 0; i < 16; ++i) { S1[i] = __builtin_amdgcn_exp2f(S1[i] - m_new); ls += S1[i]; }
    }
  }
  l_run += ls;
  {
    const bf16x8 pb0 = PACKP(S0, 0);
    __builtin_amdgcn_sched_barrier(0);
    LOADV(vb0, vb1, vb2, vb3, 1)
    __builtin_amdgcn_sched_barrier(0);
    PVMFMA(va0, va1, va2, va3, pb0)
    const bf16x8 pb1 = PACKP(S0, 1);
    __builtin_amdgcn_sched_barrier(0);
    if (two) LOADV(va0, va1, va2, va3, 2)
    __builtin_amdgcn_sched_barrier(0);
    PVMFMA(vb0, vb1, vb2, vb3, pb1)
    if (two) {
      const bf16x8 pb2 = PACKP(S1, 0);
      __builtin_amdgcn_sched_barrier(0);
      LOADV(vb0, vb1, vb2, vb3, 3)
      __builtin_amdgcn_sched_barrier(0);
      PVMFMA(va0, va1, va2, va3, pb2)
      const bf16x8 pb3 = PACKP(S1, 1);
      __builtin_amdgcn_sched_barrier(0);
      PVMFMA(vb0, vb1, vb2, vb3, pb3)
    }
  }
}

template <bool SAMPLE>
DI void attn_item(const Params& p, int layer, int a, int h, unsigned char* smem) {
  const int t = tid(), l = t & 63, w = t >> 6, rg = w & 1, s = w >> 1, hb = l >> 5, r = l & 31;
  const int hh = 2 * h + s;
  const int qrow0 = SAMPLE ? SEQ + a * 32 : a * 64 + rg * 32;
  const bool active = SAMPLE ? (rg == 0) : true;
  const u16* H = p.H;
  bf16x8 qf[4];
  {
    const u16* qp = H + (size_t)(qrow0 + r) * INW + hh * 64 + hb * 8;
#pragma unroll
    for (int ks = 0; ks < 4; ++ks) qf[ks] = *(const bf16x8*)(qp + ks * 16);
  }
  f32x16 O[4];
#pragma unroll
  for (int dt = 0; dt < 4; ++dt)
#pragma unroll
    for (int i = 0; i < 16; ++i) O[dt][i] = 0.f;
  float m_run = -1e30f, l_run = 0.f;
  f32x16 Mneg;
#pragma unroll
  for (int i = 0; i < 16; ++i) Mneg[i] = 1e30f;
  u16* sm = (u16*)smem;

  __syncthreads();
  if (!SAMPLE) {
    const int ntiles = a + 1;
    const u16* kg = H + C_K + (2 * h) * 64;
    const u16* vg = H + C_V + h * 128;
    const int krow = w * 8 + (l >> 3);
    const u16* kq = kg + (size_t)krow * INW + ((l & 7) ^ ((krow >> 1) & 7)) * 8;
    const int vrow = w * 4 + (l >> 4);
    const u16* vq = vg + (size_t)vrow * INW + ((l & 15) ^ (((l >> 4) & 3) << 2)) * 8;
    const unsigned lb = __builtin_amdgcn_readfirstlane(lds_addr(smem) + w * 1024);
#define ATT_STAGE(BUF, KT)                                                                                \
    {                                                                                                     \
      const unsigned sb_ = lb + (BUF) * 32768;                                                            \
      const u16* k_ = kq + (size_t)(KT) * 64 * INW;                                                       \
      const u16* v_ = vq + (size_t)(KT) * 64 * INW;                                                       \
      glds16(k_, sb_); glds16(k_ + (size_t)32 * INW, sb_ + 4096);                                         \
      glds16(k_ + 64, sb_ + 8192); glds16(k_ + (size_t)32 * INW + 64, sb_ + 12288);                       \
      glds16(v_, sb_ + 16384); glds16(v_ + (size_t)16 * INW, sb_ + 16384 + 4096);                         \
      glds16(v_ + (size_t)32 * INW, sb_ + 16384 + 8192); glds16(v_ + (size_t)48 * INW, sb_ + 16384 + 12288); \
    }
    ATT_STAGE(0, 0)
    asm volatile("s_waitcnt vmcnt(0)" ::: "memory");
    __syncthreads();
    for (int kt = 0; kt < ntiles; ++kt) {
      const int buf = kt & 1;
      if (kt + 1 < ntiles) ATT_STAGE(buf ^ 1, kt + 1)
      __builtin_amdgcn_sched_barrier(0);
      const u16* kb = sm + buf * 16384;
      attn_compute<true>(kb, kb + 8192, qf, O, Mneg, m_run, l_run, true, s);
      asm volatile("s_waitcnt vmcnt(0)" ::: "memory");
      __syncthreads();
    }
  } else {
    const float* ck = p.cache_k + ((size_t)(layer * 32 + a) * 1024) * 512 + (2 * h) * 64;
    const float* cv = p.cache_v + ((size_t)(layer * 32 + a) * 1024) * 512 + h * 128;
    for (int j = 0; j < 9; ++j) {
      for (int g = 0; g < 2; ++g) {
        const int kt = 2 * j + g;
        u16* kb = sm + g * (ST_BYTES / 2);
        u16* vb = kb + ST_K;
        if (kt < 16) {
#pragma unroll 2
          for (int i = 0; i < 8; ++i) {
            const int cc = t + 256 * i;
            const int sh = cc >> 10, key = (cc >> 4) & 63, ch = cc & 15;
            const float4 v = *(const float4*)(ck + (size_t)(kt * 64 + key) * 512 + sh * 64 + ch * 4);
            *(uint2*)(kb + (sh * 64 + key) * KS_STRIDE + ch * 4) = make_uint2(pk(v.x, v.y), pk(v.z, v.w));
            const int vkey = cc >> 5, vch = cc & 31;
            const float4 u = *(const float4*)(cv + (size_t)(kt * 64 + vkey) * 512 + vch * 4);
            *(uint2*)(vb + vkey * VS_STRIDE + vch * 4) = make_uint2(pk(u.x, u.y), pk(u.z, u.w));
          }
        } else if (kt == 16) {
          const u16* kg = H + (size_t)(SEQ + a * 32) * INW + C_K + (2 * h) * 64;
          const u16* vg = H + (size_t)(SEQ + a * 32) * INW + C_V + h * 128;
#pragma unroll
          for (int i = 0; i < 2; ++i) {
            const int cc = t + 256 * i;
            const int sh = cc >> 8, key = (cc >> 3) & 31, ch = cc & 7;
            *(uint4*)(kb + (sh * 64 + key) * KS_STRIDE + ch * 8) = *(const uint4*)(kg + (size_t)key * INW + sh * 64 + ch * 8);
            const int vkey = cc >> 4, vch = cc & 15;
            *(uint4*)(vb + vkey * VS_STRIDE + vch * 8) = *(const uint4*)(vg + (size_t)vkey * INW + vch * 8);
          }
        }
      }
      __syncthreads();
      {
        const int kt = 2 * j + rg;
        const u16* kb = sm + rg * (ST_BYTES / 2);
        if (kt <= 16) attn_compute<false>(kb, kb + ST_K, qf, O, Mneg, m_run, l_run, kt < 16, s);
      }
      __syncthreads();
    }
    float* mgO = (float*)smem;
    float* mgML = (float*)(smem + 32768);
    if (rg == 1) {
#pragma unroll
      for (int dt = 0; dt < 4; ++dt)
#pragma unroll
        for (int i = 0; i < 16; ++i) mgO[(s * 128 + dt * 32 + crow(i, hb)) * 32 + r] = O[dt][i];
      mgML[(s * 64 + l) * 2] = m_run; mgML[(s * 64 + l) * 2 + 1] = l_run;
    }
    __syncthreads();
    if (rg == 0) {
      const float m1 = mgML[(s * 64 + l) * 2], l1 = mgML[(s * 64 + l) * 2 + 1];
      const float mm = fmaxf(m_run, m1);
      const float a0 = __builtin_amdgcn_exp2f(m_run - mm), a1 = __builtin_amdgcn_exp2f(m1 - mm);
#pragma unroll
      for (int dt = 0; dt < 4; ++dt)
#pragma unroll
        for (int i = 0; i < 16; ++i) O[dt][i] = O[dt][i] * a0 + mgO[(s * 128 + dt * 32 + crow(i, hb)) * 32 + r] * a1;
      l_run = l_run * a0 + l1 * a1;
      m_run = mm;
    }
    __syncthreads();
  }
  const int te = tid(), le = te & 63, re = le & 31, hbe = le >> 5, rge = (te >> 6) & 1, se = te >> 7;
  const bool acte = SAMPLE ? (rge == 0) : true;
  float lt = l_run + __shfl_xor(l_run, 32);
  const float inv_l = 1.f / lt;
  float* ex = (float*)smem;
  if (se == 1 && acte) {
#pragma unroll
    for (int dt = 0; dt < 4; ++dt)
#pragma unroll
      for (int i = 0; i < 16; ++i) ex[(rge * 128 + dt * 32 + crow(i, hbe)) * 32 + re] = O[dt][i] * inv_l;
  }
  __syncthreads();
  if (se == 0 && acte) {
    const float lam = __hip_atomic_load(p.lam + layer, __ATOMIC_RELAXED, __HIP_MEMORY_SCOPE_AGENT);
    const float li = __hip_atomic_load(p.lam + 4 + layer, __ATOMIC_RELAXED, __HIP_MEMORY_SCOPE_AGENT);
    float ss = 0.f;
#pragma unroll
    for (int dt = 0; dt < 4; ++dt)
#pragma unroll
      for (int i = 0; i < 16; ++i) {
        const float o = O[dt][i] * inv_l - lam * ex[(rge * 128 + dt * 32 + crow(i, hbe)) * 32 + re];
        O[dt][i] = o; ss += o * o;
      }
    ss += __shfl_xor(ss, 32);
    const float rs = rsqrtf(ss * (1.f / 128.f) + LN_EPS) * (1.f - li);
    const int row = (SAMPLE ? SEQ + a * 32 : a * 64 + rge * 32) + re;
    const u16* gp = H + (size_t)row * INW + C_GA + h * 128;
    u16* op = p.A1 + (size_t)row * 512 + h * 128;
    const float* sw = p.subln_w + layer * 128;
#pragma unroll
    for (int dt = 0; dt < 4; ++dt)
#pragma unroll
      for (int g4 = 0; g4 < 4; ++g4) {
        const int d = dt * 32 + 8 * g4 + 4 * hbe;
        const uint2 gv = *(const uint2*)(gp + d);
        const float4 wv = *(const float4*)(sw + d);
        const float y0 = O[dt][4 * g4 + 0] * rs * wv.x * siluf_(bflo(gv.x));
        const float y1 = O[dt][4 * g4 + 1] * rs * wv.y * siluf_(bfhi(gv.x));
        const float y2 = O[dt][4 * g4 + 2] * rs * wv.z * siluf_(bflo(gv.y));
        const float y3 = O[dt][4 * g4 + 3] * rs * wv.w * siluf_(bfhi(gv.y));
        *(uint2*)(op + d) = make_uint2(pk(y0, y1), pk(y2, y3));
      }
  }
}

DI void sgu_item(const Params& p, int layer, int chunk, int g, unsigned char* smem) {
  const int t = tid(), l = t & 63, w = t >> 6, wm = w >> 1, wn = w & 1, hb = l >> 5, r = l & 31;
  const int m0 = chunk * 128;
  const bool samp = chunk >= 128;
  u16* Asg = (u16*)smem;
  u16* Bsg = Asg + 128 * 72;
  float* st = (float*)(smem + 38912);
  const u16* H = p.H;
  __syncthreads();
  for (int rr = 0; rr < 32; ++rr) {
    const int row = w * 32 + rr;
    const uint4 v = *(const uint4*)(H + (size_t)(m0 + row) * INW + C_VG + l * 8);
    float x[8] = {bflo(v.x), bfhi(v.x), bflo(v.y), bfhi(v.y), bflo(v.z), bfhi(v.z), bflo(v.w), bfhi(v.w)};
    float s1 = 0.f, s2 = 0.f;
#pragma unroll
    for (int e = 0; e < 8; ++e) { s1 += x[e]; s2 += x[e] * x[e]; }
#pragma unroll
    for (int o = 32; o >= 1; o >>= 1) { s1 += __shfl_xor(s1, o); s2 += __shfl_xor(s2, o); }
    if (l == 0) {
      const float mean = s1 * (1.f / 512.f);
      const float var = fmaxf(s2 * (1.f / 512.f) - mean * mean, 0.f);
      st[row] = mean; st[128 + row] = rsqrtf(var + LN_EPS);
    }
  }
  __syncthreads();
  uint4 puu[8], pgg[8];
#pragma unroll
  for (int i = 0; i < 8; ++i) {
    const u16* hp = H + (size_t)(m0 + (t >> 4) + 16 * i) * INW + g * 128 + (t & 15) * 8;
    puu[i] = *(const uint4*)(hp + C_U); pgg[i] = *(const uint4*)(hp + C_GG);
  }
  f32x16 acc[2][2];
  zero_acc(acc);
  const float* Wg = p.w_s + ((size_t)(layer * 4 + g) * 128) * 128;
  const float* gam = p.sgu_g + layer * 512 + g * 128;
  const float* bet = p.sgu_b + layer * 512 + g * 128;
  const int q4 = (l & 15) >> 2, p4 = l & 3, blk = (l >> 4) & 1;
  for (int kh = 0; kh < 2; ++kh) {
#pragma unroll
    for (int i8 = 0; i8 < 8; ++i8) {
      const int cc = t + 256 * i8;
      const int i = cc >> 4, j4 = (cc & 15) * 4, j = kh * 64 + j4;
      float4 v;
      float e0, e1, e2, e3;
      if (!samp) {
        v = *(const float4*)(Wg + i * 128 + j);
        e0 = (j + 0 <= i) ? v.x : 0.f; e1 = (j + 1 <= i) ? v.y : 0.f; e2 = (j + 2 <= i) ? v.z : 0.f; e3 = (j + 3 <= i) ? v.w : 0.f;
      } else {
        const int i32 = i & 31, j32 = j & 31;
        v = *(const float4*)(Wg + i32 * 128 + j32);
        const bool same = (i >> 5) == (j >> 5);
        e0 = (same && j32 + 0 <= i32) ? v.x : 0.f; e1 = (same && j32 + 1 <= i32) ? v.y : 0.f;
        e2 = (same && j32 + 2 <= i32) ? v.z : 0.f; e3 = (same && j32 + 3 <= i32) ? v.w : 0.f;
      }
      *(uint2*)(Asg + i * 72 + j4) = make_uint2(pk(e0, e1), pk(e2, e3));
    }
#pragma unroll
    for (int i4 = 0; i4 < 4; ++i4) {
      const int cc = t + 256 * i4;
      const int jj = cc >> 4, dc = (cc & 15) * 8;
      const int jrow = kh * 64 + jj;
      const uint4 v = *(const uint4*)(H + (size_t)(m0 + jrow) * INW + C_VG + g * 128 + dc);
      const float mean = st[jrow], rstd = st[128 + jrow];
      const float4 g0 = *(const float4*)(gam + dc), g1 = *(const float4*)(gam + dc + 4);
      const float4 b0 = *(const float4*)(bet + dc), b1 = *(const float4*)(bet + dc + 4);
      const float y0 = (bflo(v.x) - mean) * rstd * g0.x + b0.x, y1 = (bfhi(v.x) - mean) * rstd * g0.y + b0.y;
      const float y2 = (bflo(v.y) - mean) * rstd * g0.z + b0.z, y3 = (bfhi(v.y) - mean) * rstd * g0.w + b0.w;
      const float y4 = (bflo(v.z) - mean) * rstd * g1.x + b1.x, y5 = (bfhi(v.z) - mean) * rstd * g1.y + b1.y;
      const float y6 = (bflo(v.w) - mean) * rstd * g1.z + b1.z, y7 = (bfhi(v.w) - mean) * rstd * g1.w + b1.w;
      *(uint4*)(Bsg + jj * VS_STRIDE + dc) = make_uint4(pk(y0, y1), pk(y2, y3), pk(y4, y5), pk(y6, y7));
      if (samp) {
        float* o = p.out + OFF_GV + ((size_t)layer * 1024 + (m0 - SEQ) + jrow) * 512 + g * 128 + dc;
        *(float4*)o = make_float4(y0, y1, y2, y3);
        *(float4*)(o + 4) = make_float4(y4, y5, y6, y7);
      }
    }
    __syncthreads();
    const u16* as = Asg + (wm * 64 + r) * 72 + hb * 8;
    const u16* bs = Bsg + (8 * hb + q4) * VS_STRIDE + wn * 64 + blk * 16 + p4 * 4;
#pragma unroll
    for (int ks = 0; ks < 4; ++ks) {
      bf16x8 a0 = *(const bf16x8*)(as + ks * 16), a1 = *(const bf16x8*)(as + 32 * 72 + ks * 16);
      const u16* bk = bs + ks * 16 * VS_STRIDE;
      bf16x8 b0 = cat8(tr_read(bk), tr_read(bk + 4 * VS_STRIDE));
      bf16x8 b1 = cat8(tr_read(bk + 32), tr_read(bk + 4 * VS_STRIDE + 32));
      acc[0][0] = MFMA(a0, b0, acc[0][0]); acc[0][1] = MFMA(a0, b1, acc[0][1]);
      acc[1][0] = MFMA(a1, b0, acc[1][0]); acc[1][1] = MFMA(a1, b1, acc[1][1]);
    }
    __syncthreads();
  }
  const float* bsp = p.b_s + (size_t)(layer * 4 + g) * 128;
  acc_to_lds(acc, smem);
  __syncthreads();
  {
    const float* ct = (const float*)smem;
    const int c8 = (t & 15) * 8;
#pragma unroll
    for (int i = 0; i < 8; ++i) {
      const int rl = (t >> 4) + 16 * i;
      const int row = m0 + rl;
      const float* cp = ct + rl * CT_STRIDE + c8;
      const float4 v0 = *(const float4*)cp, v1 = *(const float4*)(cp + 4);
      const float bias = bsp[samp ? (rl & 31) : rl];
      const uint4 uu = puu[i], gg = pgg[i];
      float4 o0, o1;
      o0.x = (v0.x + bias) * bflo(uu.x) * siluf_(bflo(gg.x)); o0.y = (v0.y + bias) * bfhi(uu.x) * siluf_(bfhi(gg.x));
      o0.z = (v0.z + bias) * bflo(uu.y) * siluf_(bflo(gg.y)); o0.w = (v0.w + bias) * bfhi(uu.y) * siluf_(bfhi(gg.y));
      o1.x = (v1.x + bias) * bflo(uu.z) * siluf_(bflo(gg.z)); o1.y = (v1.y + bias) * bfhi(uu.z) * siluf_(bfhi(gg.z));
      o1.z = (v1.z + bias) * bflo(uu.w) * siluf_(bflo(gg.w)); o1.w = (v1.w + bias) * bfhi(uu.w) * siluf_(bfhi(gg.w));
      *(uint4*)(p.A2 + (size_t)row * 512 + g * 128 + c8) = pack8(o0, o1);
    }
  }
}

DI void phaseB(const Params& p, int layer_slot, unsigned char* smem) {
  const int layer = layer_slot & 3;
  int* s_item = (int*)(smem + 77824);
  const bool stat = gridDim.x == 512;
  const int sq = 2 * (blockIdx.x >> 3) + ((blockIdx.x >> 2) & 1), sh = blockIdx.x & 3;
  const int total = stat ? 672 : 1696;
  for (int n = 0;; ++n) {
    int kind, a, h;
    if (stat && n < 2) { kind = 1; a = n ? sq : 255 - sq; h = sh; }
    else {
      __syncthreads();
      if (threadIdx.x == 0) *s_item = atomicAdd(p.counters + layer_slot, 1);
      __syncthreads();
      const int it = *s_item;
      if (it >= total) break;
      if (it < 128) { kind = 0; a = it >> 2; h = it & 3; }
      else if (it < 672) { kind = 2; a = (it - 128) >> 2; h = (it - 128) & 3; }
      else { kind = 1; a = 255 - ((it - 672) >> 2); h = (it - 672) & 3; }
    }
    if (kind == 0) attn_item<true>(p, layer, a, h, smem);
    else if (kind == 1) attn_item<false>(p, layer, a, h, smem);
    else sgu_item(p, layer, a, h, smem);
  }
}

DI void phaseC1_tile(const Params& p, int layer, int mt, int nt, unsigned char* smem) {
  const int t = tid();
  const int c8 = (t & 15) * 8;
  const float* ct = (const float*)smem;
  f32x16 acc[2][2];
  uint4 ya[8], gma[8], gmb[8];
#pragma unroll
  for (int i = 0; i < 8; ++i) {
    const u16* hp = p.H + (size_t)(mt * 128 + (t >> 4) + 16 * i) * INW + nt * 128 + c8;
    gma[i] = *(const uint4*)(hp + C_MA); gmb[i] = *(const uint4*)(hp + C_MB);
  }
  zero_acc(acc);
  gemm_core(p.A1 + (size_t)mt * 128 * 512, 512, p.WoaT + ((size_t)layer * 1024 + nt * 128) * 512, 512, 512, acc, smem);
  acc_to_lds(acc, smem);
  __syncthreads();
#pragma unroll
  for (int i = 0; i < 8; ++i) {
    const int rl = (t >> 4) + 16 * i;
    const int row = mt * 128 + rl;
    const float* cp = ct + rl * CT_STRIDE + c8;
    const float4 v0 = *(const float4*)cp, v1 = *(const float4*)(cp + 4);
    const uint4 g = gma[i];
    ya[i] = make_uint4(pk(v0.x * sigmoidf_(bflo(g.x)), v0.y * sigmoidf_(bfhi(g.x))), pk(v0.z * sigmoidf_(bflo(g.y)), v0.w * sigmoidf_(bfhi(g.y))),
                       pk(v1.x * sigmoidf_(bflo(g.z)), v1.y * sigmoidf_(bfhi(g.z))), pk(v1.z * sigmoidf_(bflo(g.w)), v1.w * sigmoidf_(bfhi(g.w))));
  }
  zero_acc(acc);
  gemm_core(p.A2 + (size_t)mt * 128 * 512, 512, p.WogT + ((size_t)layer * 1024 + nt * 128) * 512, 512, 512, acc, smem);
  acc_to_lds(acc, smem);
  __syncthreads();
#pragma unroll
  for (int i = 0; i < 8; ++i) {
    const int rl = (t >> 4) + 16 * i;
    const int row = mt * 128 + rl;
    const float* cp = ct + rl * CT_STRIDE + c8;
    const float4 v0 = *(const float4*)cp, v1 = *(const float4*)(cp + 4);
    const uint4 g = gmb[i];
    float4 o0, o1;
    const float4 ma0 = make_float4(bflo(ya[i].x), bfhi(ya[i].x), bflo(ya[i].y), bfhi(ya[i].y));
    const float4 ma1 = make_float4(bflo(ya[i].z), bfhi(ya[i].z), bflo(ya[i].w), bfhi(ya[i].w));
    o0.x = ma0.x + v0.x * sigmoidf_(bflo(g.x)); o0.y = ma0.y + v0.y * sigmoidf_(bfhi(g.x));
    o0.z = ma0.z + v0.z * sigmoidf_(bflo(g.y)); o0.w = ma0.w + v0.w * sigmoidf_(bfhi(g.y));
    o1.x = ma1.x + v1.x * sigmoidf_(bflo(g.z)); o1.y = ma1.y + v1.y * sigmoidf_(bfhi(g.z));
    o1.z = ma1.z + v1.z * sigmoidf_(bflo(g.w)); o1.w = ma1.w + v1.w * sigmoidf_(bfhi(g.w));
    *(uint4*)(p.Mg + (size_t)row * 1024 + nt * 128 + c8) = pack8(o0, o1);
  }
}

DI void phaseC2_tile(const Params& p, int layer, int mt, int nt, unsigned char* smem) {
  const int t = tid();
  const int c8 = (t & 15) * 8;
  const float* ct = (const float*)smem;
  const float* xsrc = layer == 0 ? (mt < 128 ? p.x_prompt : p.x_sample - (size_t)SEQ * 1024) : p.Xf;
  float4 xr0[8], xr1[8];
#pragma unroll
  for (int i = 0; i < 8; ++i) {
    const float* xp = xsrc + (size_t)(mt * 128 + (t >> 4) + 16 * i) * 1024 + nt * 128 + c8;
    xr0[i] = *(const float4*)xp; xr1[i] = *(const float4*)(xp + 4);
  }
  f32x16 acc[2][2];
  zero_acc(acc);
  gemm_core(p.Mg + (size_t)mt * 128 * 1024, 1024, p.WoutT + ((size_t)layer * 1024 + nt * 128) * 1024, 1024, 1024, acc, smem);
  acc_to_lds(acc, smem);
  __syncthreads();
#pragma unroll
  for (int i = 0; i < 8; ++i) {
    const int rl = (t >> 4) + 16 * i;
    const int row = mt * 128 + rl;
    const float* cp = ct + rl * CT_STRIDE + c8;
    const float4 v0 = *(const float4*)cp, v1 = *(const float4*)(cp + 4);
    const float4 x0 = xr0[i], x1 = xr1[i];
    float* op = p.Xpre + (size_t)row * 1024 + nt * 128 + c8;
    *(float4*)op = make_float4(ALPHA_RES * x0.x + v0.x, ALPHA_RES * x0.y + v0.y, ALPHA_RES * x0.z + v0.z, ALPHA_RES * x0.w + v0.w);
    *(float4*)(op + 4) = make_float4(ALPHA_RES * x1.x + v1.x, ALPHA_RES * x1.y + v1.y, ALPHA_RES * x1.z + v1.z, ALPHA_RES * x1.w + v1.w);
  }
}

DI void phaseLN(const Params& p, int layer) {
  const int t = tid(), l = t & 63, w = t >> 6;
  const float* g = p.ln_g + layer * 1024;
  const float* b = p.ln_b + layer * 1024;
  float* dstf = layer == 3 ? p.out : p.Xf;
  for (int row = blockIdx.x * 4 + w; row < MTOK; row += gridDim.x * 4) {
    const float* src = p.Xpre + (size_t)row * 1024;
    float4 v[4];
    float s1 = 0.f;
#pragma unroll
    for (int i = 0; i < 4; ++i) { v[i] = *(const float4*)(src + i * 256 + l * 4); s1 += v[i].x + v[i].y + v[i].z + v[i].w; }
#pragma unroll
    for (int o = 32; o >= 1; o >>= 1) s1 += __shfl_xor(s1, o);
    const float mean = s1 * (1.f / 1024.f);
    float s2 = 0.f;
#pragma unroll
    for (int i = 0; i < 4; ++i) {
      v[i].x -= mean; v[i].y -= mean; v[i].z -= mean; v[i].w -= mean;
      s2 += v[i].x * v[i].x + v[i].y * v[i].y + v[i].z * v[i].z + v[i].w * v[i].w;
    }
#pragma unroll
    for (int o = 32; o >= 1; o >>= 1) s2 += __shfl_xor(s2, o);
    const float rstd = rsqrtf(s2 * (1.f / 1024.f) + LN_EPS);
#pragma unroll
    for (int i = 0; i < 4; ++i) {
      const int c = i * 256 + l * 4;
      const float4 gv = *(const float4*)(g + c), bv = *(const float4*)(b + c);
      const float y0 = v[i].x * rstd * gv.x + bv.x, y1 = v[i].y * rstd * gv.y + bv.y;
      const float y2 = v[i].z * rstd * gv.z + bv.z, y3 = v[i].w * rstd * gv.w + bv.w;
      *(float4*)(dstf + (size_t)row * 1024 + c) = make_float4(y0, y1, y2, y3);
      if (layer < 3) *(uint2*)(p.Xb + (size_t)row * 1024 + c) = make_uint2(pk(y0, y1), pk(y2, y3));
    }
  }
}

__global__ void __launch_bounds__(256, 2) fwd_megakernel(Params p) {
  __shared__ __attribute__((aligned(16))) unsigned char smem[SMEM_BYTES];
  __shared__ uint4 xb_words;
  cg::grid_group grid = cg::this_grid();
  if (threadIdx.x == 0) xb_words = make_uint4(0u, 0u, 0u, 0u);
  __syncthreads();
  XcdBarrier xb = xcd_barrier_post(p.bar, (volatile LAS unsigned*)&xb_words);
  for (int ph = p.ph_lo; ph < p.ph_hi; ++ph) {
    if (ph == 0) {
      phase0(p, smem);
    } else {
      const int layer = (ph - 1) / 5, sub = (ph - 1) % 5;
      const int nrep = (sub == PROBE_REP || (PROBE_REP == 6 && sub >= 2)) ? 2 : 1;
      for (int rep = 0; rep < nrep; ++rep) {
        if (rep) xcd_barrier(xb);
        if (sub == 0) {
          for (int tix = blockIdx.x; tix < 136 * 22; tix += gridDim.x) phaseA_tile(p, layer, tix / 22, tix % 22, smem);
        } else if (sub == 1) {
          phaseB(p, layer + 4 * rep, smem);
        } else if (sub == 2) {
          for (int tix = blockIdx.x; tix < 136 * 8; tix += gridDim.x) phaseC1_tile(p, layer, tix >> 3, tix & 7, smem);
        } else if (sub == 3) {
          for (int tix = blockIdx.x; tix < 136 * 8; tix += gridDim.x) phaseC2_tile(p, layer, tix >> 3, tix & 7, smem);
        } else {
          phaseLN(p, layer);
        }
      }
    }
    if (PROBE_REP == 5 && ph + 1 < p.ph_hi) xcd_barrier(xb);
    if (ph + 1 < p.ph_hi) { if (p.ph_hi < 0) grid.sync(); else xcd_barrier(xb); }
  }
}

extern "C" void kernel_launch(void* const* d_in, const int* in_sizes, int n_in, void* d_out, int out_size, void* d_ws, size_t ws_size, hipStream_t stream) {
  static int grid_blocks = 0;
  if (!grid_blocks) {
    int dev = 0, cus = 0, per_cu = 0;
    hipGetDevice(&dev);
    hipDeviceGetAttribute(&cus, hipDeviceAttributeMultiprocessorCount, dev);
    hipOccupancyMaxActiveBlocksPerMultiprocessor(&per_cu, fwd_megakernel, 256, 0);
    if (per_cu < 1) per_cu = 1;
    if (per_cu > 2) per_cu = 2;
    grid_blocks = cus * per_cu;
  }
  Params p{};
  const float** ins = (const float**)&p;
  for (int i = 0; i < 19; ++i) ins[i] = (const float*)d_in[i];
  p.out = (float*)d_out;
  unsigned char* ws = (unsigned char*)d_ws;
  size_t off = 0;
  auto take = [&](size_t bytes) { unsigned char* q = ws + off; off += (bytes + 255) & ~(size_t)255; return q; };
  p.WinT = (u16*)take((size_t)4 * 5632 * 1024 * 2);
  p.WoaT = (u16*)take((size_t)4 * 1024 * 512 * 2);
  p.WogT = (u16*)take((size_t)4 * 1024 * 512 * 2);
  p.WoutT = (u16*)take((size_t)4 * 1024 * 1024 * 2);
  p.Xb = (u16*)take((size_t)MTOK * 1024 * 2);
  p.H = (u16*)take((size_t)MTOK * INW * 2);
  p.A1 = (u16*)take((size_t)MTOK * 512 * 2);
  p.A2 = (u16*)take((size_t)MTOK * 512 * 2);
  p.Mg = (u16*)take((size_t)MTOK * 1024 * 2);
  p.Xf = (float*)take((size_t)MTOK * 1024 * 4);
  p.Xpre = (float*)take((size_t)MTOK * 1024 * 4);
  p.rope = (float*)take((size_t)SEQ * 32 * 2 * 4);
  p.lam = (float*)take(256);
  p.counters = (int*)take(256);
  p.bar = (unsigned*)take(XCD_BAR_WORDS * 4);
  hipMemsetAsync(p.bar, 0, XCD_BAR_WORDS * 4, stream);
#if MULTI_LAUNCH
  for (int ph = 0; ph < 21; ++ph) {
    p.ph_lo = ph; p.ph_hi = ph + 1;
    hipLaunchKernelGGL(fwd_megakernel, dim3(grid_blocks), dim3(256), 0, stream, p);
  }
#else
  p.ph_lo = 0; p.ph_hi = 21;
  void* args[] = {&p};
  hipError_t e = hipLaunchCooperativeKernel((void*)fwd_megakernel, dim3(grid_blocks), dim3(256), args, 0, stream);
  if (e != hipSuccess) fprintf(stderr, "cooperative launch failed: %s (grid %d)\n", hipGetErrorString(e), grid_blocks);
#endif
}
```

```cpp
#include <hip/hip_runtime.h>
#include <hip/hip_cooperative_groups.h>
#include <cstdio>
namespace cg = cooperative_groups;

#ifndef PROBE_REP
#define PROBE_REP -1
#endif
#ifndef MULTI_LAUNCH
#define MULTI_LAUNCH 0
#endif

#define DI __device__ __forceinline__
typedef unsigned short u16;
typedef __attribute__((ext_vector_type(8))) short bf16x8;
typedef __attribute__((ext_vector_type(4))) short s16x4;
typedef __attribute__((ext_vector_type(16))) float f32x16;
typedef __attribute__((ext_vector_type(2))) float f32x2;
typedef __attribute__((ext_vector_type(2))) __bf16 bf16x2_t;

constexpr int SEQ = 16384, MTOK = 17408, INW = 5632;
constexpr int C_K = 512, C_V = 1024, C_GA = 1536, C_U = 2048, C_VG = 2560, C_GG = 3072, C_MA = 3584, C_MB = 4608;
constexpr size_t OFF_KP = 17825792, OFF_VP = 51380224, OFF_KS = 84934656, OFF_VS = 87031808, OFF_GV = 89128960;
constexpr int SMEM_BYTES = 77824 + 64;
constexpr float ALPHA_RES = 1.681792830507429f;
constexpr float LN_EPS = 1e-5f;

struct Params {
  const float *x_prompt, *x_sample, *cache_k, *cache_v, *w_in, *w_oa, *w_og, *w_out;
  const float *lq1, *lk1, *lq2, *lk2, *subln_w, *sgu_g, *sgu_b, *w_s, *b_s, *ln_g, *ln_b;
  float* out;
  u16 *WinT, *WoaT, *WogT, *WoutT, *Xb, *H, *A1, *A2, *Mg;
  float *Xf, *Xpre, *rope, *lam;
  int* counters;
  unsigned* bar;
  int ph_lo, ph_hi;
};

DI unsigned pk(float a, float b) { f32x2 x = {a, b}; bf16x2_t y = __builtin_convertvector(x, bf16x2_t); return __builtin_bit_cast(unsigned, y); }
DI u16 f2bf(float a) { return (u16)(pk(a, 0.f) & 0xffffu); }
DI float bf2f(u16 h) { return __uint_as_float(((unsigned)h) << 16); }
DI float bflo(unsigned u) { return __uint_as_float(u << 16); }
DI float bfhi(unsigned u) { return __uint_as_float(u & 0xffff0000u); }
DI int tid() { int t = threadIdx.x; asm volatile("" : "+v"(t)); return t; }
DI int crow(int i, int hb) { return (i & 3) + 8 * (i >> 2) + 4 * hb; }
DI float sigmoidf_(float x) { return 1.f / (1.f + __expf(-x)); }
DI float siluf_(float x) { return x / (1.f + __expf(-x)); }
#define MFMA(a, b, c) __builtin_amdgcn_mfma_f32_32x32x16_bf16((a), (b), (c), 0, 0, 0)
typedef __attribute__((address_space(3))) s16x4 lds_s16x4;
typedef __attribute__((address_space(3))) unsigned lds_u32;
DI void glds16(const void* g, unsigned lds_base) {
  unsigned sv;
  asm volatile("s_mov_b32 %0, m0\n\ts_mov_b32 m0, %2\n\ts_nop 0\n\tglobal_load_lds_dwordx4 %1, off\n\ts_mov_b32 m0, %0" : "=&s"(sv) : "v"(g), "s"(lds_base) : "memory");
}
DI unsigned lds_addr(const void* p) { return (unsigned)(size_t)(__attribute__((address_space(3))) const unsigned char*)p; }
DI s16x4 tr_read(const u16* p) { return __builtin_amdgcn_ds_read_tr16_b64_v4i16((lds_s16x4*)p); }
DI bf16x8 cat8(s16x4 lo, s16x4 hi) { return __builtin_shufflevector(lo, hi, 0, 1, 2, 3, 4, 5, 6, 7); }


#define XB_TMO      128
#define XB_XCNT(j)  (256  + 64 * (j))
#define XB_XSUB(j)  (1280 + 64 * (j))
#define XB_XGEN(j)  (2304 + 64 * (j))
#define XB_TOP      3328
#define XB_TOPGEN   3392
#define XCD_BAR_WORDS 3456
#define XB_SPIN_CAP (1u << 24)
#define LAS __attribute__((address_space(3)))
DI unsigned xb_ld(unsigned* p)              { return __hip_atomic_load(p, __ATOMIC_RELAXED, __HIP_MEMORY_SCOPE_AGENT); }
DI unsigned xb_add(unsigned* p, unsigned v) { return __hip_atomic_fetch_add(p, v, __ATOMIC_RELAXED, __HIP_MEMORY_SCOPE_AGENT); }
DI unsigned xb_xcc_id() { return (unsigned)__builtin_amdgcn_s_getreg((3 << 11) | 20) & 0xFu; }
#define XB_SPIN(cond, bar) do { unsigned _sp = 0; while (cond) { __builtin_amdgcn_s_sleep(1); \
    if ((++_sp & 255u) == 0u) { if (xb_ld(&(bar)[XB_TMO])) break; if (_sp > XB_SPIN_CAP) { atomicAdd(&(bar)[XB_TMO], 1u); break; } } } } while (0)
struct XcdBarrier { unsigned* bar; unsigned x; volatile LAS unsigned* st; };
DI XcdBarrier xcd_barrier_post(unsigned* bar, volatile LAS unsigned* st) {
  XcdBarrier b; b.bar = bar; b.x = xb_xcc_id(); b.st = st;
  if (threadIdx.x == 0) (void)xb_add(&bar[XB_XCNT(b.x)], 1u);
  return b;
}
DI void xcd_barrier_complete(unsigned* bar, unsigned x, unsigned& nloc, unsigned& nx) {
  const unsigned G = gridDim.x * gridDim.y * gridDim.z;
  unsigned sum, cnt, mine, sp = 0u;
  for (;;) {
    sum = 0u; cnt = 0u; mine = 0u;
#pragma unroll
    for (unsigned j = 0; j < 16; ++j) { const unsigned c = xb_ld(&bar[XB_XCNT(j)]); sum += c; cnt += (c > 0u) ? 1u : 0u; mine = (j == x) ? c : mine; }
    if (sum == G) break;
    __builtin_amdgcn_s_sleep(1);
    if ((++sp & 255u) == 0u) { if (xb_ld(&bar[XB_TMO])) break; if (sp > XB_SPIN_CAP) { atomicAdd(&bar[XB_TMO], 1u); break; } }
  }
  nloc = mine > 0u ? mine : 1u; nx = cnt > 0u ? cnt : 1u;
}
DI void xcd_barrier(const XcdBarrier& b) {
  asm volatile("s_waitcnt vmcnt(0)" ::: "memory");
  __syncthreads();
  if (threadIdx.x == 0) {
    unsigned* bar = b.bar;
    __builtin_amdgcn_s_waitcnt(0);
    unsigned nloc = b.st[0], nx = b.st[1];
    if (nloc == 0u) { xcd_barrier_complete(bar, b.x, nloc, nx); b.st[0] = nloc; b.st[1] = nx; }
    const unsigned old = xb_add(&bar[XB_XSUB(b.x)], 1u);
    const unsigned gen = old / nloc;
    if (old + 1u == (gen + 1u) * nloc) {
      __builtin_amdgcn_fence(__ATOMIC_RELEASE, "agent");
      asm volatile("s_waitcnt vmcnt(0)" ::: "memory");
      const unsigned og = xb_add(&bar[XB_TOP], 1u);
      const unsigned tg = og / nx;
      if (og + 1u == (tg + 1u) * nx) xb_add(&bar[XB_TOPGEN], 1u);
      else XB_SPIN(xb_ld(&bar[XB_TOPGEN]) == tg, bar);
      __builtin_amdgcn_fence(__ATOMIC_ACQUIRE, "agent");
      xb_add(&bar[XB_XGEN(b.x)], 1u);
      asm volatile("s_waitcnt vmcnt(0)" ::: "memory");
    } else {
      XB_SPIN(xb_ld(&bar[XB_XGEN(b.x)]) == gen, bar);
      __builtin_amdgcn_fence(__ATOMIC_ACQUIRE, "agent");
      asm volatile("s_waitcnt vmcnt(0)" ::: "memory");
    }
  }
  __syncthreads();
}

DI void gemm_core(const u16* __restrict__ A, int lda, const u16* __restrict__ Bt, int ldb, int K,
                  f32x16 (&acc)[2][2], unsigned char* smem) {
  const int t = tid(), l = t & 63, w = t >> 6, wm = w >> 1, wn = w & 1, hb = l >> 5, r = l & 31;
  const int grow = w * 8 + (l >> 3);
  const int gch = (l & 7) ^ ((grow >> 1) & 7);
  const u16* ag = A + (size_t)grow * lda + gch * 8;
  const u16* bg = Bt + (size_t)grow * ldb + gch * 8;
  const unsigned lbase = __builtin_amdgcn_readfirstlane(lds_addr(smem) + w * 1024);
#define GM_STAGE(BUF, KO)                                                                                        \
  {                                                                                                              \
    const unsigned sa_ = lbase + (BUF) * 32768;                                                                  \
    _Pragma("unroll") for (int i = 0; i < 4; ++i) {                                                              \
      glds16(ag + (size_t)(32 * i) * lda + (KO), sa_ + i * 4096);                                                \
      glds16(bg + (size_t)(32 * i) * ldb + (KO), sa_ + 16384 + i * 4096);                                        \
    }                                                                                                            \
  }
  __syncthreads();
  GM_STAGE(0, 0)
  asm volatile("s_waitcnt vmcnt(0)" ::: "memory");
  __syncthreads();
  const int sw = (r >> 1) & 7;
  const int o0 = ((0 + hb) ^ sw) * 8, o1 = ((2 + hb) ^ sw) * 8, o2 = ((4 + hb) ^ sw) * 8, o3 = ((6 + hb) ^ sw) * 8;
  const int nk = K >> 6;
  for (int kt = 0; kt < nk; ++kt) {
    const int buf = kt & 1;
    if (kt + 1 < nk) GM_STAGE(buf ^ 1, (kt + 1) * 64)
    __builtin_amdgcn_sched_barrier(0);
    const u16* as = (const u16*)(smem + buf * 32768) + (wm * 64 + r) * 64;
    const u16* bs = (const u16*)(smem + buf * 32768 + 16384) + (wn * 64 + r) * 64;
#define GM_LDF(A0, A1, B0, B1, OFF)                                                       \
    A0 = *(const bf16x8*)(as + (OFF)); A1 = *(const bf16x8*)(as + 32 * 64 + (OFF));       \
    B0 = *(const bf16x8*)(bs + (OFF)); B1 = *(const bf16x8*)(bs + 32 * 64 + (OFF));
#define GM_MM(A0, A1, B0, B1)                                                             \
    acc[0][0] = MFMA(A0, B0, acc[0][0]); acc[0][1] = MFMA(A0, B1, acc[0][1]);             \
    acc[1][0] = MFMA(A1, B0, acc[1][0]); acc[1][1] = MFMA(A1, B1, acc[1][1]);
    {
      bf16x8 xa0, xa1, xb0, xb1, ya0, ya1, yb0, yb1;
      GM_LDF(xa0, xa1, xb0, xb1, o0)
      GM_LDF(ya0, ya1, yb0, yb1, o1)
      __builtin_amdgcn_sched_barrier(0);
      GM_MM(xa0, xa1, xb0, xb1)
      __builtin_amdgcn_sched_barrier(0);
      GM_LDF(xa0, xa1, xb0, xb1, o2)
      __builtin_amdgcn_sched_barrier(0);
      GM_MM(ya0, ya1, yb0, yb1)
      __builtin_amdgcn_sched_barrier(0);
      GM_LDF(ya0, ya1, yb0, yb1, o3)
      __builtin_amdgcn_sched_barrier(0);
      GM_MM(xa0, xa1, xb0, xb1)
      __builtin_amdgcn_sched_barrier(0);
      GM_MM(ya0, ya1, yb0, yb1)
    }
    asm volatile("s_waitcnt vmcnt(0)" ::: "memory");
    __syncthreads();
  }
}


DI void gemm_core_wide(const u16* __restrict__ A, int lda, const u16* __restrict__ Bt, int ldb, int K,
                       f32x16 (&acc)[2][4], unsigned char* smem) {
  const int t = tid(), l = t & 63, w = t >> 6, wm = w >> 1, wn = w & 1, hb = l >> 5, r = l & 31;
  const int grow = w * 16 + (l >> 2);
  const int gch = (l & 3) ^ ((l >> 4) & 3);
  const u16* ag = A + (size_t)grow * lda + gch * 8;
  const u16* bg = Bt + (size_t)grow * ldb + gch * 8;
  const unsigned lbase = __builtin_amdgcn_readfirstlane(lds_addr(smem) + w * 1024);
#define GW_STAGE(SLOT, KO)                                                                  \
  {                                                                                         \
    const unsigned sa_ = lbase + (SLOT) * 24576;                                            \
    glds16(ag + (KO), sa_);                                                                 \
    glds16(ag + (size_t)64 * lda + (KO), sa_ + 4096);                                       \
    glds16(bg + (KO), sa_ + 8192);                                                          \
    glds16(bg + (size_t)64 * ldb + (KO), sa_ + 8192 + 4096);                                \
    glds16(bg + (size_t)128 * ldb + (KO), sa_ + 8192 + 8192);                               \
    glds16(bg + (size_t)192 * ldb + (KO), sa_ + 8192 + 12288);                              \
  }
  __syncthreads();
  GW_STAGE(0, 0)
  GW_STAGE(1, 32)
  const int sw = (r >> 2) & 3;
  const int o0 = ((0 + hb) ^ sw) * 8, o1 = ((2 + hb) ^ sw) * 8;
  const int nk = K >> 5;
  int slot = 0;
  for (int kt = 0; kt < nk; ++kt) {
    if (kt + 1 < nk) asm volatile("s_waitcnt vmcnt(6)" ::: "memory"); else asm volatile("s_waitcnt vmcnt(0)" ::: "memory");
    __syncthreads();
    if (kt + 2 < nk) { const int s2 = slot >= 1 ? slot - 1 : 2; GW_STAGE(s2, (kt + 2) * 32) }
    __builtin_amdgcn_sched_barrier(0);
    const u16* as = (const u16*)(smem + slot * 24576) + (wm * 64 + r) * 32;
    const u16* bs = (const u16*)(smem + slot * 24576 + 8192) + (wn * 128 + r) * 32;
    {
      bf16x8 a0 = *(const bf16x8*)(as + o0), a1 = *(const bf16x8*)(as + 32 * 32 + o0);
      bf16x8 b0 = *(const bf16x8*)(bs + o0), b1 = *(const bf16x8*)(bs + 32 * 32 + o0);
      bf16x8 b2 = *(const bf16x8*)(bs + 64 * 32 + o0), b3 = *(const bf16x8*)(bs + 96 * 32 + o0);
      bf16x8 c0 = *(const bf16x8*)(as + o1), c1 = *(const bf16x8*)(as + 32 * 32 + o1);
      bf16x8 d0 = *(const bf16x8*)(bs + o1), d1 = *(const bf16x8*)(bs + 32 * 32 + o1);
      bf16x8 d2 = *(const bf16x8*)(bs + 64 * 32 + o1), d3 = *(const bf16x8*)(bs + 96 * 32 + o1);
      acc[0][0] = MFMA(a0, b0, acc[0][0]); acc[0][1] = MFMA(a0, b1, acc[0][1]); acc[0][2] = MFMA(a0, b2, acc[0][2]); acc[0][3] = MFMA(a0, b3, acc[0][3]);
      acc[1][0] = MFMA(a1, b0, acc[1][0]); acc[1][1] = MFMA(a1, b1, acc[1][1]); acc[1][2] = MFMA(a1, b2, acc[1][2]); acc[1][3] = MFMA(a1, b3, acc[1][3]);
      acc[0][0] = MFMA(c0, d0, acc[0][0]); acc[0][1] = MFMA(c0, d1, acc[0][1]); acc[0][2] = MFMA(c0, d2, acc[0][2]); acc[0][3] = MFMA(c0, d3, acc[0][3]);
      acc[1][0] = MFMA(c1, d0, acc[1][0]); acc[1][1] = MFMA(c1, d1, acc[1][1]); acc[1][2] = MFMA(c1, d2, acc[1][2]); acc[1][3] = MFMA(c1, d3, acc[1][3]);
    }
    slot = slot == 2 ? 0 : slot + 1;
  }
}

constexpr int CT_STRIDE = 132;
DI void acc_to_lds(const f32x16 (&acc)[2][2], unsigned char* smem) {
  const int t = tid(), l = t & 63, w = t >> 6, wm = w >> 1, wn = w & 1, hb = l >> 5, r = l & 31;
  float* base = (float*)smem + (wm * 64 + 4 * hb) * CT_STRIDE + wn * 64 + r;
#pragma unroll
  for (int tm = 0; tm < 2; ++tm)
#pragma unroll
    for (int tn = 0; tn < 2; ++tn)
#pragma unroll
      for (int i = 0; i < 16; ++i) base[(tm * 32 + (i & 3) + 8 * (i >> 2)) * CT_STRIDE + tn * 32] = acc[tm][tn][i];
}
typedef __attribute__((ext_vector_type(4))) float f32x4_t;
DI void nt_store4(float* p, const float4& v) { f32x4_t x = {v.x, v.y, v.z, v.w}; __builtin_nontemporal_store(x, (f32x4_t*)p); }
DI uint4 pack8(const float4& a, const float4& b) { return make_uint4(pk(a.x, a.y), pk(a.z, a.w), pk(b.x, b.y), pk(b.z, b.w)); }

DI void zero_acc(f32x16 (&acc)[2][2]) {
#pragma unroll
  for (int a = 0; a < 2; ++a)
#pragma unroll
    for (int b = 0; b < 2; ++b)
#pragma unroll
      for (int i = 0; i < 16; ++i) acc[a][b][i] = 0.f;
}

DI void transpose_tile(const float* __restrict__ src, u16* __restrict__ dst, int K, int N, int kt, int nt, unsigned char* smem) {
  float* tile = (float*)smem;
  const int t = tid();
  __syncthreads();
#pragma unroll
  for (int i = 0; i < 4; ++i) {
    const int row = (t >> 4) + 16 * i, c4 = (t & 15) * 4;
    const float4 v = *(const float4*)(src + (size_t)(kt * 64 + row) * N + nt * 64 + c4);
    tile[row * 65 + c4 + 0] = v.x; tile[row * 65 + c4 + 1] = v.y; tile[row * 65 + c4 + 2] = v.z; tile[row * 65 + c4 + 3] = v.w;
  }
  __syncthreads();
  const int n = t >> 2, kseg = (t & 3) * 16;
  unsigned o[8];
#pragma unroll
  for (int e = 0; e < 8; ++e) o[e] = pk(tile[(kseg + 2 * e) * 65 + n], tile[(kseg + 2 * e + 1) * 65 + n]);
  u16* d = dst + (size_t)(nt * 64 + n) * K + kt * 64 + kseg;
  *(uint4*)d = make_uint4(o[0], o[1], o[2], o[3]);
  *(uint4*)(d + 8) = make_uint4(o[4], o[5], o[6], o[7]);
}

__device__ const float ROPE_INV[32] = {1.0f, 0.749894202f, 0.562341332f, 0.421696514f, 0.316227764f, 0.237137377f, 0.177827939f, 0.133352146f, 0.100000001f, 0.0749894232f, 0.0562341325f, 0.0421696492f, 0.0316227749f, 0.0237137377f, 0.0177827943f, 0.013335214f, 0.00999999978f, 0.00749894232f, 0.00562341325f, 0.00421696482f, 0.00316227763f, 0.00237137382f, 0.00177827943f, 0.00133352145f, 0.00100000005f, 0.000749894185f, 0.000562341302f, 0.000421696517f, 0.000316227757f, 0.00023713737f, 0.00017782794f, 0.00013335215f};

DI void phase0(const Params& p, unsigned char* smem) {
  const int t = tid();
  if (blockIdx.x == 0) {
    if (t < 4) {
      float s1 = 0.f, s2 = 0.f;
      for (int i = 0; i < 64; ++i) { s1 += p.lq1[t * 64 + i] * p.lk1[t * 64 + i]; s2 += p.lq2[t * 64 + i] * p.lk2[t * 64 + i]; }
      const float li = t == 0 ? 0.2f : (t == 1 ? 0.355509067590969f : (t == 2 ? 0.470713018343584f : 0.556058204155641f));
      p.lam[t] = expf(s1) - expf(s2) + li;
      p.lam[4 + t] = li;
      p.counters[t] = 0; p.counters[4 + t] = 0;
    }
  }
  {
    float* tile = (float*)smem;
    const int trow = t >> 4, tc4 = (t & 15) * 4;
    const int tn = t >> 2, tkseg = (t & 3) * 16;
    const float* tsrc; u16* tdst; int tK, tN, tkt, tnt;
#define TR_DECODE(J)                                                                                                                       \
    if ((J) < 5632) { const int l_ = (J) / 1408, r_ = (J) % 1408; tsrc = p.w_in + (size_t)l_ * 1024 * 5632; tdst = p.WinT + (size_t)l_ * 5632 * 1024; tK = 1024; tN = 5632; tkt = r_ / 88; tnt = r_ % 88; } \
    else if ((J) < 6144) { const int q_ = (J) - 5632, l_ = q_ >> 7, r_ = q_ & 127; tsrc = p.w_oa + (size_t)l_ * 512 * 1024; tdst = p.WoaT + (size_t)l_ * 1024 * 512; tK = 512; tN = 1024; tkt = r_ >> 4; tnt = r_ & 15; } \
    else if ((J) < 6656) { const int q_ = (J) - 6144, l_ = q_ >> 7, r_ = q_ & 127; tsrc = p.w_og + (size_t)l_ * 512 * 1024; tdst = p.WogT + (size_t)l_ * 1024 * 512; tK = 512; tN = 1024; tkt = r_ >> 4; tnt = r_ & 15; } \
    else { const int q_ = (J) - 6656, l_ = q_ >> 8, r_ = q_ & 255; tsrc = p.w_out + (size_t)l_ * 1024 * 1024; tdst = p.WoutT + (size_t)l_ * 1024 * 1024; tK = 1024; tN = 1024; tkt = r_ >> 4; tnt = r_ & 15; }
#define TR_LOAD()                                                                                                                          \
    { const float* s_ = tsrc + (size_t)(tkt * 64 + trow) * tN + tnt * 64 + tc4;                                                            \
      f0 = *(const float4*)s_; f1 = *(const float4*)(s_ + (size_t)16 * tN); f2 = *(const float4*)(s_ + (size_t)32 * tN); f3 = *(const float4*)(s_ + (size_t)48 * tN); }
    float4 f0, f1, f2, f3;
    int j = blockIdx.x;
    if (j < 7680) { TR_DECODE(j) TR_LOAD() }
    for (; j < 7680; j += gridDim.x) {
      u16* d = tdst + (size_t)(tnt * 64 + tn) * tK + tkt * 64 + tkseg;
      __syncthreads();
      float* w0 = tile + trow * 65 + tc4;
      w0[0] = f0.x; w0[1] = f0.y; w0[2] = f0.z; w0[3] = f0.w;
      w0[16 * 65 + 0] = f1.x; w0[16 * 65 + 1] = f1.y; w0[16 * 65 + 2] = f1.z; w0[16 * 65 + 3] = f1.w;
      w0[32 * 65 + 0] = f2.x; w0[32 * 65 + 1] = f2.y; w0[32 * 65 + 2] = f2.z; w0[32 * 65 + 3] = f2.w;
      w0[48 * 65 + 0] = f3.x; w0[48 * 65 + 1] = f3.y; w0[48 * 65 + 2] = f3.z; w0[48 * 65 + 3] = f3.w;
      __syncthreads();
      const int jn = j + gridDim.x;
      if (jn < 7680) { TR_DECODE(jn) TR_LOAD() }
      unsigned o0 = pk(tile[(tkseg + 0) * 65 + tn], tile[(tkseg + 1) * 65 + tn]), o1 = pk(tile[(tkseg + 2) * 65 + tn], tile[(tkseg + 3) * 65 + tn]);
      unsigned o2 = pk(tile[(tkseg + 4) * 65 + tn], tile[(tkseg + 5) * 65 + tn]), o3 = pk(tile[(tkseg + 6) * 65 + tn], tile[(tkseg + 7) * 65 + tn]);
      unsigned o4 = pk(tile[(tkseg + 8) * 65 + tn], tile[(tkseg + 9) * 65 + tn]), o5 = pk(tile[(tkseg + 10) * 65 + tn], tile[(tkseg + 11) * 65 + tn]);
      unsigned o6 = pk(tile[(tkseg + 12) * 65 + tn], tile[(tkseg + 13) * 65 + tn]), o7 = pk(tile[(tkseg + 14) * 65 + tn], tile[(tkseg + 15) * 65 + tn]);
      *(uint4*)d = make_uint4(o0, o1, o2, o3);
      *(uint4*)(d + 8) = make_uint4(o4, o5, o6, o7);
    }
  }
  const int gt = blockIdx.x * 256 + t, gs = gridDim.x * 256;
  for (int idx = gt; idx < MTOK * 128; idx += gs) {
    const int row = idx >> 7, c8 = (idx & 127) * 8;
    const float* src = row < SEQ ? p.x_prompt + (size_t)row * 1024 + c8 : p.x_sample + (size_t)(row - SEQ) * 1024 + c8;
    const float4 a = *(const float4*)src, b = *(const float4*)(src + 4);
    *(uint4*)(p.Xb + (size_t)row * 1024 + c8) = make_uint4(pk(a.x, a.y), pk(a.z, a.w), pk(b.x, b.y), pk(b.z, b.w));
  }
  for (int idx = gt; idx < SEQ * 32; idx += gs) {
    const int pos = idx >> 5, j = idx & 31;
    const float inv = ROPE_INV[j];
    const float ang = (float)pos * inv;
    double rev = (double)ang * 0.15915494309189535;
    rev -= rint(rev);
    const float rf = (float)rev;
    p.rope[2 * idx] = __builtin_amdgcn_cosf(rf);
    p.rope[2 * idx + 1] = __builtin_amdgcn_sinf(rf);
  }
}

constexpr int CW_STRIDE = 260;
DI void phaseA_tile(const Params& p, int layer, int mt, int nt, unsigned char* smem) {
  f32x16 acc[2][4];
#pragma unroll
  for (int a = 0; a < 2; ++a)
#pragma unroll
    for (int b = 0; b < 4; ++b)
#pragma unroll
      for (int i = 0; i < 16; ++i) acc[a][b][i] = 0.f;
  gemm_core_wide(p.Xb + (size_t)mt * 128 * 1024, 1024, p.WinT + ((size_t)layer * 5632 + nt * 256) * 1024, 1024, 1024, acc, smem);
  const int t = tid(), l = t & 63, w = t >> 6, wm = w >> 1, wn = w & 1, hb = l >> 5, r = l & 31;
  const int n0 = nt * 256, seg = n0 >> 9;
  const bool samp = mt >= 128;
  float* ct = (float*)smem;
#pragma unroll
  for (int h = 0; h < 2; ++h) {
    __syncthreads();
    if (wm == h) {
      float* base = ct + (4 * hb) * CW_STRIDE + wn * 128 + r;
#pragma unroll
      for (int tm = 0; tm < 2; ++tm)
#pragma unroll
        for (int tn = 0; tn < 4; ++tn)
#pragma unroll
          for (int i = 0; i < 16; ++i) base[(tm * 32 + (i & 3) + 8 * (i >> 2)) * CW_STRIDE + tn * 32] = acc[tm][tn][i];
    }
    __syncthreads();
    if (seg <= 1) {
      const int j = t & 15, head = j >> 2, c8 = (j & 3) * 8;
#pragma unroll
      for (int i = 0; i < 4; ++i) {
        const int rl = (t >> 4) + 16 * i;
        const int row = mt * 128 + h * 64 + rl;
        const int pos = samp ? 1024 + ((row - SEQ) & 31) : row;
        const float* cp = ct + rl * CW_STRIDE + head * 64 + c8;
        const float4 xa0 = *(const float4*)cp, xa1 = *(const float4*)(cp + 4);
        const float4 xb0 = *(const float4*)(cp + 32), xb1 = *(const float4*)(cp + 36);
        const float4* rp = (const float4*)(p.rope + ((size_t)pos * 32 + c8) * 2);
        const float4 r0 = rp[0], r1 = rp[1], r2 = rp[2], r3 = rp[3];
        float4 ya0, ya1, yb0, yb1;
        ya0.x = xa0.x * r0.x - xb0.x * r0.y; yb0.x = xb0.x * r0.x + xa0.x * r0.y;
        ya0.y = xa0.y * r0.z - xb0.y * r0.w; yb0.y = xb0.y * r0.z + xa0.y * r0.w;
        ya0.z = xa0.z * r1.x - xb0.z * r1.y; yb0.z = xb0.z * r1.x + xa0.z * r1.y;
        ya0.w = xa0.w * r1.z - xb0.w * r1.w; yb0.w = xb0.w * r1.z + xa0.w * r1.w;
        ya1.x = xa1.x * r2.x - xb1.x * r2.y; yb1.x = xb1.x * r2.x + xa1.x * r2.y;
        ya1.y = xa1.y * r2.z - xb1.y * r2.w; yb1.y = xb1.y * r2.z + xa1.y * r2.w;
        ya1.z = xa1.z * r3.x - xb1.z * r3.y; yb1.z = xb1.z * r3.x + xa1.z * r3.y;
        ya1.w = xa1.w * r3.z - xb1.w * r3.w; yb1.w = xb1.w * r3.z + xa1.w * r3.w;
        const int col = n0 + head * 64 + c8;
        u16* hp = p.H + (size_t)row * INW + col;
        if (seg == 0) {
          const float qs = 0.125f * 1.4426950408889634f;
          *(uint4*)hp = make_uint4(pk(ya0.x * qs, ya0.y * qs), pk(ya0.z * qs, ya0.w * qs), pk(ya1.x * qs, ya1.y * qs), pk(ya1.z * qs, ya1.w * qs));
          *(uint4*)(hp + 32) = make_uint4(pk(yb0.x * qs, yb0.y * qs), pk(yb0.z * qs, yb0.w * qs), pk(yb1.x * qs, yb1.y * qs), pk(yb1.z * qs, yb1.w * qs));
        } else {
          *(uint4*)hp = pack8(ya0, ya1);
          *(uint4*)(hp + 32) = pack8(yb0, yb1);
        }
        if (seg == 1) {
          float* o = samp ? p.out + OFF_KS + ((size_t)layer * 1024 + (row - SEQ)) * 512 + (col - C_K)
                          : p.out + OFF_KP + ((size_t)layer * SEQ + row) * 512 + (col - C_K);
          nt_store4(o, ya0); nt_store4(o + 4, ya1); nt_store4(o + 32, yb0); nt_store4(o + 36, yb1);
        }
      }
    } else {
      const int c8 = (t & 31) * 8;
#pragma unroll
      for (int i = 0; i < 8; ++i) {
        const int rl = (t >> 5) + 8 * i;
        const int row = mt * 128 + h * 64 + rl;
        const float* cp = ct + rl * CW_STRIDE + c8;
        const float4 v0 = *(const float4*)cp, v1 = *(const float4*)(cp + 4);
        const int col = n0 + c8;
        *(uint4*)(p.H + (size_t)row * INW + col) = pack8(v0, v1);
        if (seg == 2) {
          float* o = samp ? p.out + OFF_VS + ((size_t)layer * 1024 + (row - SEQ)) * 512 + (col - C_V)
                          : p.out + OFF_VP + ((size_t)layer * SEQ + row) * 512 + (col - C_V);
          nt_store4(o, v0); nt_store4(o + 4, v1);
        }
      }
    }
  }
}

constexpr int KS_STRIDE = 72;
constexpr int VS_STRIDE = 160;
constexpr int ST_K = 2 * 64 * KS_STRIDE;
constexpr int ST_BYTES = ST_K * 2 + 64 * VS_STRIDE * 2;

#define LOADV(D0, D1, D2, D3, G)                                                             \
  {                                                                                          \
    const u16* vk_ = vp + ((G) * 16) * VROW;                                                 \
    D0 = cat8(tr_read(vk_ + vo0), tr_read(vk_ + 8 * VROW + vo0));                            \
    D1 = cat8(tr_read(vk_ + vo1), tr_read(vk_ + 8 * VROW + vo1));                            \
    D2 = cat8(tr_read(vk_ + vo2), tr_read(vk_ + 8 * VROW + vo2));                            \
    D3 = cat8(tr_read(vk_ + vo3), tr_read(vk_ + 8 * VROW + vo3));                            \
  }
#define PACKP(S, U) __builtin_bit_cast(bf16x8, make_uint4(pk(S[8 * (U) + 0], S[8 * (U) + 1]), pk(S[8 * (U) + 2], S[8 * (U) + 3]), pk(S[8 * (U) + 4], S[8 * (U) + 5]), pk(S[8 * (U) + 6], S[8 * (U) + 7])))
#define PVMFMA(D0, D1, D2, D3, PB) { O[0] = MFMA(D0, PB, O[0]); O[1] = MFMA(D1, PB, O[1]); O[2] = MFMA(D2, PB, O[2]); O[3] = MFMA(D3, PB, O[3]); }
template <bool SWZ>
DI void attn_compute(const u16* Kb, const u16* Vb, const bf16x8 (&qf)[4], f32x16 (&O)[4], f32x16& Mneg, float& m_run, float& l_run, bool two, int s) {
  const int l = tid() & 63, hb = l >> 5, r = l & 31;
  f32x16 S0, S1;
  constexpr int KROW = SWZ ? 64 : KS_STRIDE, VROW = SWZ ? 128 : VS_STRIDE;
  const int q4 = (l & 15) >> 2, p4 = l & 3, blk = (l >> 4) & 1;
  const int ksw = SWZ ? ((r >> 1) & 7) : 0;
  const u16* kp = Kb + (s * 64 + r) * KROW;
  const int ko0 = ((0 + hb) ^ ksw) * 8, ko1 = ((2 + hb) ^ ksw) * 8, ko2 = ((4 + hb) ^ ksw) * 8, ko3 = ((6 + hb) ^ ksw) * 8;
  const u16* vp = Vb + (4 * hb + q4) * VROW + blk * 16 + p4 * 4;
  const int vsw = SWZ ? q4 : 0;
  const int vo0 = (0 ^ vsw) * 32, vo1 = (1 ^ vsw) * 32, vo2 = (2 ^ vsw) * 32, vo3 = (3 ^ vsw) * 32;
  bf16x8 ka0, ka1, ka2, ka3, kb0, kb1, kb2, kb3, va0, va1, va2, va3, vb0, vb1, vb2, vb3;
  ka0 = *(const bf16x8*)(kp + ko0); ka1 = *(const bf16x8*)(kp + ko1); ka2 = *(const bf16x8*)(kp + ko2); ka3 = *(const bf16x8*)(kp + ko3);
  if (two) {
    kb0 = *(const bf16x8*)(kp + 32 * KROW + ko0); kb1 = *(const bf16x8*)(kp + 32 * KROW + ko1);
    kb2 = *(const bf16x8*)(kp + 32 * KROW + ko2); kb3 = *(const bf16x8*)(kp + 32 * KROW + ko3);
  }
  LOADV(va0, va1, va2, va3, 0)
  __builtin_amdgcn_sched_barrier(0);
  S0 = MFMA(ka0, qf[0], Mneg); S0 = MFMA(ka1, qf[1], S0); S0 = MFMA(ka2, qf[2], S0); S0 = MFMA(ka3, qf[3], S0);
  if (two) { S1 = MFMA(kb0, qf[0], Mneg); S1 = MFMA(kb1, qf[1], S1); S1 = MFMA(kb2, qf[2], S1); S1 = MFMA(kb3, qf[3], S1); }
  float ls = 0.f;
#pragma unroll
  for (int i = 0; i < 16; ++i) { S0[i] = __builtin_amdgcn_exp2f(S0[i]); ls += S0[i]; }
  if (two) {
#pragma unroll
    for (int i = 0; i < 16; ++i) { S1[i] = __builtin_amdgcn_exp2f(S1[i]); ls += S1[i]; }
  }
  if (__any(!(ls <= 4194304.f))) {
    bf16x8 ra0 = *(const bf16x8*)(kp + ko0), ra1 = *(const bf16x8*)(kp + ko1), ra2 = *(const bf16x8*)(kp + ko2), ra3 = *(const bf16x8*)(kp + ko3);
#pragma unroll
    for (int i = 0; i < 16; ++i) { S0[i] = 0.f; S1[i] = 0.f; }
    S0 = MFMA(ra0, qf[0], S0); S0 = MFMA(ra1, qf[1], S0); S0 = MFMA(ra2, qf[2], S0); S0 = MFMA(ra3, qf[3], S0);
    if (two) {
      ra0 = *(const bf16x8*)(kp + 32 * KROW + ko0); ra1 = *(const bf16x8*)(kp + 32 * KROW + ko1);
      ra2 = *(const bf16x8*)(kp + 32 * KROW + ko2); ra3 = *(const bf16x8*)(kp + 32 * KROW + ko3);
      S1 = MFMA(ra0, qf[0], S1); S1 = MFMA(ra1, qf[1], S1); S1 = MFMA(ra2, qf[2], S1); S1 = MFMA(ra3, qf[3], S1);
    }
    float mx = S0[0];
#pragma unroll
    for (int i = 1; i < 16; ++i) mx = fmaxf(mx, S0[i]);
    if (two) {
#pragma unroll
      for (int i = 0; i < 16; ++i) mx = fmaxf(mx, S1[i]);
    }
    mx = fmaxf(mx, __shfl_xor(mx, 32));
    const float m_new = fmaxf(m_run, mx);
    const float alpha = __builtin_amdgcn_exp2f(m_run - m_new);
    m_run = m_new;
#pragma unroll
    for (int i = 0; i < 16; ++i) Mneg[i] = -m_new;
    l_run *= alpha;
#pragma unroll
    for (int dt = 0; dt < 4; ++dt)
#pragma unroll
      for (int i = 0; i < 16; ++i) O[dt][i] *= alpha;
    ls = 0.f;
#pragma unroll
    for (int i = 0; i < 16; ++i) { S0[i] = __builtin_amdgcn_exp2f(S0[i] - m_new); ls += S0[i]; }
    if (two) {
#pragma unroll
      for (int i = 0; i < 16; ++i) { S1[i] = __builtin_amdgcn_exp2f(S1[i] - m_new); ls += S1[i]; }
    }
  }
  l_run += ls;
  {
    const bf16x8 pb0 = PACKP(S0, 0);
    __builtin_amdgcn_sched_barrier(0);
    LOADV(vb0, vb1, vb2, vb3, 1)
    __builtin_amdgcn_sched_barrier(0);
    PVMFMA(va0, va1, va2, va3, pb0)
    const bf16x8 pb1 = PACKP(S0, 1);
    __builtin_amdgcn_sched_barrier(0);
    if (two) LOADV(va0, va1, va2, va3, 2)
    __builtin_amdgcn_sched_barrier(0);
    PVMFMA(vb0, vb1, vb2, vb3, pb1)
    if (two) {
      const bf16x8 pb2 = PACKP(S1, 0);
      __builtin_amdgcn_sched_barrier(0);
      LOADV(vb0, vb1, vb2, vb3, 3)
      __builtin_amdgcn_sched_barrier(0);
      PVMFMA(va0, va1, va2, va3, pb2)
      const bf16x8 pb3 = PACKP(S1, 1);
      __builtin_amdgcn_sched_barrier(0);
      PVMFMA(vb0, vb1, vb2, vb3, pb3)
    }
  }
}

template <bool SAMPLE>
DI void attn_item(const Params& p, int layer, int a, int h, unsigned char* smem) {
  const int t = tid(), l = t & 63, w = t >> 6, rg = w & 1, s = w >> 1, hb = l >> 5, r = l & 31;
  const int hh = 2 * h + s;
  const int qrow0 = SAMPLE ? SEQ + a * 32 : a * 64 + rg * 32;
  const bool active = SAMPLE ? (rg == 0) : true;
  const u16* H = p.H;
  bf16x8 qf[4];
  {
    const u16* qp = H + (size_t)(qrow0 + r) * INW + hh * 64 + hb * 8;
#pragma unroll
    for (int ks = 0; ks < 4; ++ks) qf[ks] = *(const bf16x8*)(qp + ks * 16);
  }
  f32x16 O[4];
#pragma unroll
  for (int dt = 0; dt < 4; ++dt)
#pragma unroll
    for (int i = 0; i < 16; ++i) O[dt][i] = 0.f;
  float m_run = -1e30f, l_run = 0.f;
  f32x16 Mneg;
#pragma unroll
  for (int i = 0; i < 16; ++i) Mneg[i] = 1e30f;
  u16* sm = (u16*)smem;

  __syncthreads();
  if (!SAMPLE) {
    const int ntiles = a + 1;
    const u16* kg = H + C_K + (2 * h) * 64;
    const u16* vg = H + C_V + h * 128;
    const int krow = w * 8 + (l >> 3);
    const u16* kq = kg + (size_t)krow * INW + ((l & 7) ^ ((krow >> 1) & 7)) * 8;
    const int vrow = w * 4 + (l >> 4);
    const u16* vq = vg + (size_t)vrow * INW + ((l & 15) ^ (((l >> 4) & 3) << 2)) * 8;
    const unsigned lb = __builtin_amdgcn_readfirstlane(lds_addr(smem) + w * 1024);
#define ATT_STAGE(BUF, KT)                                                                                \
    {                                                                                                     \
      const unsigned sb_ = lb + (BUF) * 32768;                                                            \
      const u16* k_ = kq + (size_t)(KT) * 64 * INW;                                                       \
      const u16* v_ = vq + (size_t)(KT) * 64 * INW;                                                       \
      glds16(k_, sb_); glds16(k_ + (size_t)32 * INW, sb_ + 4096);                                         \
      glds16(k_ + 64, sb_ + 8192); glds16(k_ + (size_t)32 * INW + 64, sb_ + 12288);                       \
      glds16(v_, sb_ + 16384); glds16(v_ + (size_t)16 * INW, sb_ + 16384 + 4096);                         \
      glds16(v_ + (size_t)32 * INW, sb_ + 16384 + 8192); glds16(v_ + (size_t)48 * INW, sb_ + 16384 + 12288); \
    }
    ATT_STAGE(0, 0)
    asm volatile("s_waitcnt vmcnt(0)" ::: "memory");
    __syncthreads();
    for (int kt = 0; kt < ntiles; ++kt) {
      const int buf = kt & 1;
      if (kt + 1 < ntiles) ATT_STAGE(buf ^ 1, kt + 1)
      __builtin_amdgcn_sched_barrier(0);
      const u16* kb = sm + buf * 16384;
      attn_compute<true>(kb, kb + 8192, qf, O, Mneg, m_run, l_run, true, s);
      asm volatile("s_waitcnt vmcnt(0)" ::: "memory");
      __syncthreads();
    }
  } else {
    const float* ck = p.cache_k + ((size_t)(layer * 32 + a) * 1024) * 512 + (2 * h) * 64;
    const float* cv = p.cache_v + ((size_t)(layer * 32 + a) * 1024) * 512 + h * 128;
    for (int j = 0; j < 9; ++j) {
      for (int g = 0; g < 2; ++g) {
        const int kt = 2 * j + g;
        u16* kb = sm + g * (ST_BYTES / 2);
        u16* vb = kb + ST_K;
        if (kt < 16) {
#pragma unroll 4
          for (int i = 0; i < 8; ++i) {
            const int cc = t + 256 * i;
            const int sh = cc >> 10, key = (cc >> 4) & 63, ch = cc & 15;
            const float4 v = *(const float4*)(ck + (size_t)(kt * 64 + key) * 512 + sh * 64 + ch * 4);
            *(uint2*)(kb + (sh * 64 + key) * KS_STRIDE + ch * 4) = make_uint2(pk(v.x, v.y), pk(v.z, v.w));
            const int vkey = cc >> 5, vch = cc & 31;
            const float4 u = *(const float4*)(cv + (size_t)(kt * 64 + vkey) * 512 + vch * 4);
            *(uint2*)(vb + vkey * VS_STRIDE + vch * 4) = make_uint2(pk(u.x, u.y), pk(u.z, u.w));
          }
        } else if (kt == 16) {
          const u16* kg = H + (size_t)(SEQ + a * 32) * INW + C_K + (2 * h) * 64;
          const u16* vg = H + (size_t)(SEQ + a * 32) * INW + C_V + h * 128;
#pragma unroll
          for (int i = 0; i < 2; ++i) {
            const int cc = t + 256 * i;
            const int sh = cc >> 8, key = (cc >> 3) & 31, ch = cc & 7;
            *(uint4*)(kb + (sh * 64 + key) * KS_STRIDE + ch * 8) = *(const uint4*)(kg + (size_t)key * INW + sh * 64 + ch * 8);
            const int vkey = cc >> 4, vch = cc & 15;
            *(uint4*)(vb + vkey * VS_STRIDE + vch * 8) = *(const uint4*)(vg + (size_t)vkey * INW + vch * 8);
          }
        }
      }
      __syncthreads();
      {
        const int kt = 2 * j + rg;
        const u16* kb = sm + rg * (ST_BYTES / 2);
        if (kt <= 16) attn_compute<false>(kb, kb + ST_K, qf, O, Mneg, m_run, l_run, kt < 16, s);
      }
      __syncthreads();
    }
    float* mgO = (float*)smem;
    float* mgML = (float*)(smem + 32768);
    if (rg == 1) {
#pragma unroll
      for (int dt = 0; dt < 4; ++dt)
#pragma unroll
        for (int i = 0; i < 16; ++i) mgO[(s * 128 + dt * 32 + crow(i, hb)) * 32 + r] = O[dt][i];
      mgML[(s * 64 + l) * 2] = m_run; mgML[(s * 64 + l) * 2 + 1] = l_run;
    }
    __syncthreads();
    if (rg == 0) {
      const float m1 = mgML[(s * 64 + l) * 2], l1 = mgML[(s * 64 + l) * 2 + 1];
      const float mm = fmaxf(m_run, m1);
      const float a0 = __builtin_amdgcn_exp2f(m_run - mm), a1 = __builtin_amdgcn_exp2f(m1 - mm);
#pragma unroll
      for (int dt = 0; dt < 4; ++dt)
#pragma unroll
        for (int i = 0; i < 16; ++i) O[dt][i] = O[dt][i] * a0 + mgO[(s * 128 + dt * 32 + crow(i, hb)) * 32 + r] * a1;
      l_run = l_run * a0 + l1 * a1;
      m_run = mm;
    }
    __syncthreads();
  }
  const int te = tid(), le = te & 63, re = le & 31, hbe = le >> 5, rge = (te >> 6) & 1, se = te >> 7;
  const bool acte = SAMPLE ? (rge == 0) : true;
  float lt = l_run + __shfl_xor(l_run, 32);
  const float inv_l = 1.f / lt;
  float* ex = (float*)smem;
  if (se == 1 && acte) {
#pragma unroll
    for (int dt = 0; dt < 4; ++dt)
#pragma unroll
      for (int i = 0; i < 16; ++i) ex[(rge * 128 + dt * 32 + crow(i, hbe)) * 32 + re] = O[dt][i] * inv_l;
  }
  __syncthreads();
  if (se == 0 && acte) {
    const float lam = __hip_atomic_load(p.lam + layer, __ATOMIC_RELAXED, __HIP_MEMORY_SCOPE_AGENT);
    const float li = __hip_atomic_load(p.lam + 4 + layer, __ATOMIC_RELAXED, __HIP_MEMORY_SCOPE_AGENT);
    float ss = 0.f;
#pragma unroll
    for (int dt = 0; dt < 4; ++dt)
#pragma unroll
      for (int i = 0; i < 16; ++i) {
        const float o = O[dt][i] * inv_l - lam * ex[(rge * 128 + dt * 32 + crow(i, hbe)) * 32 + re];
        O[dt][i] = o; ss += o * o;
      }
    ss += __shfl_xor(ss, 32);
    const float rs = rsqrtf(ss * (1.f / 128.f) + LN_EPS) * (1.f - li);
    const int row = (SAMPLE ? SEQ + a * 32 : a * 64 + rge * 32) + re;
    const u16* gp = H + (size_t)row * INW + C_GA + h * 128;
    u16* op = p.A1 + (size_t)row * 512 + h * 128;
    const float* sw = p.subln_w + layer * 128;
#pragma unroll
    for (int dt = 0; dt < 4; ++dt)
#pragma unroll
      for (int g4 = 0; g4 < 4; ++g4) {
        const int d = dt * 32 + 8 * g4 + 4 * hbe;
        const uint2 gv = *(const uint2*)(gp + d);
        const float4 wv = *(const float4*)(sw + d);
        const float y0 = O[dt][4 * g4 + 0] * rs * wv.x * siluf_(bflo(gv.x));
        const float y1 = O[dt][4 * g4 + 1] * rs * wv.y * siluf_(bfhi(gv.x));
        const float y2 = O[dt][4 * g4 + 2] * rs * wv.z * siluf_(bflo(gv.y));
        const float y3 = O[dt][4 * g4 + 3] * rs * wv.w * siluf_(bfhi(gv.y));
        *(uint2*)(op + d) = make_uint2(pk(y0, y1), pk(y2, y3));
      }
  }
}

DI void sgu_item(const Params& p, int layer, int chunk, int g, unsigned char* smem) {
  const int t = tid(), l = t & 63, w = t >> 6, wm = w >> 1, wn = w & 1, hb = l >> 5, r = l & 31;
  const int m0 = chunk * 128;
  const bool samp = chunk >= 128;
  u16* Asg = (u16*)smem;
  u16* Bsg = Asg + 128 * 72;
  float* st = (float*)(smem + 38912);
  const u16* H = p.H;
  __syncthreads();
#pragma unroll 8
  for (int rr = 0; rr < 32; ++rr) {
    const int row = w * 32 + rr;
    const uint4 v = *(const uint4*)(H + (size_t)(m0 + row) * INW + C_VG + l * 8);
    float x[8] = {bflo(v.x), bfhi(v.x), bflo(v.y), bfhi(v.y), bflo(v.z), bfhi(v.z), bflo(v.w), bfhi(v.w)};
    float s1 = 0.f, s2 = 0.f;
#pragma unroll
    for (int e = 0; e < 8; ++e) { s1 += x[e]; s2 += x[e] * x[e]; }
#pragma unroll
    for (int o = 32; o >= 1; o >>= 1) { s1 += __shfl_xor(s1, o); s2 += __shfl_xor(s2, o); }
    if (l == 0) {
      const float mean = s1 * (1.f / 512.f);
      const float var = fmaxf(s2 * (1.f / 512.f) - mean * mean, 0.f);
      st[row] = mean; st[128 + row] = rsqrtf(var + LN_EPS);
    }
  }
  __syncthreads();
  uint4 puu[8], pgg[8];
#pragma unroll
  for (int i = 0; i < 8; ++i) {
    const u16* hp = H + (size_t)(m0 + (t >> 4) + 16 * i) * INW + g * 128 + (t & 15) * 8;
    puu[i] = *(const uint4*)(hp + C_U); pgg[i] = *(const uint4*)(hp + C_GG);
  }
  f32x16 acc[2][2];
  zero_acc(acc);
  const float* Wg = p.w_s + ((size_t)(layer * 4 + g) * 128) * 128;
  const float* gam = p.sgu_g + layer * 512 + g * 128;
  const float* bet = p.sgu_b + layer * 512 + g * 128;
  const int q4 = (l & 15) >> 2, p4 = l & 3, blk = (l >> 4) & 1;
  for (int kh = 0; kh < 2; ++kh) {
#pragma unroll
    for (int i8 = 0; i8 < 8; ++i8) {
      const int cc = t + 256 * i8;
      const int i = cc >> 4, j4 = (cc & 15) * 4, j = kh * 64 + j4;
      float4 v;
      float e0, e1, e2, e3;
      if (!samp) {
        v = *(const float4*)(Wg + i * 128 + j);
        e0 = (j + 0 <= i) ? v.x : 0.f; e1 = (j + 1 <= i) ? v.y : 0.f; e2 = (j + 2 <= i) ? v.z : 0.f; e3 = (j + 3 <= i) ? v.w : 0.f;
      } else {
        const int i32 = i & 31, j32 = j & 31;
        v = *(const float4*)(Wg + i32 * 128 + j32);
        const bool same = (i >> 5) == (j >> 5);
        e0 = (same && j32 + 0 <= i32) ? v.x : 0.f; e1 = (same && j32 + 1 <= i32) ? v.y : 0.f;
        e2 = (same && j32 + 2 <= i32) ? v.z : 0.f; e3 = (same && j32 + 3 <= i32) ? v.w : 0.f;
      }
      *(uint2*)(Asg + i * 72 + j4) = make_uint2(pk(e0, e1), pk(e2, e3));
    }
#pragma unroll
    for (int i4 = 0; i4 < 4; ++i4) {
      const int cc = t + 256 * i4;
      const int jj = cc >> 4, dc = (cc & 15) * 8;
      const int jrow = kh * 64 + jj;
      const uint4 v = *(const uint4*)(H + (size_t)(m0 + jrow) * INW + C_VG + g * 128 + dc);
      const float mean = st[jrow], rstd = st[128 + jrow];
      const float4 g0 = *(const float4*)(gam + dc), g1 = *(const float4*)(gam + dc + 4);
      const float4 b0 = *(const float4*)(bet + dc), b1 = *(const float4*)(bet + dc + 4);
      const float y0 = (bflo(v.x) - mean) * rstd * g0.x + b0.x, y1 = (bfhi(v.x) - mean) * rstd * g0.y + b0.y;
      const float y2 = (bflo(v.y) - mean) * rstd * g0.z + b0.z, y3 = (bfhi(v.y) - mean) * rstd * g0.w + b0.w;
      const float y4 = (bflo(v.z) - mean) * rstd * g1.x + b1.x, y5 = (bfhi(v.z) - mean) * rstd * g1.y + b1.y;
      const float y6 = (bflo(v.w) - mean) * rstd * g1.z + b1.z, y7 = (bfhi(v.w) - mean) * rstd * g1.w + b1.w;
      *(uint4*)(Bsg + jj * VS_STRIDE + dc) = make_uint4(pk(y0, y1), pk(y2, y3), pk(y4, y5), pk(y6, y7));
      if (samp) {
        float* o = p.out + OFF_GV + ((size_t)layer * 1024 + (m0 - SEQ) + jrow) * 512 + g * 128 + dc;
        *(float4*)o = make_float4(y0, y1, y2, y3);
        *(float4*)(o + 4) = make_float4(y4, y5, y6, y7);
      }
    }
    __syncthreads();
    const u16* as = Asg + (wm * 64 + r) * 72 + hb * 8;
    const u16* bs = Bsg + (8 * hb + q4) * VS_STRIDE + wn * 64 + blk * 16 + p4 * 4;
#pragma unroll
    for (int ks = 0; ks < 4; ++ks) {
      bf16x8 a0 = *(const bf16x8*)(as + ks * 16), a1 = *(const bf16x8*)(as + 32 * 72 + ks * 16);
      const u16* bk = bs + ks * 16 * VS_STRIDE;
      bf16x8 b0 = cat8(tr_read(bk), tr_read(bk + 4 * VS_STRIDE));
      bf16x8 b1 = cat8(tr_read(bk + 32), tr_read(bk + 4 * VS_STRIDE + 32));
      acc[0][0] = MFMA(a0, b0, acc[0][0]); acc[0][1] = MFMA(a0, b1, acc[0][1]);
      acc[1][0] = MFMA(a1, b0, acc[1][0]); acc[1][1] = MFMA(a1, b1, acc[1][1]);
    }
    __syncthreads();
  }
  const float* bsp = p.b_s + (size_t)(layer * 4 + g) * 128;
  acc_to_lds(acc, smem);
  __syncthreads();
  {
    const float* ct = (const float*)smem;
    const int c8 = (t & 15) * 8;
#pragma unroll
    for (int i = 0; i < 8; ++i) {
      const int rl = (t >> 4) + 16 * i;
      const int row = m0 + rl;
      const float* cp = ct + rl * CT_STRIDE + c8;
      const float4 v0 = *(const float4*)cp, v1 = *(const float4*)(cp + 4);
      const float bias = bsp[samp ? (rl & 31) : rl];
      const uint4 uu = puu[i], gg = pgg[i];
      float4 o0, o1;
      o0.x = (v0.x + bias) * bflo(uu.x) * siluf_(bflo(gg.x)); o0.y = (v0.y + bias) * bfhi(uu.x) * siluf_(bfhi(gg.x));
      o0.z = (v0.z + bias) * bflo(uu.y) * siluf_(bflo(gg.y)); o0.w = (v0.w + bias) * bfhi(uu.y) * siluf_(bfhi(gg.y));
      o1.x = (v1.x + bias) * bflo(uu.z) * siluf_(bflo(gg.z)); o1.y = (v1.y + bias) * bfhi(uu.z) * siluf_(bfhi(gg.z));
      o1.z = (v1.z + bias) * bflo(uu.w) * siluf_(bflo(gg.w)); o1.w = (v1.w + bias) * bfhi(uu.w) * siluf_(bfhi(gg.w));
      *(uint4*)(p.A2 + (size_t)row * 512 + g * 128 + c8) = pack8(o0, o1);
    }
  }
}

DI void phaseB(const Params& p, int layer_slot, unsigned char* smem) {
  const int layer = layer_slot & 3;
  int* s_item = (int*)(smem + 77824);
  const bool stat = gridDim.x == 512;
  const int sq = 2 * (blockIdx.x >> 3) + ((blockIdx.x >> 2) & 1), sh = blockIdx.x & 3;
  const int total = stat ? 672 : 1696;
  for (int n = 0;; ++n) {
    int kind, a, h;
    if (stat && n < 2) { kind = 1; a = n ? sq : 255 - sq; h = sh; }
    else {
      __syncthreads();
      if (threadIdx.x == 0) *s_item = atomicAdd(p.counters + layer_slot, 1);
      __syncthreads();
      const int it = *s_item;
      if (it >= total) break;
      if (it < 128) { kind = 0; a = it >> 2; h = it & 3; }
      else if (it < 672) { kind = 2; a = (it - 128) >> 2; h = (it - 128) & 3; }
      else { kind = 1; a = 255 - ((it - 672) >> 2); h = (it - 672) & 3; }
    }
    if (kind == 0) attn_item<true>(p, layer, a, h, smem);
    else if (kind == 1) attn_item<false>(p, layer, a, h, smem);
    else sgu_item(p, layer, a, h, smem);
  }
}

DI void phaseC1_tile(const Params& p, int layer, int mt, int nt, unsigned char* smem) {
  const int t = tid();
  const int c8 = (t & 15) * 8;
  const float* ct = (const float*)smem;
  f32x16 acc[2][2];
  uint4 ya[8], gma[8], gmb[8];
#pragma unroll
  for (int i = 0; i < 8; ++i) {
    const u16* hp = p.H + (size_t)(mt * 128 + (t >> 4) + 16 * i) * INW + nt * 128 + c8;
    gma[i] = *(const uint4*)(hp + C_MA); gmb[i] = *(const uint4*)(hp + C_MB);
  }
  zero_acc(acc);
  gemm_core(p.A1 + (size_t)mt * 128 * 512, 512, p.WoaT + ((size_t)layer * 1024 + nt * 128) * 512, 512, 512, acc, smem);
  acc_to_lds(acc, smem);
  __syncthreads();
#pragma unroll
  for (int i = 0; i < 8; ++i) {
    const int rl = (t >> 4) + 16 * i;
    const int row = mt * 128 + rl;
    const float* cp = ct + rl * CT_STRIDE + c8;
    const float4 v0 = *(const float4*)cp, v1 = *(const float4*)(cp + 4);
    const uint4 g = gma[i];
    ya[i] = make_uint4(pk(v0.x * sigmoidf_(bflo(g.x)), v0.y * sigmoidf_(bfhi(g.x))), pk(v0.z * sigmoidf_(bflo(g.y)), v0.w * sigmoidf_(bfhi(g.y))),
                       pk(v1.x * sigmoidf_(bflo(g.z)), v1.y * sigmoidf_(bfhi(g.z))), pk(v1.z * sigmoidf_(bflo(g.w)), v1.w * sigmoidf_(bfhi(g.w))));
  }
  zero_acc(acc);
  gemm_core(p.A2 + (size_t)mt * 128 * 512, 512, p.WogT + ((size_t)layer * 1024 + nt * 128) * 512, 512, 512, acc, smem);
  acc_to_lds(acc, smem);
  __syncthreads();
#pragma unroll
  for (int i = 0; i < 8; ++i) {
    const int rl = (t >> 4) + 16 * i;
    const int row = mt * 128 + rl;
    const float* cp = ct + rl * CT_STRIDE + c8;
    const float4 v0 = *(const float4*)cp, v1 = *(const float4*)(cp + 4);
    const uint4 g = gmb[i];
    float4 o0, o1;
    const float4 ma0 = make_float4(bflo(ya[i].x), bfhi(ya[i].x), bflo(ya[i].y), bfhi(ya[i].y));
    const float4 ma1 = make_float4(bflo(ya[i].z), bfhi(ya[i].z), bflo(ya[i].w), bfhi(ya[i].w));
    o0.x = ma0.x + v0.x * sigmoidf_(bflo(g.x)); o0.y = ma0.y + v0.y * sigmoidf_(bfhi(g.x));
    o0.z = ma0.z + v0.z * sigmoidf_(bflo(g.y)); o0.w = ma0.w + v0.w * sigmoidf_(bfhi(g.y));
    o1.x = ma1.x + v1.x * sigmoidf_(bflo(g.z)); o1.y = ma1.y + v1.y * sigmoidf_(bfhi(g.z));
    o1.z = ma1.z + v1.z * sigmoidf_(bflo(g.w)); o1.w = ma1.w + v1.w * sigmoidf_(bfhi(g.w));
    *(uint4*)(p.Mg + (size_t)row * 1024 + nt * 128 + c8) = pack8(o0, o1);
  }
}

DI void phaseC2_tile(const Params& p, int layer, int mt, int nt, unsigned char* smem) {
  const int t = tid();
  const int c8 = (t & 15) * 8;
  const float* ct = (const float*)smem;
  const float* xsrc = layer == 0 ? (mt < 128 ? p.x_prompt : p.x_sample - (size_t)SEQ * 1024) : p.Xf;
  float4 xr0[8], xr1[8];
#pragma unroll
  for (int i = 0; i < 8; ++i) {
    const float* xp = xsrc + (size_t)(mt * 128 + (t >> 4) + 16 * i) * 1024 + nt * 128 + c8;
    xr0[i] = *(const float4*)xp; xr1[i] = *(const float4*)(xp + 4);
  }
  f32x16 acc[2][2];
  zero_acc(acc);
  gemm_core(p.Mg + (size_t)mt * 128 * 1024, 1024, p.WoutT + ((size_t)layer * 1024 + nt * 128) * 1024, 1024, 1024, acc, smem);
  acc_to_lds(acc, smem);
  __syncthreads();
#pragma unroll
  for (int i = 0; i < 8; ++i) {
    const int rl = (t >> 4) + 16 * i;
    const int row = mt * 128 + rl;
    const float* cp = ct + rl * CT_STRIDE + c8;
    const float4 v0 = *(const float4*)cp, v1 = *(const float4*)(cp + 4);
    const float4 x0 = xr0[i], x1 = xr1[i];
    float* op = p.Xpre + (size_t)row * 1024 + nt * 128 + c8;
    *(float4*)op = make_float4(ALPHA_RES * x0.x + v0.x, ALPHA_RES * x0.y + v0.y, ALPHA_RES * x0.z + v0.z, ALPHA_RES * x0.w + v0.w);
    *(float4*)(op + 4) = make_float4(ALPHA_RES * x1.x + v1.x, ALPHA_RES * x1.y + v1.y, ALPHA_RES * x1.z + v1.z, ALPHA_RES * x1.w + v1.w);
  }
}

DI void phaseLN(const Params& p, int layer) {
  const int t = tid(), l = t & 63, w = t >> 6;
  const float* g = p.ln_g + layer * 1024;
  const float* b = p.ln_b + layer * 1024;
  float* dstf = layer == 3 ? p.out : p.Xf;
  for (int row = blockIdx.x * 4 + w; row < MTOK; row += gridDim.x * 4) {
    const float* src = p.Xpre + (size_t)row * 1024;
    float4 v[4];
    float s1 = 0.f;
#pragma unroll
    for (int i = 0; i < 4; ++i) { v[i] = *(const float4*)(src + i * 256 + l * 4); s1 += v[i].x + v[i].y + v[i].z + v[i].w; }
#pragma unroll
    for (int o = 32; o >= 1; o >>= 1) s1 += __shfl_xor(s1, o);
    const float mean = s1 * (1.f / 1024.f);
    float s2 = 0.f;
#pragma unroll
    for (int i = 0; i < 4; ++i) {
      v[i].x -= mean; v[i].y -= mean; v[i].z -= mean; v[i].w -= mean;
      s2 += v[i].x * v[i].x + v[i].y * v[i].y + v[i].z * v[i].z + v[i].w * v[i].w;
    }
#pragma unroll
    for (int o = 32; o >= 1; o >>= 1) s2 += __shfl_xor(s2, o);
    const float rstd = rsqrtf(s2 * (1.f / 1024.f) + LN_EPS);
#pragma unroll
    for (int i = 0; i < 4; ++i) {
      const int c = i * 256 + l * 4;
      const float4 gv = *(const float4*)(g + c), bv = *(const float4*)(b + c);
      const float y0 = v[i].x * rstd * gv.x + bv.x, y1 = v[i].y * rstd * gv.y + bv.y;
      const float y2 = v[i].z * rstd * gv.z + bv.z, y3 = v[i].w * rstd * gv.w + bv.w;
      *(float4*)(dstf + (size_t)row * 1024 + c) = make_float4(y0, y1, y2, y3);
      if (layer < 3) *(uint2*)(p.Xb + (size_t)row * 1024 + c) = make_uint2(pk(y0, y1), pk(y2, y3));
    }
  }
}

__global__ void __launch_bounds__(256, 2) fwd_megakernel(Params p) {
  __shared__ __attribute__((aligned(16))) unsigned char smem[SMEM_BYTES];
  __shared__ uint4 xb_words;
  cg::grid_group grid = cg::this_grid();
  if (threadIdx.x == 0) xb_words = make_uint4(0u, 0u, 0u, 0u);
  __syncthreads();
  XcdBarrier xb = xcd_barrier_post(p.bar, (volatile LAS unsigned*)&xb_words);
  for (int ph = p.ph_lo; ph < p.ph_hi; ++ph) {
    if (ph == 0) {
      phase0(p, smem);
    } else {
      const int layer = (ph - 1) / 5, sub = (ph - 1) % 5;
      const int nrep = (sub == PROBE_REP || (PROBE_REP == 6 && sub >= 2)) ? 2 : 1;
      for (int rep = 0; rep < nrep; ++rep) {
        if (rep) xcd_barrier(xb);
        if (sub == 0) {
          for (int tix = blockIdx.x; tix < 136 * 22; tix += gridDim.x) phaseA_tile(p, layer, tix / 22, tix % 22, smem);
        } else if (sub == 1) {
          phaseB(p, layer + 4 * rep, smem);
        } else if (sub == 2) {
          for (int tix = blockIdx.x; tix < 136 * 8; tix += gridDim.x) phaseC1_tile(p, layer, tix >> 3, tix & 7, smem);
        } else if (sub == 3) {
          for (int tix = blockIdx.x; tix < 136 * 8; tix += gridDim.x) phaseC2_tile(p, layer, tix >> 3, tix & 7, smem);
        } else {
          phaseLN(p, layer);
        }
      }
    }
    if (PROBE_REP == 5 && ph + 1 < p.ph_hi) xcd_barrier(xb);
    if (ph + 1 < p.ph_hi) { if (p.ph_hi < 0) grid.sync(); else xcd_barrier(xb); }
  }
}

extern "C" void kernel_launch(void* const* d_in, const int* in_sizes, int n_in, void* d_out, int out_size, void* d_ws, size_t ws_size, hipStream_t stream) {
  static int grid_blocks = 0;
  if (!grid_blocks) {
    int dev = 0, cus = 0, per_cu = 0;
    hipGetDevice(&dev);
    hipDeviceGetAttribute(&cus, hipDeviceAttributeMultiprocessorCount, dev);
    hipOccupancyMaxActiveBlocksPerMultiprocessor(&per_cu, fwd_megakernel, 256, 0);
    if (per_cu < 1) per_cu = 1;
    if (per_cu > 2) per_cu = 2;
    grid_blocks = cus * per_cu;
  }
  Params p{};
  const float** ins = (const float**)&p;
  for (int i = 0; i < 19; ++i) ins[i] = (const float*)d_in[i];
  p.out = (float*)d_out;
  unsigned char* ws = (unsigned char*)d_ws;
  size_t off = 0;
  auto take = [&](size_t bytes) { unsigned char* q = ws + off; off += (bytes + 255) & ~(size_t)255; return q; };
  p.WinT = (u16*)take((size_t)4 * 5632 * 1024 * 2);
  p.WoaT = (u16*)take((size_t)4 * 1024 * 512 * 2);
  p.WogT = (u16*)take((size_t)4 * 1024 * 512 * 2);
  p.WoutT = (u16*)take((size_t)4 * 1024 * 1024 * 2);
  p.Xb = (u16*)take((size_t)MTOK * 1024 * 2);
  p.H = (u16*)take((size_t)MTOK * INW * 2);
  p.A1 = (u16*)take((size_t)MTOK * 512 * 2);
  p.A2 = (u16*)take((size_t)MTOK * 512 * 2);
  p.Mg = (u16*)take((size_t)MTOK * 1024 * 2);
  p.Xf = (float*)take((size_t)MTOK * 1024 * 4);
  p.Xpre = (float*)take((size_t)MTOK * 1024 * 4);
  p.rope = (float*)take((size_t)SEQ * 32 * 2 * 4);
  p.lam = (float*)take(256);
  p.counters = (int*)take(256);
  p.bar = (unsigned*)take(XCD_BAR_WORDS * 4);
  hipMemsetAsync(p.bar, 0, XCD_BAR_WORDS * 4, stream);
#if MULTI_LAUNCH
  for (int ph = 0; ph < 21; ++ph) {
    p.ph_lo = ph; p.ph_hi = ph + 1;
    hipLaunchKernelGGL(fwd_megakernel, dim3(grid_blocks), dim3(256), 0, stream, p);
  }
#else
  p.ph_lo = 0; p.ph_hi = 21;
  void* args[] = {&p};
  hipError_t e = hipLaunchCooperativeKernel((void*)fwd_megakernel, dim3(grid_blocks), dim3(256), args, 0, stream);
  if (e != hipSuccess) fprintf(stderr, "cooperative launch failed: %s (grid %d)\n", hipGetErrorString(e), grid_blocks);
#endif
}
```

```cpp
#include <hip/hip_runtime.h>
#include <hip/hip_cooperative_groups.h>
#include <cstdio>
namespace cg = cooperative_groups;

#ifndef PROBE_REP
#define PROBE_REP -1
#endif
#ifndef MULTI_LAUNCH
#define MULTI_LAUNCH 0
#endif

#define DI __device__ __forceinline__
typedef unsigned short u16;
typedef __attribute__((ext_vector_type(8))) short bf16x8;
typedef __attribute__((ext_vector_type(4))) short s16x4;
typedef __attribute__((ext_vector_type(16))) float f32x16;
typedef __attribute__((ext_vector_type(2))) float f32x2;
typedef __attribute__((ext_vector_type(2))) __bf16 bf16x2_t;

constexpr int SEQ = 16384, MTOK = 17408, INW = 5632;
constexpr int C_K = 512, C_V = 1024, C_GA = 1536, C_U = 2048, C_VG = 2560, C_GG = 3072, C_MA = 3584, C_MB = 4608;
constexpr size_t OFF_KP = 17825792, OFF_VP = 51380224, OFF_KS = 84934656, OFF_VS = 87031808, OFF_GV = 89128960;
constexpr int SMEM_BYTES = 77824 + 64;
constexpr float ALPHA_RES = 1.681792830507429f;
constexpr float LN_EPS = 1e-5f;

struct Params {
  const float *x_prompt, *x_sample, *cache_k, *cache_v, *w_in, *w_oa, *w_og, *w_out;
  const float *lq1, *lk1, *lq2, *lk2, *subln_w, *sgu_g, *sgu_b, *w_s, *b_s, *ln_g, *ln_b;
  float* out;
  u16 *WinT, *WoaT, *WogT, *WoutT, *Xb, *H, *A1, *A2, *Mg;
  float *Xf, *Xpre, *rope, *lam;
  int* counters;
  unsigned* bar;
  int ph_lo, ph_hi;
};

DI unsigned pk(float a, float b) { f32x2 x = {a, b}; bf16x2_t y = __builtin_convertvector(x, bf16x2_t); return __builtin_bit_cast(unsigned, y); }
DI u16 f2bf(float a) { return (u16)(pk(a, 0.f) & 0xffffu); }
DI float bf2f(u16 h) { return __uint_as_float(((unsigned)h) << 16); }
DI float bflo(unsigned u) { return __uint_as_float(u << 16); }
DI float bfhi(unsigned u) { return __uint_as_float(u & 0xffff0000u); }
DI int tid() { int t = threadIdx.x; asm volatile("" : "+v"(t)); return t; }
DI int crow(int i, int hb) { return (i & 3) + 8 * (i >> 2) + 4 * hb; }
DI float sigmoidf_(float x) { return 1.f / (1.f + __expf(-x)); }
DI float siluf_(float x) { return x / (1.f + __expf(-x)); }
#define MFMA(a, b, c) __builtin_amdgcn_mfma_f32_32x32x16_bf16((a), (b), (c), 0, 0, 0)
typedef __attribute__((address_space(3))) s16x4 lds_s16x4;
typedef __attribute__((address_space(3))) unsigned lds_u32;
DI void glds16(const void* g, unsigned lds_base) {
  unsigned sv;
  asm volatile("s_mov_b32 %0, m0\n\ts_mov_b32 m0, %2\n\ts_nop 0\n\tglobal_load_lds_dwordx4 %1, off\n\ts_mov_b32 m0, %0" : "=&s"(sv) : "v"(g), "s"(lds_base) : "memory");
}
DI unsigned lds_addr(const void* p) { return (unsigned)(size_t)(__attribute__((address_space(3))) const unsigned char*)p; }
DI s16x4 tr_read(const u16* p) { return __builtin_amdgcn_ds_read_tr16_b64_v4i16((lds_s16x4*)p); }
DI bf16x8 cat8(s16x4 lo, s16x4 hi) { return __builtin_shufflevector(lo, hi, 0, 1, 2, 3, 4, 5, 6, 7); }


#define XB_TMO      128
#define XB_XCNT(j)  (256  + 64 * (j))
#define XB_XSUB(j)  (1280 + 64 * (j))
#define XB_XGEN(j)  (2304 + 64 * (j))
#define XB_TOP      3328
#define XB_TOPGEN   3392
#define XCD_BAR_WORDS 3456
#define XB_SPIN_CAP (1u << 24)
#define LAS __attribute__((address_space(3)))
DI unsigned xb_ld(unsigned* p)              { return __hip_atomic_load(p, __ATOMIC_RELAXED, __HIP_MEMORY_SCOPE_AGENT); }
DI unsigned xb_add(unsigned* p, unsigned v) { return __hip_atomic_fetch_add(p, v, __ATOMIC_RELAXED, __HIP_MEMORY_SCOPE_AGENT); }
DI unsigned xb_xcc_id() { return (unsigned)__builtin_amdgcn_s_getreg((3 << 11) | 20) & 0xFu; }
#define XB_SPIN(cond, bar) do { unsigned _sp = 0; while (cond) { __builtin_amdgcn_s_sleep(1); \
    if ((++_sp & 255u) == 0u) { if (xb_ld(&(bar)[XB_TMO])) break; if (_sp > XB_SPIN_CAP) { atomicAdd(&(bar)[XB_TMO], 1u); break; } } } } while (0)
struct XcdBarrier { unsigned* bar; unsigned x; volatile LAS unsigned* st; };
DI XcdBarrier xcd_barrier_post(unsigned* bar, volatile LAS unsigned* st) {
  XcdBarrier b; b.bar = bar; b.x = xb_xcc_id(); b.st = st;
  if (threadIdx.x == 0) (void)xb_add(&bar[XB_XCNT(b.x)], 1u);
  return b;
}
DI void xcd_barrier_complete(unsigned* bar, unsigned x, unsigned& nloc, unsigned& nx) {
  const unsigned G = gridDim.x * gridDim.y * gridDim.z;
  unsigned sum, cnt, mine, sp = 0u;
  for (;;) {
    sum = 0u; cnt = 0u; mine = 0u;
#pragma unroll
    for (unsigned j = 0; j < 16; ++j) { const unsigned c = xb_ld(&bar[XB_XCNT(j)]); sum += c; cnt += (c > 0u) ? 1u : 0u; mine = (j == x) ? c : mine; }
    if (sum == G) break;
    __builtin_amdgcn_s_sleep(1);
    if ((++sp & 255u) == 0u) { if (xb_ld(&bar[XB_TMO])) break; if (sp > XB_SPIN_CAP) { atomicAdd(&bar[XB_TMO], 1u); break; } }
  }
  nloc = mine > 0u ? mine : 1u; nx = cnt > 0u ? cnt : 1u;
}
DI void xcd_barrier(const XcdBarrier& b) {
  asm volatile("s_waitcnt vmcnt(0)" ::: "memory");
  __syncthreads();
  if (threadIdx.x == 0) {
    unsigned* bar = b.bar;
    __builtin_amdgcn_s_waitcnt(0);
    unsigned nloc = b.st[0], nx = b.st[1];
    if (nloc == 0u) { xcd_barrier_complete(bar, b.x, nloc, nx); b.st[0] = nloc; b.st[1] = nx; }
    const unsigned old = xb_add(&bar[XB_XSUB(b.x)], 1u);
    const unsigned gen = old / nloc;
    if (old + 1u == (gen + 1u) * nloc) {
      __builtin_amdgcn_fence(__ATOMIC_RELEASE, "agent");
      asm volatile("s_waitcnt vmcnt(0)" ::: "memory");
      const unsigned og = xb_add(&bar[XB_TOP], 1u);
      const unsigned tg = og / nx;
      if (og + 1u == (tg + 1u) * nx) xb_add(&bar[XB_TOPGEN], 1u);
      else XB_SPIN(xb_ld(&bar[XB_TOPGEN]) == tg, bar);
      __builtin_amdgcn_fence(__ATOMIC_ACQUIRE, "agent");
      xb_add(&bar[XB_XGEN(b.x)], 1u);
      asm volatile("s_waitcnt vmcnt(0)" ::: "memory");
    } else {
      XB_SPIN(xb_ld(&bar[XB_XGEN(b.x)]) == gen, bar);
      __builtin_amdgcn_fence(__ATOMIC_ACQUIRE, "agent");
      asm volatile("s_waitcnt vmcnt(0)" ::: "memory");
    }
  }
  __syncthreads();
}

DI void gemm_core(const u16* __restrict__ A, int lda, const u16* __restrict__ Bt, int ldb, int K,
                  f32x16 (&acc)[2][2], unsigned char* smem) {
  const int t = tid(), l = t & 63, w = t >> 6, wm = w >> 1, wn = w & 1, hb = l >> 5, r = l & 31;
  const int grow = w * 8 + (l >> 3);
  const int gch = (l & 7) ^ ((grow >> 1) & 7);
  const u16* ag = A + (size_t)grow * lda + gch * 8;
  const u16* bg = Bt + (size_t)grow * ldb + gch * 8;
  const unsigned lbase = __builtin_amdgcn_readfirstlane(lds_addr(smem) + w * 1024);
#define GM_STAGE(BUF, KO)                                                                                        \
  {                                                                                                              \
    const unsigned sa_ = lbase + (BUF) * 32768;                                                                  \
    _Pragma("unroll") for (int i = 0; i < 4; ++i) {                                                              \
      glds16(ag + (size_t)(32 * i) * lda + (KO), sa_ + i * 4096);                                                \
      glds16(bg + (size_t)(32 * i) * ldb + (KO), sa_ + 16384 + i * 4096);                                        \
    }                                                                                                            \
  }
  __syncthreads();
  GM_STAGE(0, 0)
  asm volatile("s_waitcnt vmcnt(0)" ::: "memory");
  __syncthreads();
  const int sw = (r >> 1) & 7;
  const int o0 = ((0 + hb) ^ sw) * 8, o1 = ((2 + hb) ^ sw) * 8, o2 = ((4 + hb) ^ sw) * 8, o3 = ((6 + hb) ^ sw) * 8;
  const int nk = K >> 6;
  for (int kt = 0; kt < nk; ++kt) {
    const int buf = kt & 1;
    if (kt + 1 < nk) GM_STAGE(buf ^ 1, (kt + 1) * 64)
    __builtin_amdgcn_sched_barrier(0);
    const u16* as = (const u16*)(smem + buf * 32768) + (wm * 64 + r) * 64;
    const u16* bs = (const u16*)(smem + buf * 32768 + 16384) + (wn * 64 + r) * 64;
#define GM_LDF(A0, A1, B0, B1, OFF)                                                       \
    A0 = *(const bf16x8*)(as + (OFF)); A1 = *(const bf16x8*)(as + 32 * 64 + (OFF));       \
    B0 = *(const bf16x8*)(bs + (OFF)); B1 = *(const bf16x8*)(bs + 32 * 64 + (OFF));
#define GM_MM(A0, A1, B0, B1)                                                             \
    acc[0][0] = MFMA(A0, B0, acc[0][0]); acc[0][1] = MFMA(A0, B1, acc[0][1]);             \
    acc[1][0] = MFMA(A1, B0, acc[1][0]); acc[1][1] = MFMA(A1, B1, acc[1][1]);
    {
      bf16x8 xa0, xa1, xb0, xb1, ya0, ya1, yb0, yb1;
      GM_LDF(xa0, xa1, xb0, xb1, o0)
      GM_LDF(ya0, ya1, yb0, yb1, o1)
      __builtin_amdgcn_sched_barrier(0);
      GM_MM(xa0, xa1, xb0, xb1)
      __builtin_amdgcn_sched_barrier(0);
      GM_LDF(xa0, xa1, xb0, xb1, o2)
      __builtin_amdgcn_sched_barrier(0);
      GM_MM(ya0, ya1, yb0, yb1)
      __builtin_amdgcn_sched_barrier(0);
      GM_LDF(ya0, ya1, yb0, yb1, o3)
      __builtin_amdgcn_sched_barrier(0);
      GM_MM(xa0, xa1, xb0, xb1)
      __builtin_amdgcn_sched_barrier(0);
      GM_MM(ya0, ya1, yb0, yb1)
    }
    asm volatile("s_waitcnt vmcnt(0)" ::: "memory");
    __syncthreads();
  }
}


DI void gemm_core_wide(const u16* __restrict__ A, int lda, const u16* __restrict__ Bt, int ldb, int K,
                       f32x16 (&acc)[2][4], unsigned char* smem) {
  const int t = tid(), l = t & 63, w = t >> 6, wm = w >> 1, wn = w & 1, hb = l >> 5, r = l & 31;
  const int grow = w * 16 + (l >> 2);
  const int gch = (l & 3) ^ ((l >> 4) & 3);
  const u16* ag = A + (size_t)grow * lda + gch * 8;
  const u16* bg = Bt + (size_t)grow * ldb + gch * 8;
  const unsigned lbase = __builtin_amdgcn_readfirstlane(lds_addr(smem) + w * 1024);
#define GW_STAGE(SLOT, KO)                                                                  \
  {                                                                                         \
    const unsigned sa_ = lbase + (SLOT) * 24576;                                            \
    glds16(ag + (KO), sa_);                                                                 \
    glds16(ag + (size_t)64 * lda + (KO), sa_ + 4096);                                       \
    glds16(bg + (KO), sa_ + 8192);                                                          \
    glds16(bg + (size_t)64 * ldb + (KO), sa_ + 8192 + 4096);                                \
    glds16(bg + (size_t)128 * ldb + (KO), sa_ + 8192 + 8192);                               \
    glds16(bg + (size_t)192 * ldb + (KO), sa_ + 8192 + 12288);                              \
  }
  __syncthreads();
  GW_STAGE(0, 0)
  GW_STAGE(1, 32)
  const int sw = (r >> 2) & 3;
  const int o0 = ((0 + hb) ^ sw) * 8, o1 = ((2 + hb) ^ sw) * 8;
  const int nk = K >> 5;
  int slot = 0;
  for (int kt = 0; kt < nk; ++kt) {
    if (kt + 1 < nk) asm volatile("s_waitcnt vmcnt(6)" ::: "memory"); else asm volatile("s_waitcnt vmcnt(0)" ::: "memory");
    __syncthreads();
    if (kt + 2 < nk) { const int s2 = slot >= 1 ? slot - 1 : 2; GW_STAGE(s2, (kt + 2) * 32) }
    __builtin_amdgcn_sched_barrier(0);
    const u16* as = (const u16*)(smem + slot * 24576) + (wm * 64 + r) * 32;
    const u16* bs = (const u16*)(smem + slot * 24576 + 8192) + (wn * 128 + r) * 32;
    {
      bf16x8 a0 = *(const bf16x8*)(as + o0), a1 = *(const bf16x8*)(as + 32 * 32 + o0);
      bf16x8 b0 = *(const bf16x8*)(bs + o0), b1 = *(const bf16x8*)(bs + 32 * 32 + o0);
      bf16x8 b2 = *(const bf16x8*)(bs + 64 * 32 + o0), b3 = *(const bf16x8*)(bs + 96 * 32 + o0);
      bf16x8 c0 = *(const bf16x8*)(as + o1), c1 = *(const bf16x8*)(as + 32 * 32 + o1);
      bf16x8 d0 = *(const bf16x8*)(bs + o1), d1 = *(const bf16x8*)(bs + 32 * 32 + o1);
      bf16x8 d2 = *(const bf16x8*)(bs + 64 * 32 + o1), d3 = *(const bf16x8*)(bs + 96 * 32 + o1);
      acc[0][0] = MFMA(a0, b0, acc[0][0]); acc[0][1] = MFMA(a0, b1, acc[0][1]); acc[0][2] = MFMA(a0, b2, acc[0][2]); acc[0][3] = MFMA(a0, b3, acc[0][3]);
      acc[1][0] = MFMA(a1, b0, acc[1][0]); acc[1][1] = MFMA(a1, b1, acc[1][1]); acc[1][2] = MFMA(a1, b2, acc[1][2]); acc[1][3] = MFMA(a1, b3, acc[1][3]);
      acc[0][0] = MFMA(c0, d0, acc[0][0]); acc[0][1] = MFMA(c0, d1, acc[0][1]); acc[0][2] = MFMA(c0, d2, acc[0][2]); acc[0][3] = MFMA(c0, d3, acc[0][3]);
      acc[1][0] = MFMA(c1, d0, acc[1][0]); acc[1][1] = MFMA(c1, d1, acc[1][1]); acc[1][2] = MFMA(c1, d2, acc[1][2]); acc[1][3] = MFMA(c1, d3, acc[1][3]);
    }
    slot = slot == 2 ? 0 : slot + 1;
  }
}

constexpr int CT_STRIDE = 132;
DI void acc_to_lds(const f32x16 (&acc)[2][2], unsigned char* smem) {
  const int t = tid(), l = t & 63, w = t >> 6, wm = w >> 1, wn = w & 1, hb = l >> 5, r = l & 31;
  float* base = (float*)smem + (wm * 64 + 4 * hb) * CT_STRIDE + wn * 64 + r;
#pragma unroll
  for (int tm = 0; tm < 2; ++tm)
#pragma unroll
    for (int tn = 0; tn < 2; ++tn)
#pragma unroll
      for (int i = 0; i < 16; ++i) base[(tm * 32 + (i & 3) + 8 * (i >> 2)) * CT_STRIDE + tn * 32] = acc[tm][tn][i];
}
typedef __attribute__((ext_vector_type(4))) float f32x4_t;
DI void nt_store4(float* p, const float4& v) { f32x4_t x = {v.x, v.y, v.z, v.w}; __builtin_nontemporal_store(x, (f32x4_t*)p); }
DI uint4 pack8(const float4& a, const float4& b) { return make_uint4(pk(a.x, a.y), pk(a.z, a.w), pk(b.x, b.y), pk(b.z, b.w)); }

DI void zero_acc(f32x16 (&acc)[2][2]) {
#pragma unroll
  for (int a = 0; a < 2; ++a)
#pragma unroll
    for (int b = 0; b < 2; ++b)
#pragma unroll
      for (int i = 0; i < 16; ++i) acc[a][b][i] = 0.f;
}

DI void transpose_tile(const float* __restrict__ src, u16* __restrict__ dst, int K, int N, int kt, int nt, unsigned char* smem) {
  float* tile = (float*)smem;
  const int t = tid();
  __syncthreads();
#pragma unroll
  for (int i = 0; i < 4; ++i) {
    const int row = (t >> 4) + 16 * i, c4 = (t & 15) * 4;
    const float4 v = *(const float4*)(src + (size_t)(kt * 64 + row) * N + nt * 64 + c4);
    tile[row * 65 + c4 + 0] = v.x; tile[row * 65 + c4 + 1] = v.y; tile[row * 65 + c4 + 2] = v.z; tile[row * 65 + c4 + 3] = v.w;
  }
  __syncthreads();
  const int n = t >> 2, kseg = (t & 3) * 16;
  unsigned o[8];
#pragma unroll
  for (int e = 0; e < 8; ++e) o[e] = pk(tile[(kseg + 2 * e) * 65 + n], tile[(kseg + 2 * e + 1) * 65 + n]);
  u16* d = dst + (size_t)(nt * 64 + n) * K + kt * 64 + kseg;
  *(uint4*)d = make_uint4(o[0], o[1], o[2], o[3]);
  *(uint4*)(d + 8) = make_uint4(o[4], o[5], o[6], o[7]);
}

__device__ const float ROPE_INV[32] = {1.0f, 0.749894202f, 0.562341332f, 0.421696514f, 0.316227764f, 0.237137377f, 0.177827939f, 0.133352146f, 0.100000001f, 0.0749894232f, 0.0562341325f, 0.0421696492f, 0.0316227749f, 0.0237137377f, 0.0177827943f, 0.013335214f, 0.00999999978f, 0.00749894232f, 0.00562341325f, 0.00421696482f, 0.00316227763f, 0.00237137382f, 0.00177827943f, 0.00133352145f, 0.00100000005f, 0.000749894185f, 0.000562341302f, 0.000421696517f, 0.000316227757f, 0.00023713737f, 0.00017782794f, 0.00013335215f};

DI void phase0(const Params& p, unsigned char* smem) {
  const int t = tid();
  if (blockIdx.x == 0) {
    if (t < 4) {
      float s1 = 0.f, s2 = 0.f;
      for (int i = 0; i < 64; ++i) { s1 += p.lq1[t * 64 + i] * p.lk1[t * 64 + i]; s2 += p.lq2[t * 64 + i] * p.lk2[t * 64 + i]; }
      const float li = t == 0 ? 0.2f : (t == 1 ? 0.355509067590969f : (t == 2 ? 0.470713018343584f : 0.556058204155641f));
      p.lam[t] = expf(s1) - expf(s2) + li;
      p.lam[4 + t] = li;
      p.counters[t] = 0; p.counters[4 + t] = 0;
    }
  }
  {
    float* tile = (float*)smem;
    const int trow = t >> 4, tc4 = (t & 15) * 4;
    const int tn = t >> 2, tkseg = (t & 3) * 16;
    const float* tsrc; u16* tdst; int tK, tN, tkt, tnt;
#define TR_DECODE(J)                                                                                                                       \
    if ((J) < 5632) { const int l_ = (J) / 1408, r_ = (J) % 1408; tsrc = p.w_in + (size_t)l_ * 1024 * 5632; tdst = p.WinT + (size_t)l_ * 5632 * 1024; tK = 1024; tN = 5632; tkt = r_ / 88; tnt = r_ % 88; } \
    else if ((J) < 6144) { const int q_ = (J) - 5632, l_ = q_ >> 7, r_ = q_ & 127; tsrc = p.w_oa + (size_t)l_ * 512 * 1024; tdst = p.WoaT + (size_t)l_ * 1024 * 512; tK = 512; tN = 1024; tkt = r_ >> 4; tnt = r_ & 15; } \
    else if ((J) < 6656) { const int q_ = (J) - 6144, l_ = q_ >> 7, r_ = q_ & 127; tsrc = p.w_og + (size_t)l_ * 512 * 1024; tdst = p.WogT + (size_t)l_ * 1024 * 512; tK = 512; tN = 1024; tkt = r_ >> 4; tnt = r_ & 15; } \
    else { const int q_ = (J) - 6656, l_ = q_ >> 8, r_ = q_ & 255; tsrc = p.w_out + (size_t)l_ * 1024 * 1024; tdst = p.WoutT + (size_t)l_ * 1024 * 1024; tK = 1024; tN = 1024; tkt = r_ >> 4; tnt = r_ & 15; }
#define TR_LOAD()                                                                                                                          \
    { const float* s_ = tsrc + (size_t)(tkt * 64 + trow) * tN + tnt * 64 + tc4;                                                            \
      f0 = *(const float4*)s_; f1 = *(const float4*)(s_ + (size_t)16 * tN); f2 = *(const float4*)(s_ + (size_t)32 * tN); f3 = *(const float4*)(s_ + (size_t)48 * tN); }
    float4 f0, f1, f2, f3;
    int j = blockIdx.x;
    if (j < 7680) { TR_DECODE(j) TR_LOAD() }
    for (; j < 7680; j += gridDim.x) {
      u16* d = tdst + (size_t)(tnt * 64 + tn) * tK + tkt * 64 + tkseg;
      __syncthreads();
      float* w0 = tile + trow * 65 + tc4;
      w0[0] = f0.x; w0[1] = f0.y; w0[2] = f0.z; w0[3] = f0.w;
      w0[16 * 65 + 0] = f1.x; w0[16 * 65 + 1] = f1.y; w0[16 * 65 + 2] = f1.z; w0[16 * 65 + 3] = f1.w;
      w0[32 * 65 + 0] = f2.x; w0[32 * 65 + 1] = f2.y; w0[32 * 65 + 2] = f2.z; w0[32 * 65 + 3] = f2.w;
      w0[48 * 65 + 0] = f3.x; w0[48 * 65 + 1] = f3.y; w0[48 * 65 + 2] = f3.z; w0[48 * 65 + 3] = f3.w;
      __syncthreads();
      const int jn = j + gridDim.x;
      if (jn < 7680) { TR_DECODE(jn) TR_LOAD() }
      unsigned o0 = pk(tile[(tkseg + 0) * 65 + tn], tile[(tkseg + 1) * 65 + tn]), o1 = pk(tile[(tkseg + 2) * 65 + tn], tile[(tkseg + 3) * 65 + tn]);
      unsigned o2 = pk(tile[(tkseg + 4) * 65 + tn], tile[(tkseg + 5) * 65 + tn]), o3 = pk(tile[(tkseg + 6) * 65 + tn], tile[(tkseg + 7) * 65 + tn]);
      unsigned o4 = pk(tile[(tkseg + 8) * 65 + tn], tile[(tkseg + 9) * 65 + tn]), o5 = pk(tile[(tkseg + 10) * 65 + tn], tile[(tkseg + 11) * 65 + tn]);
      unsigned o6 = pk(tile[(tkseg + 12) * 65 + tn], tile[(tkseg + 13) * 65 + tn]), o7 = pk(tile[(tkseg + 14) * 65 + tn], tile[(tkseg + 15) * 65 + tn]);
      *(uint4*)d = make_uint4(o0, o1, o2, o3);
      *(uint4*)(d + 8) = make_uint4(o4, o5, o6, o7);
    }
  }
  const int gt = blockIdx.x * 256 + t, gs = gridDim.x * 256;
  for (int idx = gt; idx < MTOK * 128; idx += gs) {
    const int row = idx >> 7, c8 = (idx & 127) * 8;
    const float* src = row < SEQ ? p.x_prompt + (size_t)row * 1024 + c8 : p.x_sample + (size_t)(row - SEQ) * 1024 + c8;
    const float4 a = *(const float4*)src, b = *(const float4*)(src + 4);
    *(uint4*)(p.Xb + (size_t)row * 1024 + c8) = make_uint4(pk(a.x, a.y), pk(a.z, a.w), pk(b.x, b.y), pk(b.z, b.w));
  }
  for (int idx = gt; idx < SEQ * 32; idx += gs) {
    const int pos = idx >> 5, j = idx & 31;
    const float inv = ROPE_INV[j];
    const float ang = (float)pos * inv;
    double rev = (double)ang * 0.15915494309189535;
    rev -= rint(rev);
    const float rf = (float)rev;
    p.rope[2 * idx] = __builtin_amdgcn_cosf(rf);
    p.rope[2 * idx + 1] = __builtin_amdgcn_sinf(rf);
  }
}

constexpr int CW_STRIDE = 260;
DI void phaseA_tile(const Params& p, int layer, int mt, int nt, unsigned char* smem) {
  f32x16 acc[2][4];
#pragma unroll
  for (int a = 0; a < 2; ++a)
#pragma unroll
    for (int b = 0; b < 4; ++b)
#pragma unroll
      for (int i = 0; i < 16; ++i) acc[a][b][i] = 0.f;
  gemm_core_wide(p.Xb + (size_t)mt * 128 * 1024, 1024, p.WinT + ((size_t)layer * 5632 + nt * 256) * 1024, 1024, 1024, acc, smem);
  const int t = tid(), l = t & 63, w = t >> 6, wm = w >> 1, wn = w & 1, hb = l >> 5, r = l & 31;
  const int n0 = nt * 256, seg = n0 >> 9;
  const bool samp = mt >= 128;
  float* ct = (float*)smem;
#pragma unroll
  for (int h = 0; h < 2; ++h) {
    __syncthreads();
    if (wm == h) {
      float* base = ct + (4 * hb) * CW_STRIDE + wn * 128 + r;
#pragma unroll
      for (int tm = 0; tm < 2; ++tm)
#pragma unroll
        for (int tn = 0; tn < 4; ++tn)
#pragma unroll
          for (int i = 0; i < 16; ++i) base[(tm * 32 + (i & 3) + 8 * (i >> 2)) * CW_STRIDE + tn * 32] = acc[tm][tn][i];
    }
    __syncthreads();
    if (seg <= 1) {
      const int j = t & 15, head = j >> 2, c8 = (j & 3) * 8;
#pragma unroll
      for (int i = 0; i < 4; ++i) {
        const int rl = (t >> 4) + 16 * i;
        const int row = mt * 128 + h * 64 + rl;
        const int pos = samp ? 1024 + ((row - SEQ) & 31) : row;
        const float* cp = ct + rl * CW_STRIDE + head * 64 + c8;
        const float4 xa0 = *(const float4*)cp, xa1 = *(const float4*)(cp + 4);
        const float4 xb0 = *(const float4*)(cp + 32), xb1 = *(const float4*)(cp + 36);
        const float4* rp = (const float4*)(p.rope + ((size_t)pos * 32 + c8) * 2);
        const float4 r0 = rp[0], r1 = rp[1], r2 = rp[2], r3 = rp[3];
        float4 ya0, ya1, yb0, yb1;
        ya0.x = xa0.x * r0.x - xb0.x * r0.y; yb0.x = xb0.x * r0.x + xa0.x * r0.y;
        ya0.y = xa0.y * r0.z - xb0.y * r0.w; yb0.y = xb0.y * r0.z + xa0.y * r0.w;
        ya0.z = xa0.z * r1.x - xb0.z * r1.y; yb0.z = xb0.z * r1.x + xa0.z * r1.y;
        ya0.w = xa0.w * r1.z - xb0.w * r1.w; yb0.w = xb0.w * r1.z + xa0.w * r1.w;
        ya1.x = xa1.x * r2.x - xb1.x * r2.y; yb1.x = xb1.x * r2.x + xa1.x * r2.y;
        ya1.y = xa1.y * r2.z - xb1.y * r2.w; yb1.y = xb1.y * r2.z + xa1.y * r2.w;
        ya1.z = xa1.z * r3.x - xb1.z * r3.y; yb1.z = xb1.z * r3.x + xa1.z * r3.y;
        ya1.w = xa1.w * r3.z - xb1.w * r3.w; yb1.w = xb1.w * r3.z + xa1.w * r3.w;
        const int col = n0 + head * 64 + c8;
        u16* hp = p.H + (size_t)row * INW + col;
        if (seg == 0) {
          const float qs = 0.125f * 1.4426950408889634f;
          *(uint4*)hp = make_uint4(pk(ya0.x * qs, ya0.y * qs), pk(ya0.z * qs, ya0.w * qs), pk(ya1.x * qs, ya1.y * qs), pk(ya1.z * qs, ya1.w * qs));
          *(uint4*)(hp + 32) = make_uint4(pk(yb0.x * qs, yb0.y * qs), pk(yb0.z * qs, yb0.w * qs), pk(yb1.x * qs, yb1.y * qs), pk(yb1.z * qs, yb1.w * qs));
        } else {
          *(uint4*)hp = pack8(ya0, ya1);
          *(uint4*)(hp + 32) = pack8(yb0, yb1);
        }
        if (seg == 1) {
          float* o = samp ? p.out + OFF_KS + ((size_t)layer * 1024 + (row - SEQ)) * 512 + (col - C_K)
                          : p.out + OFF_KP + ((size_t)layer * SEQ + row) * 512 + (col - C_K);
          nt_store4(o, ya0); nt_store4(o + 4, ya1); nt_store4(o + 32, yb0); nt_store4(o + 36, yb1);
        }
      }
    } else {
      const int c8 = (t & 31) * 8;
#pragma unroll
      for (int i = 0; i < 8; ++i) {
        const int rl = (t >> 5) + 8 * i;
        const int row = mt * 128 + h * 64 + rl;
        const float* cp = ct + rl * CW_STRIDE + c8;
        const float4 v0 = *(const float4*)cp, v1 = *(const float4*)(cp + 4);
        const int col = n0 + c8;
        *(uint4*)(p.H + (size_t)row * INW + col) = pack8(v0, v1);
        if (seg == 2) {
          float* o = samp ? p.out + OFF_VS + ((size_t)layer * 1024 + (row - SEQ)) * 512 + (col - C_V)
                          : p.out + OFF_VP + ((size_t)layer * SEQ + row) * 512 + (col - C_V);
          nt_store4(o, v0); nt_store4(o + 4, v1);
        }
      }
    }
  }
}

constexpr int KS_STRIDE = 72;
constexpr int VS_STRIDE = 160;
constexpr int ST_K = 2 * 64 * KS_STRIDE;
constexpr int ST_BYTES = ST_K * 2 + 64 * VS_STRIDE * 2;

#define LOADV(D0, D1, D2, D3, G)                                                             \
  {                                                                                          \
    const u16* vk_ = vp + ((G) * 16) * VROW;                                                 \
    D0 = cat8(tr_read(vk_ + vo0), tr_read(vk_ + 8 * VROW + vo0));                            \
    D1 = cat8(tr_read(vk_ + vo1), tr_read(vk_ + 8 * VROW + vo1));                            \
    D2 = cat8(tr_read(vk_ + vo2), tr_read(vk_ + 8 * VROW + vo2));                            \
    D3 = cat8(tr_read(vk_ + vo3), tr_read(vk_ + 8 * VROW + vo3));                            \
  }
#define PACKP(S, U) __builtin_bit_cast(bf16x8, make_uint4(pk(S[8 * (U) + 0], S[8 * (U) + 1]), pk(S[8 * (U) + 2], S[8 * (U) + 3]), pk(S[8 * (U) + 4], S[8 * (U) + 5]), pk(S[8 * (U) + 6], S[8 * (U) + 7])))
#define PVMFMA(D0, D1, D2, D3, PB) { O[0] = MFMA(D0, PB, O[0]); O[1] = MFMA(D1, PB, O[1]); O[2] = MFMA(D2, PB, O[2]); O[3] = MFMA(D3, PB, O[3]); }
template <bool SWZ>
DI void attn_compute(const u16* Kb, const u16* Vb, const bf16x8 (&qf)[4], f32x16 (&O)[4], f32x16& Mneg, float& m_run, float& l_run, bool two, int s) {
  const int l = tid() & 63, hb = l >> 5, r = l & 31;
  f32x16 S0, S1;
  constexpr int KROW = SWZ ? 64 : KS_STRIDE, VROW = SWZ ? 128 : VS_STRIDE;
  const int q4 = (l & 15) >> 2, p4 = l & 3, blk = (l >> 4) & 1;
  const int ksw = SWZ ? ((r >> 1) & 7) : 0;
  const u16* kp = Kb + (s * 64 + r) * KROW;
  const int ko0 = ((0 + hb) ^ ksw) * 8, ko1 = ((2 + hb) ^ ksw) * 8, ko2 = ((4 + hb) ^ ksw) * 8, ko3 = ((6 + hb) ^ ksw) * 8;
  const u16* vp = Vb + (4 * hb + q4) * VROW + blk * 16 + p4 * 4;
  const int vsw = SWZ ? q4 : 0;
  const int vo0 = (0 ^ vsw) * 32, vo1 = (1 ^ vsw) * 32, vo2 = (2 ^ vsw) * 32, vo3 = (3 ^ vsw) * 32;
  bf16x8 ka0, ka1, ka2, ka3, kb0, kb1, kb2, kb3, va0, va1, va2, va3, vb0, vb1, vb2, vb3;
  ka0 = *(const bf16x8*)(kp + ko0); ka1 = *(const bf16x8*)(kp + ko1); ka2 = *(const bf16x8*)(kp + ko2); ka3 = *(const bf16x8*)(kp + ko3);
  if (two) {
    kb0 = *(const bf16x8*)(kp + 32 * KROW + ko0); kb1 = *(const bf16x8*)(kp + 32 * KROW + ko1);
    kb2 = *(const bf16x8*)(kp + 32 * KROW + ko2); kb3 = *(const bf16x8*)(kp + 32 * KROW + ko3);
  }
  LOADV(va0, va1, va2, va3, 0)
  __builtin_amdgcn_sched_barrier(0);
  S0 = MFMA(ka0, qf[0], Mneg); S0 = MFMA(ka1, qf[1], S0); S0 = MFMA(ka2, qf[2], S0); S0 = MFMA(ka3, qf[3], S0);
  if (two) { S1 = MFMA(kb0, qf[0], Mneg); S1 = MFMA(kb1, qf[1], S1); S1 = MFMA(kb2, qf[2], S1); S1 = MFMA(kb3, qf[3], S1); }
  float ls = 0.f;
#pragma unroll
  for (int i = 0; i < 16; ++i) { S0[i] = __builtin_amdgcn_exp2f(S0[i]); ls += S0[i]; }
  if (two) {
#pragma unroll
    for (int i = 0; i < 16; ++i) { S1[i] = __builtin_amdgcn_exp2f(S1[i]); ls += S1[i]; }
  }
  if (__any(!(ls <= 4194304.f))) {
    bf16x8 ra0 = *(const bf16x8*)(kp + ko0), ra1 = *(const bf16x8*)(kp + ko1), ra2 = *(const bf16x8*)(kp + ko2), ra3 = *(const bf16x8*)(kp + ko3);
#pragma unroll
    for (int i = 0; i < 16; ++i) { S0[i] = 0.f; S1[i] = 0.f; }
    S0 = MFMA(ra0, qf[0], S0); S0 = MFMA(ra1, qf[1], S0); S0 = MFMA(ra2, qf[2], S0); S0 = MFMA(ra3, qf[3], S0);
    if (two) {
      ra0 = *(const bf16x8*)(kp + 32 * KROW + ko0); ra1 = *(const bf16x8*)(kp + 32 * KROW + ko1);
      ra2 = *(const bf16x8*)(kp + 32 * KROW + ko2); ra3 = *(const bf16x8*)(kp + 32 * KROW + ko3);
      S1 = MFMA(ra0, qf[0], S1); S1 = MFMA(ra1, qf[1], S1); S1 = MFMA(ra2, qf[2], S1); S1 = MFMA(ra3, qf[3], S1);
    }
    float mx = S0[0];
#pragma unroll
    for (int i = 1; i < 16; ++i) mx = fmaxf(mx, S0[i]);
    if (two) {
#pragma unroll
      for (int i = 0; i < 16; ++i) mx = fmaxf(mx, S1[i]);
    }
    mx = fmaxf(mx, __shfl_xor(mx, 32));
    const float m_new = fmaxf(m_run, mx);
    const float alpha = __builtin_amdgcn_exp2f(m_run - m_new);
    m_run = m_new;
#pragma unroll
    for (int i = 0; i < 16; ++i) Mneg[i] = -m_new;
    l_run *= alpha;
#pragma unroll
    for (int dt = 0; dt < 4; ++dt)
#pragma unroll
      for (int i = 0; i < 16; ++i) O[dt][i] *= alpha;
    ls = 0.f;
#pragma unroll
    for (int i = 0; i < 16; ++i) { S0[i] = __builtin_amdgcn_exp2f(S0[i] - m_new); ls += S0[i]; }
    if (two) {
#pragma unroll
      for (int i = 0; i < 16; ++i) { S1[i] = __builtin_amdgcn_exp2f(S1[i] - m_new); ls += S1[i]; }
    }
  }
  l_run += ls;
  {
    const bf16x8 pb0 = PACKP(S0, 0);
    __builtin_amdgcn_sched_barrier(0);
    LOADV(vb0, vb1, vb2, vb3, 1)
    __builtin_amdgcn_sched_barrier(0);
    PVMFMA(va0, va1, va2, va3, pb0)
    const bf16x8 pb1 = PACKP(S0, 1);
    __builtin_amdgcn_sched_barrier(0);
    if (two) LOADV(va0, va1, va2, va3, 2)
    __builtin_amdgcn_sched_barrier(0);
    PVMFMA(vb0, vb1, vb2, vb3, pb1)
    if (two) {
      const bf16x8 pb2 = PACKP(S1, 0);
      __builtin_amdgcn_sched_barrier(0);
      LOADV(vb0, vb1, vb2, vb3, 3)
      __builtin_amdgcn_sched_barrier(0);
      PVMFMA(va0, va1, va2, va3, pb2)
      const bf16x8 pb3 = PACKP(S1, 1);
      __builtin_amdgcn_sched_barrier(0);
      PVMFMA(vb0, vb1, vb2, vb3, pb3)
    }
  }
}

template <bool SAMPLE>
DI void attn_item(const Params& p, int layer, int a, int h, unsigned char* smem) {
  const int t = tid(), l = t & 63, w = t >> 6, rg = w & 1, s = w >> 1, hb = l >> 5, r = l & 31;
  const int hh = 2 * h + s;
  const int qrow0 = SAMPLE ? SEQ + a * 32 : a * 64 + rg * 32;
  const bool active = SAMPLE ? (rg == 0) : true;
  const u16* H = p.H;
  bf16x8 qf[4];
  {
    const u16* qp = H + (size_t)(qrow0 + r) * INW + hh * 64 + hb * 8;
#pragma unroll
    for (int ks = 0; ks < 4; ++ks) qf[ks] = *(const bf16x8*)(qp + ks * 16);
  }
  f32x16 O[4];
#pragma unroll
  for (int dt = 0; dt < 4; ++dt)
#pragma unroll
    for (int i = 0; i < 16; ++i) O[dt][i] = 0.f;
  float m_run = -1e30f, l_run = 0.f;
  f32x16 Mneg;
#pragma unroll
  for (int i = 0; i < 16; ++i) Mneg[i] = 1e30f;
  u16* sm = (u16*)smem;

  __syncthreads();
  if (!SAMPLE) {
    const int ntiles = a + 1;
    const u16* kg = H + C_K + (2 * h) * 64;
    const u16* vg = H + C_V + h * 128;
    const int krow = w * 8 + (l >> 3);
    const u16* kq = kg + (size_t)krow * INW + ((l & 7) ^ ((krow >> 1) & 7)) * 8;
    const int vrow = w * 4 + (l >> 4);
    const u16* vq = vg + (size_t)vrow * INW + ((l & 15) ^ (((l >> 4) & 3) << 2)) * 8;
    const unsigned lb = __builtin_amdgcn_readfirstlane(lds_addr(smem) + w * 1024);
#define ATT_STAGE(BUF, KT)                                                                                \
    {                                                                                                     \
      const unsigned sb_ = lb + (BUF) * 32768;                                                            \
      const u16* k_ = kq + (size_t)(KT) * 64 * INW;                                                       \
      const u16* v_ = vq + (size_t)(KT) * 64 * INW;                                                       \
      glds16(k_, sb_); glds16(k_ + (size_t)32 * INW, sb_ + 4096);                                         \
      glds16(k_ + 64, sb_ + 8192); glds16(k_ + (size_t)32 * INW + 64, sb_ + 12288);                       \
      glds16(v_, sb_ + 16384); glds16(v_ + (size_t)16 * INW, sb_ + 16384 + 4096);                         \
      glds16(v_ + (size_t)32 * INW, sb_ + 16384 + 8192); glds16(v_ + (size_t)48 * INW, sb_ + 16384 + 12288); \
    }
    ATT_STAGE(0, 0)
    asm volatile("s_waitcnt vmcnt(0)" ::: "memory");
    __syncthreads();
    for (int kt = 0; kt < ntiles; ++kt) {
      const int buf = kt & 1;
      if (kt + 1 < ntiles) ATT_STAGE(buf ^ 1, kt + 1)
      __builtin_amdgcn_sched_barrier(0);
      const u16* kb = sm + buf * 16384;
      attn_compute<true>(kb, kb + 8192, qf, O, Mneg, m_run, l_run, true, s);
      asm volatile("s_waitcnt vmcnt(0)" ::: "memory");
      __syncthreads();
    }
  } else {
    const float* ck = p.cache_k + ((size_t)(layer * 32 + a) * 1024) * 512 + (2 * h) * 64;
    const float* cv = p.cache_v + ((size_t)(layer * 32 + a) * 1024) * 512 + h * 128;
    for (int j = 0; j < 9; ++j) {
      for (int g = 0; g < 2; ++g) {
        const int kt = 2 * j + g;
        u16* kb = sm + g * (ST_BYTES / 2);
        u16* vb = kb + ST_K;
        if (kt < 16) {
#pragma unroll
          for (int i = 0; i < 8; ++i) {
            const int cc = t + 256 * i;
            const int sh = cc >> 10, key = (cc >> 4) & 63, ch = cc & 15;
            const float4 v = *(const float4*)(ck + (size_t)(kt * 64 + key) * 512 + sh * 64 + ch * 4);
            *(uint2*)(kb + (sh * 64 + key) * KS_STRIDE + ch * 4) = make_uint2(pk(v.x, v.y), pk(v.z, v.w));
            const int vkey = cc >> 5, vch = cc & 31;
            const float4 u = *(const float4*)(cv + (size_t)(kt * 64 + vkey) * 512 + vch * 4);
            *(uint2*)(vb + vkey * VS_STRIDE + vch * 4) = make_uint2(pk(u.x, u.y), pk(u.z, u.w));
          }
        } else if (kt == 16) {
          const u16* kg = H + (size_t)(SEQ + a * 32) * INW + C_K + (2 * h) * 64;
          const u16* vg = H + (size_t)(SEQ + a * 32) * INW + C_V + h * 128;
#pragma unroll
          for (int i = 0; i < 2; ++i) {
            const int cc = t + 256 * i;
            const int sh = cc >> 8, key = (cc >> 3) & 31, ch = cc & 7;
            *(uint4*)(kb + (sh * 64 + key) * KS_STRIDE + ch * 8) = *(const uint4*)(kg + (size_t)key * INW + sh * 64 + ch * 8);
            const int vkey = cc >> 4, vch = cc & 15;
            *(uint4*)(vb + vkey * VS_STRIDE + vch * 8) = *(const uint4*)(vg + (size_t)vkey * INW + vch * 8);
          }
        }
      }
      __syncthreads();
      {
        const int kt = 2 * j + rg;
        const u16* kb = sm + rg * (ST_BYTES / 2);
        if (kt <= 16) attn_compute<false>(kb, kb + ST_K, qf, O, Mneg, m_run, l_run, kt < 16, s);
      }
      __syncthreads();
    }
    float* mgO = (float*)smem;
    float* mgML = (float*)(smem + 32768);
    if (rg == 1) {
#pragma unroll
      for (int dt = 0; dt < 4; ++dt)
#pragma unroll
        for (int i = 0; i < 16; ++i) mgO[(s * 128 + dt * 32 + crow(i, hb)) * 32 + r] = O[dt][i];
      mgML[(s * 64 + l) * 2] = m_run; mgML[(s * 64 + l) * 2 + 1] = l_run;
    }
    __syncthreads();
    if (rg == 0) {
      const float m1 = mgML[(s * 64 + l) * 2], l1 = mgML[(s * 64 + l) * 2 + 1];
      const float mm = fmaxf(m_run, m1);
      const float a0 = __builtin_amdgcn_exp2f(m_run - mm), a1 = __builtin_amdgcn_exp2f(m1 - mm);
#pragma unroll
      for (int dt = 0; dt < 4; ++dt)
#pragma unroll
        for (int i = 0; i < 16; ++i) O[dt][i] = O[dt][i] * a0 + mgO[(s * 128 + dt * 32 + crow(i, hb)) * 32 + r] * a1;
      l_run = l_run * a0 + l1 * a1;
      m_run = mm;
    }
    __syncthreads();
  }
  const int te = tid(), le = te & 63, re = le & 31, hbe = le >> 5, rge = (te >> 6) & 1, se = te >> 7;
  const bool acte = SAMPLE ? (rge == 0) : true;
  float lt = l_run + __shfl_xor(l_run, 32);
  const float inv_l = 1.f / lt;
  float* ex = (float*)smem;
  if (se == 1 && acte) {
#pragma unroll
    for (int dt = 0; dt < 4; ++dt)
#pragma unroll
      for (int i = 0; i < 16; ++i) ex[(rge * 128 + dt * 32 + crow(i, hbe)) * 32 + re] = O[dt][i] * inv_l;
  }
  __syncthreads();
  if (se == 0 && acte) {
    const float lam = __hip_atomic_load(p.lam + layer, __ATOMIC_RELAXED, __HIP_MEMORY_SCOPE_AGENT);
    const float li = __hip_atomic_load(p.lam + 4 + layer, __ATOMIC_RELAXED, __HIP_MEMORY_SCOPE_AGENT);
    float ss = 0.f;
#pragma unroll
    for (int dt = 0; dt < 4; ++dt)
#pragma unroll
      for (int i = 0; i < 16; ++i) {
        const float o = O[dt][i] * inv_l - lam * ex[(rge * 128 + dt * 32 + crow(i, hbe)) * 32 + re];
        O[dt][i] = o; ss += o * o;
      }
    ss += __shfl_xor(ss, 32);
    const float rs = rsqrtf(ss * (1.f / 128.f) + LN_EPS) * (1.f - li);
    const int row = (SAMPLE ? SEQ + a * 32 : a * 64 + rge * 32) + re;
    const u16* gp = H + (size_t)row * INW + C_GA + h * 128;
    u16* op = p.A1 + (size_t)row * 512 + h * 128;
    const float* sw = p.subln_w + layer * 128;
#pragma unroll
    for (int dt = 0; dt < 4; ++dt)
#pragma unroll
      for (int g4 = 0; g4 < 4; ++g4) {
        const int d = dt * 32 + 8 * g4 + 4 * hbe;
        const uint2 gv = *(const uint2*)(gp + d);
        const float4 wv = *(const float4*)(sw + d);
        const float y0 = O[dt][4 * g4 + 0] * rs * wv.x * siluf_(bflo(gv.x));
        const float y1 = O[dt][4 * g4 + 1] * rs * wv.y * siluf_(bfhi(gv.x));
        const float y2 = O[dt][4 * g4 + 2] * rs * wv.z * siluf_(bflo(gv.y));
        const float y3 = O[dt][4 * g4 + 3] * rs * wv.w * siluf_(bfhi(gv.y));
        *(uint2*)(op + d) = make_uint2(pk(y0, y1), pk(y2, y3));
      }
  }
}

DI void sgu_item(const Params& p, int layer, int chunk, int g, unsigned char* smem) {
  const int t = tid(), l = t & 63, w = t >> 6, wm = w >> 1, wn = w & 1, hb = l >> 5, r = l & 31;
  const int m0 = chunk * 128;
  const bool samp = chunk >= 128;
  u16* Asg = (u16*)smem;
  u16* Bsg = Asg + 128 * 72;
  float* st = (float*)(smem + 38912);
  const u16* H = p.H;
  __syncthreads();
#pragma unroll 8
  for (int rr = 0; rr < 32; ++rr) {
    const int row = w * 32 + rr;
    const uint4 v = *(const uint4*)(H + (size_t)(m0 + row) * INW + C_VG + l * 8);
    float x[8] = {bflo(v.x), bfhi(v.x), bflo(v.y), bfhi(v.y), bflo(v.z), bfhi(v.z), bflo(v.w), bfhi(v.w)};
    float s1 = 0.f, s2 = 0.f;
#pragma unroll
    for (int e = 0; e < 8; ++e) { s1 += x[e]; s2 += x[e] * x[e]; }
#pragma unroll
    for (int o = 32; o >= 1; o >>= 1) { s1 += __shfl_xor(s1, o); s2 += __shfl_xor(s2, o); }
    if (l == 0) {
      const float mean = s1 * (1.f / 512.f);
      const float var = fmaxf(s2 * (1.f / 512.f) - mean * mean, 0.f);
      st[row] = mean; st[128 + row] = rsqrtf(var + LN_EPS);
    }
  }
  __syncthreads();
  uint4 puu[8], pgg[8];
#pragma unroll
  for (int i = 0; i < 8; ++i) {
    const u16* hp = H + (size_t)(m0 + (t >> 4) + 16 * i) * INW + g * 128 + (t & 15) * 8;
    puu[i] = *(const uint4*)(hp + C_U); pgg[i] = *(const uint4*)(hp + C_GG);
  }
  f32x16 acc[2][2];
  zero_acc(acc);
  const float* Wg = p.w_s + ((size_t)(layer * 4 + g) * 128) * 128;
  const float* gam = p.sgu_g + layer * 512 + g * 128;
  const float* bet = p.sgu_b + layer * 512 + g * 128;
  const int q4 = (l & 15) >> 2, p4 = l & 3, blk = (l >> 4) & 1;
  for (int kh = 0; kh < 2; ++kh) {
#pragma unroll
    for (int i8 = 0; i8 < 8; ++i8) {
      const int cc = t + 256 * i8;
      const int i = cc >> 4, j4 = (cc & 15) * 4, j = kh * 64 + j4;
      float4 v;
      float e0, e1, e2, e3;
      if (!samp) {
        v = *(const float4*)(Wg + i * 128 + j);
        e0 = (j + 0 <= i) ? v.x : 0.f; e1 = (j + 1 <= i) ? v.y : 0.f; e2 = (j + 2 <= i) ? v.z : 0.f; e3 = (j + 3 <= i) ? v.w : 0.f;
      } else {
        const int i32 = i & 31, j32 = j & 31;
        v = *(const float4*)(Wg + i32 * 128 + j32);
        const bool same = (i >> 5) == (j >> 5);
        e0 = (same && j32 + 0 <= i32) ? v.x : 0.f; e1 = (same && j32 + 1 <= i32) ? v.y : 0.f;
        e2 = (same && j32 + 2 <= i32) ? v.z : 0.f; e3 = (same && j32 + 3 <= i32) ? v.w : 0.f;
      }
      *(uint2*)(Asg + i * 72 + j4) = make_uint2(pk(e0, e1), pk(e2, e3));
    }
#pragma unroll
    for (int i4 = 0; i4 < 4; ++i4) {
      const int cc = t + 256 * i4;
      const int jj = cc >> 4, dc = (cc & 15) * 8;
      const int jrow = kh * 64 + jj;
      const uint4 v = *(const uint4*)(H + (size_t)(m0 + jrow) * INW + C_VG + g * 128 + dc);
      const float mean = st[jrow], rstd = st[128 + jrow];
      const float4 g0 = *(const float4*)(gam + dc), g1 = *(const float4*)(gam + dc + 4);
      const float4 b0 = *(const float4*)(bet + dc), b1 = *(const float4*)(bet + dc + 4);
      const float y0 = (bflo(v.x) - mean) * rstd * g0.x + b0.x, y1 = (bfhi(v.x) - mean) * rstd * g0.y + b0.y;
      const float y2 = (bflo(v.y) - mean) * rstd * g0.z + b0.z, y3 = (bfhi(v.y) - mean) * rstd * g0.w + b0.w;
      const float y4 = (bflo(v.z) - mean) * rstd * g1.x + b1.x, y5 = (bfhi(v.z) - mean) * rstd * g1.y + b1.y;
      const float y6 = (bflo(v.w) - mean) * rstd * g1.z + b1.z, y7 = (bfhi(v.w) - mean) * rstd * g1.w + b1.w;
      *(uint4*)(Bsg + jj * VS_STRIDE + dc) = make_uint4(pk(y0, y1), pk(y2, y3), pk(y4, y5), pk(y6, y7));
      if (samp) {
        float* o = p.out + OFF_GV + ((size_t)layer * 1024 + (m0 - SEQ) + jrow) * 512 + g * 128 + dc;
        *(float4*)o = make_float4(y0, y1, y2, y3);
        *(float4*)(o + 4) = make_float4(y4, y5, y6, y7);
      }
    }
    __syncthreads();
    const u16* as = Asg + (wm * 64 + r) * 72 + hb * 8;
    const u16* bs = Bsg + (8 * hb + q4) * VS_STRIDE + wn * 64 + blk * 16 + p4 * 4;
#pragma unroll
    for (int ks = 0; ks < 4; ++ks) {
      bf16x8 a0 = *(const bf16x8*)(as + ks * 16), a1 = *(const bf16x8*)(as + 32 * 72 + ks * 16);
      const u16* bk = bs + ks * 16 * VS_STRIDE;
      bf16x8 b0 = cat8(tr_read(bk), tr_read(bk + 4 * VS_STRIDE));
      bf16x8 b1 = cat8(tr_read(bk + 32), tr_read(bk + 4 * VS_STRIDE + 32));
      acc[0][0] = MFMA(a0, b0, acc[0][0]); acc[0][1] = MFMA(a0, b1, acc[0][1]);
      acc[1][0] = MFMA(a1, b0, acc[1][0]); acc[1][1] = MFMA(a1, b1, acc[1][1]);
    }
    __syncthreads();
  }
  const float* bsp = p.b_s + (size_t)(layer * 4 + g) * 128;
  acc_to_lds(acc, smem);
  __syncthreads();
  {
    const float* ct = (const float*)smem;
    const int c8 = (t & 15) * 8;
#pragma unroll
    for (int i = 0; i < 8; ++i) {
      const int rl = (t >> 4) + 16 * i;
      const int row = m0 + rl;
      const float* cp = ct + rl * CT_STRIDE + c8;
      const float4 v0 = *(const float4*)cp, v1 = *(const float4*)(cp + 4);
      const float bias = bsp[samp ? (rl & 31) : rl];
      const uint4 uu = puu[i], gg = pgg[i];
      float4 o0, o1;
      o0.x = (v0.x + bias) * bflo(uu.x) * siluf_(bflo(gg.x)); o0.y = (v0.y + bias) * bfhi(uu.x) * siluf_(bfhi(gg.x));
      o0.z = (v0.z + bias) * bflo(uu.y) * siluf_(bflo(gg.y)); o0.w = (v0.w + bias) * bfhi(uu.y) * siluf_(bfhi(gg.y));
      o1.x = (v1.x + bias) * bflo(uu.z) * siluf_(bflo(gg.z)); o1.y = (v1.y + bias) * bfhi(uu.z) * siluf_(bfhi(gg.z));
      o1.z = (v1.z + bias) * bflo(uu.w) * siluf_(bflo(gg.w)); o1.w = (v1.w + bias) * bfhi(uu.w) * siluf_(bfhi(gg.w));
      *(uint4*)(p.A2 + (size_t)row * 512 + g * 128 + c8) = pack8(o0, o1);
    }
  }
}

DI void phaseB(const Params& p, int layer_slot, unsigned char* smem) {
  const int layer = layer_slot & 3;
  int* s_item = (int*)(smem + 77824);
  const bool stat = gridDim.x == 512;
  const int sq = 2 * (blockIdx.x >> 3) + ((blockIdx.x >> 2) & 1), sh = blockIdx.x & 3;
  const int total = stat ? 672 : 1696;
  for (int n = 0;; ++n) {
    int kind, a, h;
    if (stat && n < 2) { kind = 1; a = n ? sq : 255 - sq; h = sh; }
    else {
      __syncthreads();
      if (threadIdx.x == 0) *s_item = atomicAdd(p.counters + layer_slot, 1);
      __syncthreads();
      const int it = *s_item;
      if (it >= total) break;
      if (it < 128) { kind = 0; a = it >> 2; h = it & 3; }
      else if (it < 672) { kind = 2; a = (it - 128) >> 2; h = (it - 128) & 3; }
      else { kind = 1; a = 255 - ((it - 672) >> 2); h = (it - 672) & 3; }
    }
    if (kind == 0) attn_item<true>(p, layer, a, h, smem);
    else if (kind == 1) attn_item<false>(p, layer, a, h, smem);
    else sgu_item(p, layer, a, h, smem);
  }
}

DI void phaseC1_tile(const Params& p, int layer, int mt, int nt, unsigned char* smem) {
  const int t = tid();
  const int c8 = (t & 15) * 8;
  const float* ct = (const float*)smem;
  f32x16 acc[2][2];
  uint4 ya[8], gma[8], gmb[8];
#pragma unroll
  for (int i = 0; i < 8; ++i) {
    const u16* hp = p.H + (size_t)(mt * 128 + (t >> 4) + 16 * i) * INW + nt * 128 + c8;
    gma[i] = *(const uint4*)(hp + C_MA); gmb[i] = *(const uint4*)(hp + C_MB);
  }
  zero_acc(acc);
  gemm_core(p.A1 + (size_t)mt * 128 * 512, 512, p.WoaT + ((size_t)layer * 1024 + nt * 128) * 512, 512, 512, acc, smem);
  acc_to_lds(acc, smem);
  __syncthreads();
#pragma unroll
  for (int i = 0; i < 8; ++i) {
    const int rl = (t >> 4) + 16 * i;
    const int row = mt * 128 + rl;
    const float* cp = ct + rl * CT_STRIDE + c8;
    const float4 v0 = *(const float4*)cp, v1 = *(const float4*)(cp + 4);
    const uint4 g = gma[i];
    ya[i] = make_uint4(pk(v0.x * sigmoidf_(bflo(g.x)), v0.y * sigmoidf_(bfhi(g.x))), pk(v0.z * sigmoidf_(bflo(g.y)), v0.w * sigmoidf_(bfhi(g.y))),
                       pk(v1.x * sigmoidf_(bflo(g.z)), v1.y * sigmoidf_(bfhi(g.z))), pk(v1.z * sigmoidf_(bflo(g.w)), v1.w * sigmoidf_(bfhi(g.w))));
  }
  zero_acc(acc);
  gemm_core(p.A2 + (size_t)mt * 128 * 512, 512, p.WogT + ((size_t)layer * 1024 + nt * 128) * 512, 512, 512, acc, smem);
  acc_to_lds(acc, smem);
  __syncthreads();
#pragma unroll
  for (int i = 0; i < 8; ++i) {
    const int rl = (t >> 4) + 16 * i;
    const int row = mt * 128 + rl;
    const float* cp = ct + rl * CT_STRIDE + c8;
    const float4 v0 = *(const float4*)cp, v1 = *(const float4*)(cp + 4);
    const uint4 g = gmb[i];
    float4 o0, o1;
    const float4 ma0 = make_float4(bflo(ya[i].x), bfhi(ya[i].x), bflo(ya[i].y), bfhi(ya[i].y));
    const float4 ma1 = make_float4(bflo(ya[i].z), bfhi(ya[i].z), bflo(ya[i].w), bfhi(ya[i].w));
    o0.x = ma0.x + v0.x * sigmoidf_(bflo(g.x)); o0.y = ma0.y + v0.y * sigmoidf_(bfhi(g.x));
    o0.z = ma0.z + v0.z * sigmoidf_(bflo(g.y)); o0.w = ma0.w + v0.w * sigmoidf_(bfhi(g.y));
    o1.x = ma1.x + v1.x * sigmoidf_(bflo(g.z)); o1.y = ma1.y + v1.y * sigmoidf_(bfhi(g.z));
    o1.z = ma1.z + v1.z * sigmoidf_(bflo(g.w)); o1.w = ma1.w + v1.w * sigmoidf_(bfhi(g.w));
    *(uint4*)(p.Mg + (size_t)row * 1024 + nt * 128 + c8) = pack8(o0, o1);
  }
}

DI void phaseC2_tile(const Params& p, int layer, int mt, int nt, unsigned char* smem) {
  const int t = tid();
  const int c8 = (t & 15) * 8;
  const float* ct = (const float*)smem;
  const float* xsrc = layer == 0 ? (mt < 128 ? p.x_prompt : p.x_sample - (size_t)SEQ * 1024) : p.Xf;
  float4 xr0[8], xr1[8];
#pragma unroll
  for (int i = 0; i < 8; ++i) {
    const float* xp = xsrc + (size_t)(mt * 128 + (t >> 4) + 16 * i) * 1024 + nt * 128 + c8;
    xr0[i] = *(const float4*)xp; xr1[i] = *(const float4*)(xp + 4);
  }
  f32x16 acc[2][2];
  zero_acc(acc);
  gemm_core(p.Mg + (size_t)mt * 128 * 1024, 1024, p.WoutT + ((size_t)layer * 1024 + nt * 128) * 1024, 1024, 1024, acc, smem);
  acc_to_lds(acc, smem);
  __syncthreads();
#pragma unroll
  for (int i = 0; i < 8; ++i) {
    const int rl = (t >> 4) + 16 * i;
    const int row = mt * 128 + rl;
    const float* cp = ct + rl * CT_STRIDE + c8;
    const float4 v0 = *(const float4*)cp, v1 = *(const float4*)(cp + 4);
    const float4 x0 = xr0[i], x1 = xr1[i];
    float* op = p.Xpre + (size_t)row * 1024 + nt * 128 + c8;
    *(float4*)op = make_float4(ALPHA_RES * x0.x + v0.x, ALPHA_RES * x0.y + v0.y, ALPHA_RES * x0.z + v0.z, ALPHA_RES * x0.w + v0.w);
    *(float4*)(op + 4) = make_float4(ALPHA_RES * x1.x + v1.x, ALPHA_RES * x1.y + v1.y, ALPHA_RES * x1.z + v1.z, ALPHA_RES * x1.w + v1.w);
  }
}

DI void phaseLN(const Params& p, int layer) {
  const int t = tid(), l = t & 63, w = t >> 6;
  const float* g = p.ln_g + layer * 1024;
  const float* b = p.ln_b + layer * 1024;
  float* dstf = layer == 3 ? p.out : p.Xf;
  for (int row = blockIdx.x * 4 + w; row < MTOK; row += gridDim.x * 4) {
    const float* src = p.Xpre + (size_t)row * 1024;
    float4 v[4];
    float s1 = 0.f;
#pragma unroll
    for (int i = 0; i < 4; ++i) { v[i] = *(const float4*)(src + i * 256 + l * 4); s1 += v[i].x + v[i].y + v[i].z + v[i].w; }
#pragma unroll
    for (int o = 32; o >= 1; o >>= 1) s1 += __shfl_xor(s1, o);
    const float mean = s1 * (1.f / 1024.f);
    float s2 = 0.f;
#pragma unroll
    for (int i = 0; i < 4; ++i) {
      v[i].x -= mean; v[i].y -= mean; v[i].z -= mean; v[i].w -= mean;
      s2 += v[i].x * v[i].x + v[i].y * v[i].y + v[i].z * v[i].z + v[i].w * v[i].w;
    }
#pragma unroll
    for (int o = 32; o >= 1; o >>= 1) s2 += __shfl_xor(s2, o);
    const float rstd = rsqrtf(s2 * (1.f / 1024.f) + LN_EPS);
#pragma unroll
    for (int i = 0; i < 4; ++i) {
      const int c = i * 256 + l * 4;
      const float4 gv = *(const float4*)(g + c), bv = *(const float4*)(b + c);
      const float y0 = v[i].x * rstd * gv.x + bv.x, y1 = v[i].y * rstd * gv.y + bv.y;
      const float y2 = v[i].z * rstd * gv.z + bv.z, y3 = v[i].w * rstd * gv.w + bv.w;
      *(float4*)(dstf + (size_t)row * 1024 + c) = make_float4(y0, y1, y2, y3);
      if (layer < 3) *(uint2*)(p.Xb + (size_t)row * 1024 + c) = make_uint2(pk(y0, y1), pk(y2, y3));
    }
  }
}

__global__ void __launch_bounds__(256, 2) fwd_megakernel(Params p) {
  __shared__ __attribute__((aligned(16))) unsigned char smem[SMEM_BYTES];
  __shared__ uint4 xb_words;
  cg::grid_group grid = cg::this_grid();
  if (threadIdx.x == 0) xb_words = make_uint4(0u, 0u, 0u, 0u);
  __syncthreads();
  XcdBarrier xb = xcd_barrier_post(p.bar, (volatile LAS unsigned*)&xb_words);
  for (int ph = p.ph_lo; ph < p.ph_hi; ++ph) {
    if (ph == 0) {
      phase0(p, smem);
    } else {
      const int layer = (ph - 1) / 5, sub = (ph - 1) % 5;
      const int nrep = (sub == PROBE_REP || (PROBE_REP == 6 && sub >= 2)) ? 2 : 1;
      for (int rep = 0; rep < nrep; ++rep) {
        if (rep) xcd_barrier(xb);
        if (sub == 0) {
          for (int tix = blockIdx.x; tix < 136 * 22; tix += gridDim.x) phaseA_tile(p, layer, tix / 22, tix % 22, smem);
        } else if (sub == 1) {
          phaseB(p, layer + 4 * rep, smem);
        } else if (sub == 2) {
          for (int tix = blockIdx.x; tix < 136 * 8; tix += gridDim.x) phaseC1_tile(p, layer, tix >> 3, tix & 7, smem);
        } else if (sub == 3) {
          for (int tix = blockIdx.x; tix < 136 * 8; tix += gridDim.x) phaseC2_tile(p, layer, tix >> 3, tix & 7, smem);
        } else {
          phaseLN(p, layer);
        }
      }
    }
    if (PROBE_REP == 5 && ph + 1 < p.ph_hi) xcd_barrier(xb);
    if (ph + 1 < p.ph_hi) { if (p.ph_hi < 0) grid.sync(); else xcd_barrier(xb); }
  }
}

extern "C" void kernel_launch(void* const* d_in, const int* in_sizes, int n_in, void* d_out, int out_size, void* d_ws, size_t ws_size, hipStream_t stream) {
  static int grid_blocks = 0;
  if (!grid_blocks) {
    int dev = 0, cus = 0, per_cu = 0;
    hipGetDevice(&dev);
    hipDeviceGetAttribute(&cus, hipDeviceAttributeMultiprocessorCount, dev);
    hipOccupancyMaxActiveBlocksPerMultiprocessor(&per_cu, fwd_megakernel, 256, 0);
    if (per_cu < 1) per_cu = 1;
    if (per_cu > 2) per_cu = 2;
    grid_blocks = cus * per_cu;
  }
  Params p{};
  const float** ins = (const float**)&p;
  for (int i = 0; i < 19; ++i) ins[i] = (const float*)d_in[i];
  p.out = (float*)d_out;
  unsigned char* ws = (unsigned char*)d_ws;
  size_t off = 0;
  auto take = [&](size_t bytes) { unsigned char* q = ws + off; off += (bytes + 255) & ~(size_t)255; return q; };
  p.WinT = (u16*)take((size_t)4 * 5632 * 1024 * 2);
  p.WoaT = (u16*)take((size_t)4 * 1024 * 512 * 2);
  p.WogT = (u16*)take((size_t)4 * 1024 * 512 * 2);
  p.WoutT = (u16*)take((size_t)4 * 1024 * 1024 * 2);
  p.Xb = (u16*)take((size_t)MTOK * 1024 * 2);
  p.H = (u16*)take((size_t)MTOK * INW * 2);
  p.A1 = (u16*)take((size_t)MTOK * 512 * 2);
  p.A2 = (u16*)take((size_t)MTOK * 512 * 2);
  p.Mg = (u16*)take((size_t)MTOK * 1024 * 2);
  p.Xf = (float*)take((size_t)MTOK * 1024 * 4);
  p.Xpre = (float*)take((size_t)MTOK * 1024 * 4);
  p.rope = (float*)take((size_t)SEQ * 32 * 2 * 4);
  p.lam = (float*)take(256);
  p.counters = (int*)take(256);
  p.bar = (unsigned*)take(XCD_BAR_WORDS * 4);
  hipMemsetAsync(p.bar, 0, XCD_BAR_WORDS * 4, stream);
#if MULTI_LAUNCH
  for (int ph = 0; ph < 21; ++ph) {
    p.ph_lo = ph; p.ph_hi = ph + 1;
    hipLaunchKernelGGL(fwd_megakernel, dim3(grid_blocks), dim3(256), 0, stream, p);
  }
#else
  p.ph_lo = 0; p.ph_hi = 21;
  void* args[] = {&p};
  hipError_t e = hipLaunchCooperativeKernel((void*)fwd_megakernel, dim3(grid_blocks), dim3(256), args, 0, stream);
  if (e != hipSuccess) fprintf(stderr, "cooperative launch failed: %s (grid %d)\n", hipGetErrorString(e), grid_blocks);
#endif
}
```

```cpp
#include <hip/hip_runtime.h>
#include <hip/hip_cooperative_groups.h>
#include <cstdio>
namespace cg = cooperative_groups;

#ifndef PROBE_REP
#define PROBE_REP -1
#endif
#ifndef MULTI_LAUNCH
#define MULTI_LAUNCH 0
#endif

#define DI __device__ __forceinline__
typedef unsigned short u16;
typedef __attribute__((ext_vector_type(8))) short bf16x8;
typedef __attribute__((ext_vector_type(4))) short s16x4;
typedef __attribute__((ext_vector_type(16))) float f32x16;
typedef __attribute__((ext_vector_type(2))) float f32x2;
typedef __attribute__((ext_vector_type(2))) __bf16 bf16x2_t;

constexpr int SEQ = 16384, MTOK = 17408, INW = 5632;
constexpr int C_K = 512, C_V = 1024, C_GA = 1536, C_U = 2048, C_VG = 2560, C_GG = 3072, C_MA = 3584, C_MB = 4608;
constexpr size_t OFF_KP = 17825792, OFF_VP = 51380224, OFF_KS = 84934656, OFF_VS = 87031808, OFF_GV = 89128960;
constexpr int SMEM_BYTES = 77824 + 64;
constexpr float ALPHA_RES = 1.681792830507429f;
constexpr float LN_EPS = 1e-5f;

struct Params {
  const float *x_prompt, *x_sample, *cache_k, *cache_v, *w_in, *w_oa, *w_og, *w_out;
  const float *lq1, *lk1, *lq2, *lk2, *subln_w, *sgu_g, *sgu_b, *w_s, *b_s, *ln_g, *ln_b;
  float* out;
  u16 *WinT, *WoaT, *WogT, *WoutT, *Xb, *H, *A1, *A2, *Mg;
  float *Xf, *Xpre, *rope, *lam;
  int* counters;
  unsigned* bar;
  int ph_lo, ph_hi;
};

DI unsigned pk(float a, float b) { f32x2 x = {a, b}; bf16x2_t y = __builtin_convertvector(x, bf16x2_t); return __builtin_bit_cast(unsigned, y); }
DI u16 f2bf(float a) { return (u16)(pk(a, 0.f) & 0xffffu); }
DI float bf2f(u16 h) { return __uint_as_float(((unsigned)h) << 16); }
DI float bflo(unsigned u) { return __uint_as_float(u << 16); }
DI float bfhi(unsigned u) { return __uint_as_float(u & 0xffff0000u); }
DI int tid() { int t = threadIdx.x; asm volatile("" : "+v"(t)); return t; }
DI int crow(int i, int hb) { return (i & 3) + 8 * (i >> 2) + 4 * hb; }
DI float sigmoidf_(float x) { return 1.f / (1.f + __expf(-x)); }
DI float siluf_(float x) { return x / (1.f + __expf(-x)); }
#define MFMA(a, b, c) __builtin_amdgcn_mfma_f32_32x32x16_bf16((a), (b), (c), 0, 0, 0)
typedef __attribute__((address_space(3))) s16x4 lds_s16x4;
typedef __attribute__((address_space(3))) unsigned lds_u32;
DI void glds16(const void* g, unsigned lds_base) {
  unsigned sv;
  asm volatile("s_mov_b32 %0, m0\n\ts_mov_b32 m0, %2\n\ts_nop 0\n\tglobal_load_lds_dwordx4 %1, off\n\ts_mov_b32 m0, %0" : "=&s"(sv) : "v"(g), "s"(lds_base) : "memory");
}
DI unsigned lds_addr(const void* p) { return (unsigned)(size_t)(__attribute__((address_space(3))) const unsigned char*)p; }
DI s16x4 tr_read(const u16* p) { return __builtin_amdgcn_ds_read_tr16_b64_v4i16((lds_s16x4*)p); }
DI bf16x8 cat8(s16x4 lo, s16x4 hi) { return __builtin_shufflevector(lo, hi, 0, 1, 2, 3, 4, 5, 6, 7); }


#define XB_TMO      128
#define XB_XCNT(j)  (256  + 64 * (j))
#define XB_XSUB(j)  (1280 + 64 * (j))
#define XB_XGEN(j)  (2304 + 64 * (j))
#define XB_TOP      3328
#define XB_TOPGEN   3392
#define XCD_BAR_WORDS 3456
#define XB_SPIN_CAP (1u << 24)
#define LAS __attribute__((address_space(3)))
DI unsigned xb_ld(unsigned* p)              { return __hip_atomic_load(p, __ATOMIC_RELAXED, __HIP_MEMORY_SCOPE_AGENT); }
DI unsigned xb_add(unsigned* p, unsigned v) { return __hip_atomic_fetch_add(p, v, __ATOMIC_RELAXED, __HIP_MEMORY_SCOPE_AGENT); }
DI unsigned xb_xcc_id() { return (unsigned)__builtin_amdgcn_s_getreg((3 << 11) | 20) & 0xFu; }
#define XB_SPIN(cond, bar) do { unsigned _sp = 0; while (cond) { __builtin_amdgcn_s_sleep(1); \
    if ((++_sp & 255u) == 0u) { if (xb_ld(&(bar)[XB_TMO])) break; if (_sp > XB_SPIN_CAP) { atomicAdd(&(bar)[XB_TMO], 1u); break; } } } } while (0)
struct XcdBarrier { unsigned* bar; unsigned x; volatile LAS unsigned* st; };
DI XcdBarrier xcd_barrier_post(unsigned* bar, volatile LAS unsigned* st) {
  XcdBarrier b; b.bar = bar; b.x = xb_xcc_id(); b.st = st;
  if (threadIdx.x == 0) (void)xb_add(&bar[XB_XCNT(b.x)], 1u);
  return b;
}
DI void xcd_barrier_complete(unsigned* bar, unsigned x, unsigned& nloc, unsigned& nx) {
  const unsigned G = gridDim.x * gridDim.y * gridDim.z;
  unsigned sum, cnt, mine, sp = 0u;
  for (;;) {
    sum = 0u; cnt = 0u; mine = 0u;
#pragma unroll
    for (unsigned j = 0; j < 16; ++j) { const unsigned c = xb_ld(&bar[XB_XCNT(j)]); sum += c; cnt += (c > 0u) ? 1u : 0u; mine = (j == x) ? c : mine; }
    if (sum == G) break;
    __builtin_amdgcn_s_sleep(1);
    if ((++sp & 255u) == 0u) { if (xb_ld(&bar[XB_TMO])) break; if (sp > XB_SPIN_CAP) { atomicAdd(&bar[XB_TMO], 1u); break; } }
  }
  nloc = mine > 0u ? mine : 1u; nx = cnt > 0u ? cnt : 1u;
}
DI void xcd_barrier(const XcdBarrier& b) {
  asm volatile("s_waitcnt vmcnt(0)" ::: "memory");
  __syncthreads();
  if (threadIdx.x == 0) {
    unsigned* bar = b.bar;
    __builtin_amdgcn_s_waitcnt(0);
    unsigned nloc = b.st[0], nx = b.st[1];
    if (nloc == 0u) { xcd_barrier_complete(bar, b.x, nloc, nx); b.st[0] = nloc; b.st[1] = nx; }
    const unsigned old = xb_add(&bar[XB_XSUB(b.x)], 1u);
    const unsigned gen = old / nloc;
    if (old + 1u == (gen + 1u) * nloc) {
      __builtin_amdgcn_fence(__ATOMIC_RELEASE, "agent");
      asm volatile("s_waitcnt vmcnt(0)" ::: "memory");
      const unsigned og = xb_add(&bar[XB_TOP], 1u);
      const unsigned tg = og / nx;
      if (og + 1u == (tg + 1u) * nx) xb_add(&bar[XB_TOPGEN], 1u);
      else XB_SPIN(xb_ld(&bar[XB_TOPGEN]) == tg, bar);
      __builtin_amdgcn_fence(__ATOMIC_ACQUIRE, "agent");
      xb_add(&bar[XB_XGEN(b.x)], 1u);
      asm volatile("s_waitcnt vmcnt(0)" ::: "memory");
    } else {
      XB_SPIN(xb_ld(&bar[XB_XGEN(b.x)]) == gen, bar);
      __builtin_amdgcn_fence(__ATOMIC_ACQUIRE, "agent");
      asm volatile("s_waitcnt vmcnt(0)" ::: "memory");
    }
  }
  __syncthreads();
}

DI void gemm_core(const u16* __restrict__ A, int lda, const u16* __restrict__ Bt, int ldb, int K,
                  f32x16 (&acc)[2][2], unsigned char* smem) {
  const int t = tid(), l = t & 63, w = t >> 6, wm = w >> 1, wn = w & 1, hb = l >> 5, r = l & 31;
  const int grow = w * 8 + (l >> 3);
  const int gch = (l & 7) ^ ((grow >> 1) & 7);
  const u16* ag = A + (size_t)grow * lda + gch * 8;
  const u16* bg = Bt + (size_t)grow * ldb + gch * 8;
  const unsigned lbase = __builtin_amdgcn_readfirstlane(lds_addr(smem) + w * 1024);
#define GM_STAGE(BUF, KO)                                                                                        \
  {                                                                                                              \
    const unsigned sa_ = lbase + (BUF) * 32768;                                                                  \
    _Pragma("unroll") for (int i = 0; i < 4; ++i) {                                                              \
      glds16(ag + (size_t)(32 * i) * lda + (KO), sa_ + i * 4096);                                                \
      glds16(bg + (size_t)(32 * i) * ldb + (KO), sa_ + 16384 + i * 4096);                                        \
    }                                                                                                            \
  }
  __syncthreads();
  GM_STAGE(0, 0)
  asm volatile("s_waitcnt vmcnt(0)" ::: "memory");
  __syncthreads();
  const int sw = (r >> 1) & 7;
  const int o0 = ((0 + hb) ^ sw) * 8, o1 = ((2 + hb) ^ sw) * 8, o2 = ((4 + hb) ^ sw) * 8, o3 = ((6 + hb) ^ sw) * 8;
  const int nk = K >> 6;
  for (int kt = 0; kt < nk; ++kt) {
    const int buf = kt & 1;
    if (kt + 1 < nk) GM_STAGE(buf ^ 1, (kt + 1) * 64)
    __builtin_amdgcn_sched_barrier(0);
    const u16* as = (const u16*)(smem + buf * 32768) + (wm * 64 + r) * 64;
    const u16* bs = (const u16*)(smem + buf * 32768 + 16384) + (wn * 64 + r) * 64;
#define GM_LDF(A0, A1, B0, B1, OFF)                                                       \
    A0 = *(const bf16x8*)(as + (OFF)); A1 = *(const bf16x8*)(as + 32 * 64 + (OFF));       \
    B0 = *(const bf16x8*)(bs + (OFF)); B1 = *(const bf16x8*)(bs + 32 * 64 + (OFF));
#define GM_MM(A0, A1, B0, B1)                                                             \
    acc[0][0] = MFMA(A0, B0, acc[0][0]); acc[0][1] = MFMA(A0, B1, acc[0][1]);             \
    acc[1][0] = MFMA(A1, B0, acc[1][0]); acc[1][1] = MFMA(A1, B1, acc[1][1]);
    {
      bf16x8 xa0, xa1, xb0, xb1, ya0, ya1, yb0, yb1;
      GM_LDF(xa0, xa1, xb0, xb1, o0)
      GM_LDF(ya0, ya1, yb0, yb1, o1)
      __builtin_amdgcn_sched_barrier(0);
      GM_MM(xa0, xa1, xb0, xb1)
      __builtin_amdgcn_sched_barrier(0);
      GM_LDF(xa0, xa1, xb0, xb1, o2)
      __builtin_amdgcn_sched_barrier(0);
      GM_MM(ya0, ya1, yb0, yb1)
      __builtin_amdgcn_sched_barrier(0);
      GM_LDF(ya0, ya1, yb0, yb1, o3)
      __builtin_amdgcn_sched_barrier(0);
      GM_MM(xa0, xa1, xb0, xb1)
      __builtin_amdgcn_sched_barrier(0);
      GM_MM(ya0, ya1, yb0, yb1)
    }
    asm volatile("s_waitcnt vmcnt(0)" ::: "memory");
    __syncthreads();
  }
}


DI void gemm_core_wide(const u16* __restrict__ A, int lda, const u16* __restrict__ Bt, int ldb, int K,
                       f32x16 (&acc)[2][4], unsigned char* smem) {
  const int t = tid(), l = t & 63, w = t >> 6, wm = w >> 1, wn = w & 1, hb = l >> 5, r = l & 31;
  const int grow = w * 16 + (l >> 2);
  const int gch = (l & 3) ^ ((l >> 4) & 3);
  const u16* ag = A + (size_t)grow * lda + gch * 8;
  const u16* bg = Bt + (size_t)grow * ldb + gch * 8;
  const unsigned lbase = __builtin_amdgcn_readfirstlane(lds_addr(smem) + w * 1024);
#define GW_STAGE(SLOT, KO)                                                                  \
  {                                                                                         \
    const unsigned sa_ = lbase + (SLOT) * 24576;                                            \
    glds16(ag + (KO), sa_);                                                                 \
    glds16(ag + (size_t)64 * lda + (KO), sa_ + 4096);                                       \
    glds16(bg + (KO), sa_ + 8192);                                                          \
    glds16(bg + (size_t)64 * ldb + (KO), sa_ + 8192 + 4096);                                \
    glds16(bg + (size_t)128 * ldb + (KO), sa_ + 8192 + 8192);                               \
    glds16(bg + (size_t)192 * ldb + (KO), sa_ + 8192 + 12288);                              \
  }
  __syncthreads();
  GW_STAGE(0, 0)
  GW_STAGE(1, 32)
  const int sw = (r >> 2) & 3;
  const int o0 = ((0 + hb) ^ sw) * 8, o1 = ((2 + hb) ^ sw) * 8;
  const int nk = K >> 5;
  int slot = 0;
  for (int kt = 0; kt < nk; ++kt) {
    if (kt + 1 < nk) asm volatile("s_waitcnt vmcnt(6)" ::: "memory"); else asm volatile("s_waitcnt vmcnt(0)" ::: "memory");
    __syncthreads();
    if (kt + 2 < nk) { const int s2 = slot >= 1 ? slot - 1 : 2; GW_STAGE(s2, (kt + 2) * 32) }
    __builtin_amdgcn_sched_barrier(0);
    const u16* as = (const u16*)(smem + slot * 24576) + (wm * 64 + r) * 32;
    const u16* bs = (const u16*)(smem + slot * 24576 + 8192) + (wn * 128 + r) * 32;
    {
      bf16x8 a0 = *(const bf16x8*)(as + o0), a1 = *(const bf16x8*)(as + 32 * 32 + o0);
      bf16x8 b0 = *(const bf16x8*)(bs + o0), b1 = *(const bf16x8*)(bs + 32 * 32 + o0);
      bf16x8 b2 = *(const bf16x8*)(bs + 64 * 32 + o0), b3 = *(const bf16x8*)(bs + 96 * 32 + o0);
      bf16x8 c0 = *(const bf16x8*)(as + o1), c1 = *(const bf16x8*)(as + 32 * 32 + o1);
      bf16x8 d0 = *(const bf16x8*)(bs + o1), d1 = *(const bf16x8*)(bs + 32 * 32 + o1);
      bf16x8 d2 = *(const bf16x8*)(bs + 64 * 32 + o1), d3 = *(const bf16x8*)(bs + 96 * 32 + o1);
      acc[0][0] = MFMA(a0, b0, acc[0][0]); acc[0][1] = MFMA(a0, b1, acc[0][1]); acc[0][2] = MFMA(a0, b2, acc[0][2]); acc[0][3] = MFMA(a0, b3, acc[0][3]);
      acc[1][0] = MFMA(a1, b0, acc[1][0]); acc[1][1] = MFMA(a1, b1, acc[1][1]); acc[1][2] = MFMA(a1, b2, acc[1][2]); acc[1][3] = MFMA(a1, b3, acc[1][3]);
      acc[0][0] = MFMA(c0, d0, acc[0][0]); acc[0][1] = MFMA(c0, d1, acc[0][1]); acc[0][2] = MFMA(c0, d2, acc[0][2]); acc[0][3] = MFMA(c0, d3, acc[0][3]);
      acc[1][0] = MFMA(c1, d0, acc[1][0]); acc[1][1] = MFMA(c1, d1, acc[1][1]); acc[1][2] = MFMA(c1, d2, acc[1][2]); acc[1][3] = MFMA(c1, d3, acc[1][3]);
    }
    slot = slot == 2 ? 0 : slot + 1;
  }
}

constexpr int CT_STRIDE = 132;
DI void acc_to_lds(const f32x16 (&acc)[2][2], unsigned char* smem) {
  const int t = tid(), l = t & 63, w = t >> 6, wm = w >> 1, wn = w & 1, hb = l >> 5, r = l & 31;
  float* base = (float*)smem + (wm * 64 + 4 * hb) * CT_STRIDE + wn * 64 + r;
#pragma unroll
  for (int tm = 0; tm < 2; ++tm)
#pragma unroll
    for (int tn = 0; tn < 2; ++tn)
#pragma unroll
      for (int i = 0; i < 16; ++i) base[(tm * 32 + (i & 3) + 8 * (i >> 2)) * CT_STRIDE + tn * 32] = acc[tm][tn][i];
}
typedef __attribute__((ext_vector_type(4))) float f32x4_t;
DI void nt_store4(float* p, const float4& v) { f32x4_t x = {v.x, v.y, v.z, v.w}; __builtin_nontemporal_store(x, (f32x4_t*)p); }
DI uint4 pack8(const float4& a, const float4& b) { return make_uint4(pk(a.x, a.y), pk(a.z, a.w), pk(b.x, b.y), pk(b.z, b.w)); }

DI void zero_acc(f32x16 (&acc)[2][2]) {
#pragma unroll
  for (int a = 0; a < 2; ++a)
#pragma unroll
    for (int b = 0; b < 2; ++b)
#pragma unroll
      for (int i = 0; i < 16; ++i) acc[a][b][i] = 0.f;
}

DI void transpose_tile(const float* __restrict__ src, u16* __restrict__ dst, int K, int N, int kt, int nt, unsigned char* smem) {
  float* tile = (float*)smem;
  const int t = tid();
  __syncthreads();
#pragma unroll
  for (int i = 0; i < 4; ++i) {
    const int row = (t >> 4) + 16 * i, c4 = (t & 15) * 4;
    const float4 v = *(const float4*)(src + (size_t)(kt * 64 + row) * N + nt * 64 + c4);
    tile[row * 65 + c4 + 0] = v.x; tile[row * 65 + c4 + 1] = v.y; tile[row * 65 + c4 + 2] = v.z; tile[row * 65 + c4 + 3] = v.w;
  }
  __syncthreads();
  const int n = t >> 2, kseg = (t & 3) * 16;
  unsigned o[8];
#pragma unroll
  for (int e = 0; e < 8; ++e) o[e] = pk(tile[(kseg + 2 * e) * 65 + n], tile[(kseg + 2 * e + 1) * 65 + n]);
  u16* d = dst + (size_t)(nt * 64 + n) * K + kt * 64 + kseg;
  *(uint4*)d = make_uint4(o[0], o[1], o[2], o[3]);
  *(uint4*)(d + 8) = make_uint4(o[4], o[5], o[6], o[7]);
}

__device__ const float ROPE_INV[32] = {1.0f, 0.749894202f, 0.562341332f, 0.421696514f, 0.316227764f, 0.237137377f, 0.177827939f, 0.133352146f, 0.100000001f, 0.0749894232f, 0.0562341325f, 0.0421696492f, 0.0316227749f, 0.0237137377f, 0.0177827943f, 0.013335214f, 0.00999999978f, 0.00749894232f, 0.00562341325f, 0.00421696482f, 0.00316227763f, 0.00237137382f, 0.00177827943f, 0.00133352145f, 0.00100000005f, 0.000749894185f, 0.000562341302f, 0.000421696517f, 0.000316227757f, 0.00023713737f, 0.00017782794f, 0.00013335215f};

DI void phase0(const Params& p, unsigned char* smem) {
  const int t = tid();
  if (blockIdx.x == 0) {
    if (t < 4) {
      float s1 = 0.f, s2 = 0.f;
      for (int i = 0; i < 64; ++i) { s1 += p.lq1[t * 64 + i] * p.lk1[t * 64 + i]; s2 += p.lq2[t * 64 + i] * p.lk2[t * 64 + i]; }
      const float li = t == 0 ? 0.2f : (t == 1 ? 0.355509067590969f : (t == 2 ? 0.470713018343584f : 0.556058204155641f));
      p.lam[t] = expf(s1) - expf(s2) + li;
      p.lam[4 + t] = li;
      p.counters[t] = 0; p.counters[4 + t] = 0;
    }
  }
  {
    float* tile = (float*)smem;
    const int trow = t >> 4, tc4 = (t & 15) * 4;
    const int tn = t >> 2, tkseg = (t & 3) * 16;
    const float* tsrc; u16* tdst; int tK, tN, tkt, tnt;
#define TR_DECODE(J)                                                                                                                       \
    if ((J) < 5632) { const int l_ = (J) / 1408, r_ = (J) % 1408; tsrc = p.w_in + (size_t)l_ * 1024 * 5632; tdst = p.WinT + (size_t)l_ * 5632 * 1024; tK = 1024; tN = 5632; tkt = r_ / 88; tnt = r_ % 88; } \
    else if ((J) < 6144) { const int q_ = (J) - 5632, l_ = q_ >> 7, r_ = q_ & 127; tsrc = p.w_oa + (size_t)l_ * 512 * 1024; tdst = p.WoaT + (size_t)l_ * 1024 * 512; tK = 512; tN = 1024; tkt = r_ >> 4; tnt = r_ & 15; } \
    else if ((J) < 6656) { const int q_ = (J) - 6144, l_ = q_ >> 7, r_ = q_ & 127; tsrc = p.w_og + (size_t)l_ * 512 * 1024; tdst = p.WogT + (size_t)l_ * 1024 * 512; tK = 512; tN = 1024; tkt = r_ >> 4; tnt = r_ & 15; } \
    else { const int q_ = (J) - 6656, l_ = q_ >> 8, r_ = q_ & 255; tsrc = p.w_out + (size_t)l_ * 1024 * 1024; tdst = p.WoutT + (size_t)l_ * 1024 * 1024; tK = 1024; tN = 1024; tkt = r_ >> 4; tnt = r_ & 15; }
#define TR_LOAD()                                                                                                                          \
    { const float* s_ = tsrc + (size_t)(tkt * 64 + trow) * tN + tnt * 64 + tc4;                                                            \
      f0 = *(const float4*)s_; f1 = *(const float4*)(s_ + (size_t)16 * tN); f2 = *(const float4*)(s_ + (size_t)32 * tN); f3 = *(const float4*)(s_ + (size_t)48 * tN); }
    float4 f0, f1, f2, f3;
    int j = blockIdx.x;
    if (j < 7680) { TR_DECODE(j) TR_LOAD() }
    for (; j < 7680; j += gridDim.x) {
      u16* d = tdst + (size_t)(tnt * 64 + tn) * tK + tkt * 64 + tkseg;
      __syncthreads();
      float* w0 = tile + trow * 65 + tc4;
      w0[0] = f0.x; w0[1] = f0.y; w0[2] = f0.z; w0[3] = f0.w;
      w0[16 * 65 + 0] = f1.x; w0[16 * 65 + 1] = f1.y; w0[16 * 65 + 2] = f1.z; w0[16 * 65 + 3] = f1.w;
      w0[32 * 65 + 0] = f2.x; w0[32 * 65 + 1] = f2.y; w0[32 * 65 + 2] = f2.z; w0[32 * 65 + 3] = f2.w;
      w0[48 * 65 + 0] = f3.x; w0[48 * 65 + 1] = f3.y; w0[48 * 65 + 2] = f3.z; w0[48 * 65 + 3] = f3.w;
      __syncthreads();
      const int jn = j + gridDim.x;
      if (jn < 7680) { TR_DECODE(jn) TR_LOAD() }
      unsigned o0 = pk(tile[(tkseg + 0) * 65 + tn], tile[(tkseg + 1) * 65 + tn]), o1 = pk(tile[(tkseg + 2) * 65 + tn], tile[(tkseg + 3) * 65 + tn]);
      unsigned o2 = pk(tile[(tkseg + 4) * 65 + tn], tile[(tkseg + 5) * 65 + tn]), o3 = pk(tile[(tkseg + 6) * 65 + tn], tile[(tkseg + 7) * 65 + tn]);
      unsigned o4 = pk(tile[(tkseg + 8) * 65 + tn], tile[(tkseg + 9) * 65 + tn]), o5 = pk(tile[(tkseg + 10) * 65 + tn], tile[(tkseg + 11) * 65 + tn]);
      unsigned o6 = pk(tile[(tkseg + 12) * 65 + tn], tile[(tkseg + 13) * 65 + tn]), o7 = pk(tile[(tkseg + 14) * 65 + tn], tile[(tkseg + 15) * 65 + tn]);
      *(uint4*)d = make_uint4(o0, o1, o2, o3);
      *(uint4*)(d + 8) = make_uint4(o4, o5, o6, o7);
    }
  }
  const int gt = blockIdx.x * 256 + t, gs = gridDim.x * 256;
  for (int idx = gt; idx < MTOK * 128; idx += gs) {
    const int row = idx >> 7, c8 = (idx & 127) * 8;
    const float* src = row < SEQ ? p.x_prompt + (size_t)row * 1024 + c8 : p.x_sample + (size_t)(row - SEQ) * 1024 + c8;
    const float4 a = *(const float4*)src, b = *(const float4*)(src + 4);
    *(uint4*)(p.Xb + (size_t)row * 1024 + c8) = make_uint4(pk(a.x, a.y), pk(a.z, a.w), pk(b.x, b.y), pk(b.z, b.w));
  }
  for (int idx = gt; idx < SEQ * 32; idx += gs) {
    const int pos = idx >> 5, j = idx & 31;
    const float inv = ROPE_INV[j];
    const float ang = (float)pos * inv;
    double rev = (double)ang * 0.15915494309189535;
    rev -= rint(rev);
    const float rf = (float)rev;
    p.rope[2 * idx] = __builtin_amdgcn_cosf(rf);
    p.rope[2 * idx + 1] = __builtin_amdgcn_sinf(rf);
  }
}

constexpr int CW_STRIDE = 260;
DI void phaseA_tile(const Params& p, int layer, int mt, int nt, unsigned char* smem) {
  f32x16 acc[2][4];
#pragma unroll
  for (int a = 0; a < 2; ++a)
#pragma unroll
    for (int b = 0; b < 4; ++b)
#pragma unroll
      for (int i = 0; i < 16; ++i) acc[a][b][i] = 0.f;
  gemm_core_wide(p.Xb + (size_t)mt * 128 * 1024, 1024, p.WinT + ((size_t)layer * 5632 + nt * 256) * 1024, 1024, 1024, acc, smem);
  const int t = tid(), l = t & 63, w = t >> 6, wm = w >> 1, wn = w & 1, hb = l >> 5, r = l & 31;
  const int n0 = nt * 256, seg = n0 >> 9;
  const bool samp = mt >= 128;
  float* ct = (float*)smem;
#pragma unroll
  for (int h = 0; h < 2; ++h) {
    __syncthreads();
    if (wm == h) {
      float* base = ct + (4 * hb) * CW_STRIDE + wn * 128 + r;
#pragma unroll
      for (int tm = 0; tm < 2; ++tm)
#pragma unroll
        for (int tn = 0; tn < 4; ++tn)
#pragma unroll
          for (int i = 0; i < 16; ++i) base[(tm * 32 + (i & 3) + 8 * (i >> 2)) * CW_STRIDE + tn * 32] = acc[tm][tn][i];
    }
    __syncthreads();
    if (seg <= 1) {
      const int j = t & 15, head = j >> 2, c8 = (j & 3) * 8;
#pragma unroll
      for (int i = 0; i < 4; ++i) {
        const int rl = (t >> 4) + 16 * i;
        const int row = mt * 128 + h * 64 + rl;
        const int pos = samp ? 1024 + ((row - SEQ) & 31) : row;
        const float* cp = ct + rl * CW_STRIDE + head * 64 + c8;
        const float4 xa0 = *(const float4*)cp, xa1 = *(const float4*)(cp + 4);
        const float4 xb0 = *(const float4*)(cp + 32), xb1 = *(const float4*)(cp + 36);
        const float4* rp = (const float4*)(p.rope + ((size_t)pos * 32 + c8) * 2);
        const float4 r0 = rp[0], r1 = rp[1], r2 = rp[2], r3 = rp[3];
        float4 ya0, ya1, yb0, yb1;
        ya0.x = xa0.x * r0.x - xb0.x * r0.y; yb0.x = xb0.x * r0.x + xa0.x * r0.y;
        ya0.y = xa0.y * r0.z - xb0.y * r0.w; yb0.y = xb0.y * r0.z + xa0.y * r0.w;
        ya0.z = xa0.z * r1.x - xb0.z * r1.y; yb0.z = xb0.z * r1.x + xa0.z * r1.y;
        ya0.w = xa0.w * r1.z - xb0.w * r1.w; yb0.w = xb0.w * r1.z + xa0.w * r1.w;
        ya1.x = xa1.x * r2.x - xb1.x * r2.y; yb1.x = xb1.x * r2.x + xa1.x * r2.y;
        ya1.y = xa1.y * r2.z - xb1.y * r2.w; yb1.y = xb1.y * r2.z + xa1.y * r2.w;
        ya1.z = xa1.z * r3.x - xb1.z * r3.y; yb1.z = xb1.z * r3.x + xa1.z * r3.y;
        ya1.w = xa1.w * r3.z - xb1.w * r3.w; yb1.w = xb1.w * r3.z + xa1.w * r3.w;
        const int col = n0 + head * 64 + c8;
        u16* hp = p.H + (size_t)row * INW + col;
        if (seg == 0) {
          const float qs = 0.125f * 1.4426950408889634f;
          *(uint4*)hp = make_uint4(pk(ya0.x * qs, ya0.y * qs), pk(ya0.z * qs, ya0.w * qs), pk(ya1.x * qs, ya1.y * qs), pk(ya1.z * qs, ya1.w * qs));
          *(uint4*)(hp + 32) = make_uint4(pk(yb0.x * qs, yb0.y * qs), pk(yb0.z * qs, yb0.w * qs), pk(yb1.x * qs, yb1.y * qs), pk(yb1.z * qs, yb1.w * qs));
        } else {
          *(uint4*)hp = pack8(ya0, ya1);
          *(uint4*)(hp + 32) = pack8(yb0, yb1);
        }
        if (seg == 1) {
          float* o = samp ? p.out + OFF_KS + ((size_t)layer * 1024 + (row - SEQ)) * 512 + (col - C_K)
                          : p.out + OFF_KP + ((size_t)layer * SEQ + row) * 512 + (col - C_K);
          nt_store4(o, ya0); nt_store4(o + 4, ya1); nt_store4(o + 32, yb0); nt_store4(o + 36, yb1);
        }
      }
    } else {
      const int c8 = (t & 31) * 8;
#pragma unroll
      for (int i = 0; i < 8; ++i) {
        const int rl = (t >> 5) + 8 * i;
        const int row = mt * 128 + h * 64 + rl;
        const float* cp = ct + rl * CW_STRIDE + c8;
        const float4 v0 = *(const float4*)cp, v1 = *(const float4*)(cp + 4);
        const int col = n0 + c8;
        *(uint4*)(p.H + (size_t)row * INW + col) = pack8(v0, v1);
        if (seg == 2) {
          float* o = samp ? p.out + OFF_VS + ((size_t)layer * 1024 + (row - SEQ)) * 512 + (col - C_V)
                          : p.out + OFF_VP + ((size_t)layer * SEQ + row) * 512 + (col - C_V);
          nt_store4(o, v0); nt_store4(o + 4, v1);
        }
      }
    }
  }
}

constexpr int KS_STRIDE = 72;
constexpr int VS_STRIDE = 160;
constexpr int ST_K = 2 * 64 * KS_STRIDE;
constexpr int ST_BYTES = ST_K * 2 + 64 * VS_STRIDE * 2;

#define LOADV(D0, D1, D2, D3, G)                                                             \
  {                                                                                          \
    const u16* vk_ = vp + ((G) * 16) * VROW;                                                 \
    D0 = cat8(tr_read(vk_ + vo0), tr_read(vk_ + 8 * VROW + vo0));                            \
    D1 = cat8(tr_read(vk_ + vo1), tr_read(vk_ + 8 * VROW + vo1));                            \
    D2 = cat8(tr_read(vk_ + vo2), tr_read(vk_ + 8 * VROW + vo2));                            \
    D3 = cat8(tr_read(vk_ + vo3), tr_read(vk_ + 8 * VROW + vo3));                            \
  }
#define PACKP(S, U) __builtin_bit_cast(bf16x8, make_uint4(pk(S[8 * (U) + 0], S[8 * (U) + 1]), pk(S[8 * (U) + 2], S[8 * (U) + 3]), pk(S[8 * (U) + 4], S[8 * (U) + 5]), pk(S[8 * (U) + 6], S[8 * (U) + 7])))
#define PVMFMA(D0, D1, D2, D3, PB) { O[0] = MFMA(D0, PB, O[0]); O[1] = MFMA(D1, PB, O[1]); O[2] = MFMA(D2, PB, O[2]); O[3] = MFMA(D3, PB, O[3]); }
template <bool SWZ>
DI void attn_compute(const u16* Kb, const u16* Vb, const bf16x8 (&qf)[4], f32x16 (&O)[4], f32x16& Mneg, float& m_run, float& l_run, bool two, int s) {
  const int l = tid() & 63, hb = l >> 5, r = l & 31;
  f32x16 S0, S1;
  constexpr int KROW = SWZ ? 64 : KS_STRIDE, VROW = SWZ ? 128 : VS_STRIDE;
  const int q4 = (l & 15) >> 2, p4 = l & 3, blk = (l >> 4) & 1;
  const int ksw = SWZ ? ((r >> 1) & 7) : 0;
  const u16* kp = Kb + (s * 64 + r) * KROW;
  const int ko0 = ((0 + hb) ^ ksw) * 8, ko1 = ((2 + hb) ^ ksw) * 8, ko2 = ((4 + hb) ^ ksw) * 8, ko3 = ((6 + hb) ^ ksw) * 8;
  const u16* vp = Vb + (4 * hb + q4) * VROW + blk * 16 + p4 * 4;
  const int vsw = SWZ ? q4 : 0;
  const int vo0 = (0 ^ vsw) * 32, vo1 = (1 ^ vsw) * 32, vo2 = (2 ^ vsw) * 32, vo3 = (3 ^ vsw) * 32;
  bf16x8 ka0, ka1, ka2, ka3, kb0, kb1, kb2, kb3, va0, va1, va2, va3, vb0, vb1, vb2, vb3;
  ka0 = *(const bf16x8*)(kp + ko0); ka1 = *(const bf16x8*)(kp + ko1); ka2 = *(const bf16x8*)(kp + ko2); ka3 = *(const bf16x8*)(kp + ko3);
  if (two) {
    kb0 = *(const bf16x8*)(kp + 32 * KROW + ko0); kb1 = *(const bf16x8*)(kp + 32 * KROW + ko1);
    kb2 = *(const bf16x8*)(kp + 32 * KROW + ko2); kb3 = *(const bf16x8*)(kp + 32 * KROW + ko3);
  }
  LOADV(va0, va1, va2, va3, 0)
  __builtin_amdgcn_sched_barrier(0);
  S0 = MFMA(ka0, qf[0], Mneg); S0 = MFMA(ka1, qf[1], S0); S0 = MFMA(ka2, qf[2], S0); S0 = MFMA(ka3, qf[3], S0);
  if (two) { S1 = MFMA(kb0, qf[0], Mneg); S1 = MFMA(kb1, qf[1], S1); S1 = MFMA(kb2, qf[2], S1); S1 = MFMA(kb3, qf[3], S1); }
  float ls = 0.f;
#pragma unroll
  for (int i = 0; i < 16; ++i) { S0[i] = __builtin_amdgcn_exp2f(S0[i]); ls += S0[i]; }
  if (two) {
#pragma unroll
    for (int i = 0; i < 16; ++i) { S1[i] = __builtin_amdgcn_exp2f(S1[i]); ls += S1[i]; }
  }
  if (__any(!(ls <= 4194304.f))) {
    bf16x8 ra0 = *(const bf16x8*)(kp + ko0), ra1 = *(const bf16x8*)(kp + ko1), ra2 = *(const bf16x8*)(kp + ko2), ra3 = *(const bf16x8*)(kp + ko3);
#pragma unroll
    for (int i = 0; i < 16; ++i) { S0[i] = 0.f; S1[i] = 0.f; }
    S0 = MFMA(ra0, qf[0], S0); S0 = MFMA(ra1, qf[1], S0); S0 = MFMA(ra2, qf[2], S0); S0 = MFMA(ra3, qf[3], S0);
    if (two) {
      ra0 = *(const bf16x8*)(kp + 32 * KROW + ko0); ra1 = *(const bf16x8*)(kp + 32 * KROW + ko1);
      ra2 = *(const bf16x8*)(kp + 32 * KROW + ko2); ra3 = *(const bf16x8*)(kp + 32 * KROW + ko3);
      S1 = MFMA(ra0, qf[0], S1); S1 = MFMA(ra1, qf[1], S1); S1 = MFMA(ra2, qf[2], S1); S1 = MFMA(ra3, qf[3], S1);
    }
    float mx = S0[0];
#pragma unroll
    for (int i = 1; i < 16; ++i) mx = fmaxf(mx, S0[i]);
    if (two) {
#pragma unroll
      for (int i = 0; i < 16; ++i) mx = fmaxf(mx, S1[i]);
    }
    mx = fmaxf(mx, __shfl_xor(mx, 32));
    const float m_new = fmaxf(m_run, mx);
    const float alpha = __builtin_amdgcn_exp2f(m_run - m_new);
    m_run = m_new;
#pragma unroll
    for (int i = 0; i < 16; ++i) Mneg[i] = -m_new;
    l_run *= alpha;
#pragma unroll
    for (int dt = 0; dt < 4; ++dt)
#pragma unroll
      for (int i = 0; i < 16; ++i) O[dt][i] *= alpha;
    ls = 0.f;
#pragma unroll
    for (int i = 0; i < 16; ++i) { S0[i] = __builtin_amdgcn_exp2f(S0[i] - m_new); ls += S0[i]; }
    if (two) {
#pragma unroll
      for (int i = 0; i < 16; ++i) { S1[i] = __builtin_amdgcn_exp2f(S1[i] - m_new); ls += S1[i]; }
    }
  }
  l_run += ls;
  {
    const bf16x8 pb0 = PACKP(S0, 0);
    __builtin_amdgcn_sched_barrier(0);
    LOADV(vb0, vb1, vb2, vb3, 1)
    __builtin_amdgcn_sched_barrier(0);
    PVMFMA(va0, va1, va2, va3, pb0)
    const bf16x8 pb1 = PACKP(S0, 1);
    __builtin_amdgcn_sched_barrier(0);
    if (two) LOADV(va0, va1, va2, va3, 2)
    __builtin_amdgcn_sched_barrier(0);
    PVMFMA(vb0, vb1, vb2, vb3, pb1)
    if (two) {
      const bf16x8 pb2 = PACKP(S1, 0);
      __builtin_amdgcn_sched_barrier(0);
      LOADV(vb0, vb1, vb2, vb3, 3)
      __builtin_amdgcn_sched_barrier(0);
      PVMFMA(va0, va1, va2, va3, pb2)
      const bf16x8 pb3 = PACKP(S1, 1);
      __builtin_amdgcn_sched_barrier(0);
      PVMFMA(vb0, vb1, vb2, vb3, pb3)
    }
  }
}

template <bool SAMPLE>
DI void attn_item(const Params& p, int layer, int a, int h, unsigned char* smem) {
  const int t = tid(), l = t & 63, w = t >> 6, rg = w & 1, s = w >> 1, hb = l >> 5, r = l & 31;
  const int hh = 2 * h + s;
  const int qrow0 = SAMPLE ? SEQ + a * 32 : a * 64 + rg * 32;
  const bool active = SAMPLE ? (rg == 0) : true;
  const u16* H = p.H;
  bf16x8 qf[4];
  {
    const u16* qp = H + (size_t)(qrow0 + r) * INW + hh * 64 + hb * 8;
#pragma unroll
    for (int ks = 0; ks < 4; ++ks) qf[ks] = *(const bf16x8*)(qp + ks * 16);
  }
  f32x16 O[4];
#pragma unroll
  for (int dt = 0; dt < 4; ++dt)
#pragma unroll
    for (int i = 0; i < 16; ++i) O[dt][i] = 0.f;
  float m_run = -1e30f, l_run = 0.f;
  f32x16 Mneg;
#pragma unroll
  for (int i = 0; i < 16; ++i) Mneg[i] = 1e30f;
  u16* sm = (u16*)smem;

  __syncthreads();
  if (!SAMPLE) {
    const int ntiles = a + 1;
    const u16* kg = H + C_K + (2 * h) * 64;
    const u16* vg = H + C_V + h * 128;
    const int krow = w * 8 + (l >> 3);
    const u16* kq = kg + (size_t)krow * INW + ((l & 7) ^ ((krow >> 1) & 7)) * 8;
    const int vrow = w * 4 + (l >> 4);
    const u16* vq = vg + (size_t)vrow * INW + ((l & 15) ^ (((l >> 4) & 3) << 2)) * 8;
    const unsigned lb = __builtin_amdgcn_readfirstlane(lds_addr(smem) + w * 1024);
#define ATT_STAGE(BUF, KT)                                                                                \
    {                                                                                                     \
      const unsigned sb_ = lb + (BUF) * 32768;                                                            \
      const u16* k_ = kq + (size_t)(KT) * 64 * INW;                                                       \
      const u16* v_ = vq + (size_t)(KT) * 64 * INW;                                                       \
      glds16(k_, sb_); glds16(k_ + (size_t)32 * INW, sb_ + 4096);                                         \
      glds16(k_ + 64, sb_ + 8192); glds16(k_ + (size_t)32 * INW + 64, sb_ + 12288);                       \
      glds16(v_, sb_ + 16384); glds16(v_ + (size_t)16 * INW, sb_ + 16384 + 4096);                         \
      glds16(v_ + (size_t)32 * INW, sb_ + 16384 + 8192); glds16(v_ + (size_t)48 * INW, sb_ + 16384 + 12288); \
    }
    ATT_STAGE(0, 0)
    asm volatile("s_waitcnt vmcnt(0)" ::: "memory");
    __syncthreads();
    for (int kt = 0; kt < ntiles; ++kt) {
      const int buf = kt & 1;
      if (kt + 1 < ntiles) ATT_STAGE(buf ^ 1, kt + 1)
      __builtin_amdgcn_sched_barrier(0);
      const u16* kb = sm + buf * 16384;
      attn_compute<true>(kb, kb + 8192, qf, O, Mneg, m_run, l_run, true, s);
      asm volatile("s_waitcnt vmcnt(0)" ::: "memory");
      __syncthreads();
    }
  } else {
    const float* ck = p.cache_k + ((size_t)(layer * 32 + a) * 1024) * 512 + (2 * h) * 64;
    const float* cv = p.cache_v + ((size_t)(layer * 32 + a) * 1024) * 512 + h * 128;
    for (int j = 0; j < 9; ++j) {
      for (int g = 0; g < 2; ++g) {
        const int kt = 2 * j + g;
        u16* kb = sm + g * (ST_BYTES / 2);
        u16* vb = kb + ST_K;
        if (kt < 16) {
#pragma unroll
          for (int i = 0; i < 8; ++i) {
            const int cc = t + 256 * i;
            const int sh = cc >> 10, key = (cc >> 4) & 63, ch = cc & 15;
            const float4 v = *(const float4*)(ck + (size_t)(kt * 64 + key) * 512 + sh * 64 + ch * 4);
            *(uint2*)(kb + (sh * 64 + key) * KS_STRIDE + ch * 4) = make_uint2(pk(v.x, v.y), pk(v.z, v.w));
            const int vkey = cc >> 5, vch = cc & 31;
            const float4 u = *(const float4*)(cv + (size_t)(kt * 64 + vkey) * 512 + vch * 4);
            *(uint2*)(vb + vkey * VS_STRIDE + vch * 4) = make_uint2(pk(u.x, u.y), pk(u.z, u.w));
          }
        } else if (kt == 16) {
          const u16* kg = H + (size_t)(SEQ + a * 32) * INW + C_K + (2 * h) * 64;
          const u16* vg = H + (size_t)(SEQ + a * 32) * INW + C_V + h * 128;
#pragma unroll
          for (int i = 0; i < 2; ++i) {
            const int cc = t + 256 * i;
            const int sh = cc >> 8, key = (cc >> 3) & 31, ch = cc & 7;
            *(uint4*)(kb + (sh * 64 + key) * KS_STRIDE + ch * 8) = *(const uint4*)(kg + (size_t)key * INW + sh * 64 + ch * 8);
            const int vkey = cc >> 4, vch = cc & 15;
            *(uint4*)(vb + vkey * VS_STRIDE + vch * 8) = *(const uint4*)(vg + (size_t)vkey * INW + vch * 8);
          }
        }
      }
      __syncthreads();
      {
        const int kt = 2 * j + rg;
        const u16* kb = sm + rg * (ST_BYTES / 2);
        if (kt <= 16) attn_compute<false>(kb, kb + ST_K, qf, O, Mneg, m_run, l_run, kt < 16, s);
      }
      __syncthreads();
    }
    float* mgO = (float*)smem;
    float* mgML = (float*)(smem + 32768);
    if (rg == 1) {
#pragma unroll
      for (int dt = 0; dt < 4; ++dt)
#pragma unroll
        for (int i = 0; i < 16; ++i) mgO[(s * 128 + dt * 32 + crow(i, hb)) * 32 + r] = O[dt][i];
      mgML[(s * 64 + l) * 2] = m_run; mgML[(s * 64 + l) * 2 + 1] = l_run;
    }
    __syncthreads();
    if (rg == 0) {
      const float m1 = mgML[(s * 64 + l) * 2], l1 = mgML[(s * 64 + l) * 2 + 1];
      const float mm = fmaxf(m_run, m1);
      const float a0 = __builtin_amdgcn_exp2f(m_run - mm), a1 = __builtin_amdgcn_exp2f(m1 - mm);
#pragma unroll
      for (int dt = 0; dt < 4; ++dt)
#pragma unroll
        for (int i = 0; i < 16; ++i) O[dt][i] = O[dt][i] * a0 + mgO[(s * 128 + dt * 32 + crow(i, hb)) * 32 + r] * a1;
      l_run = l_run * a0 + l1 * a1;
      m_run = mm;
    }
    __syncthreads();
  }
  const int te = tid(), le = te & 63, re = le & 31, hbe = le >> 5, rge = (te >> 6) & 1, se = te >> 7;
  const bool acte = SAMPLE ? (rge == 0) : true;
  float lt = l_run + __shfl_xor(l_run, 32);
  const float inv_l = 1.f / lt;
  float* ex = (float*)smem;
  if (se == 1 && acte) {
#pragma unroll
    for (int dt = 0; dt < 4; ++dt)
#pragma unroll
      for (int i = 0; i < 16; ++i) ex[(rge * 128 + dt * 32 + crow(i, hbe)) * 32 + re] = O[dt][i] * inv_l;
  }
  __syncthreads();
  if (se == 0 && acte) {
    const float lam = __hip_atomic_load(p.lam + layer, __ATOMIC_RELAXED, __HIP_MEMORY_SCOPE_AGENT);
    const float li = __hip_atomic_load(p.lam + 4 + layer, __ATOMIC_RELAXED, __HIP_MEMORY_SCOPE_AGENT);
    float ss = 0.f;
#pragma unroll
    for (int dt = 0; dt < 4; ++dt)
#pragma unroll
      for (int i = 0; i < 16; ++i) {
        const float o = O[dt][i] * inv_l - lam * ex[(rge * 128 + dt * 32 + crow(i, hbe)) * 32 + re];
        O[dt][i] = o; ss += o * o;
      }
    ss += __shfl_xor(ss, 32);
    const float rs = rsqrtf(ss * (1.f / 128.f) + LN_EPS) * (1.f - li);
    const int row = (SAMPLE ? SEQ + a * 32 : a * 64 + rge * 32) + re;
    const u16* gp = H + (size_t)row * INW + C_GA + h * 128;
    u16* op = p.A1 + (size_t)row * 512 + h * 128;
    const float* sw = p.subln_w + layer * 128;
#pragma unroll
    for (int dt = 0; dt < 4; ++dt)
#pragma unroll
      for (int g4 = 0; g4 < 4; ++g4) {
        const int d = dt * 32 + 8 * g4 + 4 * hbe;
        const uint2 gv = *(const uint2*)(gp + d);
        const float4 wv = *(const float4*)(sw + d);
        const float y0 = O[dt][4 * g4 + 0] * rs * wv.x * siluf_(bflo(gv.x));
        const float y1 = O[dt][4 * g4 + 1] * rs * wv.y * siluf_(bfhi(gv.x));
        const float y2 = O[dt][4 * g4 + 2] * rs * wv.z * siluf_(bflo(gv.y));
        const float y3 = O[dt][4 * g4 + 3] * rs * wv.w * siluf_(bfhi(gv.y));
        *(uint2*)(op + d) = make_uint2(pk(y0, y1), pk(y2, y3));
      }
  }
}

DI void sgu_item(const Params& p, int layer, int chunk, int g, unsigned char* smem) {
  const int t = tid(), l = t & 63, w = t >> 6, wm = w >> 1, wn = w & 1, hb = l >> 5, r = l & 31;
  const int m0 = chunk * 128;
  const bool samp = chunk >= 128;
  u16* Asg = (u16*)smem;
  u16* Bsg = Asg + 128 * 72;
  float* st = (float*)(smem + 38912);
  const u16* H = p.H;
  const float* Wg = p.w_s + ((size_t)(layer * 4 + g) * 128) * 128;
  float4 wv[2][8];
  uint4 bv[2][4], puu[8], pgg[8];
#pragma unroll
  for (int kh = 0; kh < 2; ++kh) {
#pragma unroll
    for (int i8 = 0; i8 < 8; ++i8) {
      const int cc = t + 256 * i8;
      const int i = cc >> 4, j = kh * 64 + (cc & 15) * 4;
      wv[kh][i8] = samp ? *(const float4*)(Wg + (i & 31) * 128 + (j & 31)) : *(const float4*)(Wg + i * 128 + j);
    }
#pragma unroll
    for (int i4 = 0; i4 < 4; ++i4) {
      const int cc = t + 256 * i4;
      bv[kh][i4] = *(const uint4*)(H + (size_t)(m0 + kh * 64 + (cc >> 4)) * INW + C_VG + g * 128 + (cc & 15) * 8);
    }
  }
#pragma unroll
  for (int i = 0; i < 8; ++i) {
    const u16* hp = H + (size_t)(m0 + (t >> 4) + 16 * i) * INW + g * 128 + (t & 15) * 8;
    puu[i] = *(const uint4*)(hp + C_U); pgg[i] = *(const uint4*)(hp + C_GG);
  }
  __syncthreads();
#pragma unroll 8
  for (int rr = 0; rr < 32; ++rr) {
    const int row = w * 32 + rr;
    const uint4 v = *(const uint4*)(H + (size_t)(m0 + row) * INW + C_VG + l * 8);
    float x[8] = {bflo(v.x), bfhi(v.x), bflo(v.y), bfhi(v.y), bflo(v.z), bfhi(v.z), bflo(v.w), bfhi(v.w)};
    float s1 = 0.f, s2 = 0.f;
#pragma unroll
    for (int e = 0; e < 8; ++e) { s1 += x[e]; s2 += x[e] * x[e]; }
#pragma unroll
    for (int o = 32; o >= 1; o >>= 1) { s1 += __shfl_xor(s1, o); s2 += __shfl_xor(s2, o); }
    if (l == 0) {
      const float mean = s1 * (1.f / 512.f);
      const float var = fmaxf(s2 * (1.f / 512.f) - mean * mean, 0.f);
      st[row] = mean; st[128 + row] = rsqrtf(var + LN_EPS);
    }
  }
  __syncthreads();
  f32x16 acc[2][2];
  zero_acc(acc);
  const float* gam = p.sgu_g + layer * 512 + g * 128;
  const float* bet = p.sgu_b + layer * 512 + g * 128;
  const int q4 = (l & 15) >> 2, p4 = l & 3, blk = (l >> 4) & 1;
#pragma unroll
  for (int kh = 0; kh < 2; ++kh) {
#pragma unroll
    for (int i8 = 0; i8 < 8; ++i8) {
      const int cc = t + 256 * i8;
      const int i = cc >> 4, j4 = (cc & 15) * 4, j = kh * 64 + j4;
      const float4 v = wv[kh][i8];
      float e0, e1, e2, e3;
      if (!samp) {
        e0 = (j + 0 <= i) ? v.x : 0.f; e1 = (j + 1 <= i) ? v.y : 0.f; e2 = (j + 2 <= i) ? v.z : 0.f; e3 = (j + 3 <= i) ? v.w : 0.f;
      } else {
        const int i32 = i & 31, j32 = j & 31;
        const bool same = (i >> 5) == (j >> 5);
        e0 = (same && j32 + 0 <= i32) ? v.x : 0.f; e1 = (same && j32 + 1 <= i32) ? v.y : 0.f;
        e2 = (same && j32 + 2 <= i32) ? v.z : 0.f; e3 = (same && j32 + 3 <= i32) ? v.w : 0.f;
      }
      *(uint2*)(Asg + i * 72 + j4) = make_uint2(pk(e0, e1), pk(e2, e3));
    }
#pragma unroll
    for (int i4 = 0; i4 < 4; ++i4) {
      const int cc = t + 256 * i4;
      const int jj = cc >> 4, dc = (cc & 15) * 8;
      const int jrow = kh * 64 + jj;
      const uint4 v = bv[kh][i4];
      const float mean = st[jrow], rstd = st[128 + jrow];
      const float4 g0 = *(const float4*)(gam + dc), g1 = *(const float4*)(gam + dc + 4);
      const float4 b0 = *(const float4*)(bet + dc), b1 = *(const float4*)(bet + dc + 4);
      const float y0 = (bflo(v.x) - mean) * rstd * g0.x + b0.x, y1 = (bfhi(v.x) - mean) * rstd * g0.y + b0.y;
      const float y2 = (bflo(v.y) - mean) * rstd * g0.z + b0.z, y3 = (bfhi(v.y) - mean) * rstd * g0.w + b0.w;
      const float y4 = (bflo(v.z) - mean) * rstd * g1.x + b1.x, y5 = (bfhi(v.z) - mean) * rstd * g1.y + b1.y;
      const float y6 = (bflo(v.w) - mean) * rstd * g1.z + b1.z, y7 = (bfhi(v.w) - mean) * rstd * g1.w + b1.w;
      *(uint4*)(Bsg + jj * VS_STRIDE + dc) = make_uint4(pk(y0, y1), pk(y2, y3), pk(y4, y5), pk(y6, y7));
      if (samp) {
        float* o = p.out + OFF_GV + ((size_t)layer * 1024 + (m0 - SEQ) + jrow) * 512 + g * 128 + dc;
        *(float4*)o = make_float4(y0, y1, y2, y3);
        *(float4*)(o + 4) = make_float4(y4, y5, y6, y7);
      }
    }
    __syncthreads();
    const u16* as = Asg + (wm * 64 + r) * 72 + hb * 8;
    const u16* bs = Bsg + (8 * hb + q4) * VS_STRIDE + wn * 64 + blk * 16 + p4 * 4;
#pragma unroll
    for (int ks = 0; ks < 4; ++ks) {
      bf16x8 a0 = *(const bf16x8*)(as + ks * 16), a1 = *(const bf16x8*)(as + 32 * 72 + ks * 16);
      const u16* bk = bs + ks * 16 * VS_STRIDE;
      bf16x8 b0 = cat8(tr_read(bk), tr_read(bk + 4 * VS_STRIDE));
      bf16x8 b1 = cat8(tr_read(bk + 32), tr_read(bk + 4 * VS_STRIDE + 32));
      acc[0][0] = MFMA(a0, b0, acc[0][0]); acc[0][1] = MFMA(a0, b1, acc[0][1]);
      acc[1][0] = MFMA(a1, b0, acc[1][0]); acc[1][1] = MFMA(a1, b1, acc[1][1]);
    }
    __syncthreads();
  }
  const float* bsp = p.b_s + (size_t)(layer * 4 + g) * 128;
  acc_to_lds(acc, smem);
  __syncthreads();
  {
    const float* ct = (const float*)smem;
    const int c8 = (t & 15) * 8;
#pragma unroll
    for (int i = 0; i < 8; ++i) {
      const int rl = (t >> 4) + 16 * i;
      const int row = m0 + rl;
      const float* cp = ct + rl * CT_STRIDE + c8;
      const float4 v0 = *(const float4*)cp, v1 = *(const float4*)(cp + 4);
      const float bias = bsp[samp ? (rl & 31) : rl];
      const uint4 uu = puu[i], gg = pgg[i];
      float4 o0, o1;
      o0.x = (v0.x + bias) * bflo(uu.x) * siluf_(bflo(gg.x)); o0.y = (v0.y + bias) * bfhi(uu.x) * siluf_(bfhi(gg.x));
      o0.z = (v0.z + bias) * bflo(uu.y) * siluf_(bflo(gg.y)); o0.w = (v0.w + bias) * bfhi(uu.y) * siluf_(bfhi(gg.y));
      o1.x = (v1.x + bias) * bflo(uu.z) * siluf_(bflo(gg.z)); o1.y = (v1.y + bias) * bfhi(uu.z) * siluf_(bfhi(gg.z));
      o1.z = (v1.z + bias) * bflo(uu.w) * siluf_(bflo(gg.w)); o1.w = (v1.w + bias) * bfhi(uu.w) * siluf_(bfhi(gg.w));
      *(uint4*)(p.A2 + (size_t)row * 512 + g * 128 + c8) = pack8(o0, o1);
    }
  }
}

DI void phaseB(const Params& p, int layer_slot, unsigned char* smem) {
  const int layer = layer_slot & 3;
  int* s_item = (int*)(smem + 77824);
  const bool stat = gridDim.x == 512;
  const int sq = 2 * (blockIdx.x >> 3) + ((blockIdx.x >> 2) & 1), sh = blockIdx.x & 3;
  const int total = stat ? 672 : 1696;
  for (int n = 0;; ++n) {
    int kind, a, h;
    if (stat && n < 2) { kind = 1; a = n ? sq : 255 - sq; h = sh; }
    else {
      __syncthreads();
      if (threadIdx.x == 0) *s_item = atomicAdd(p.counters + layer_slot, 1);
      __syncthreads();
      const int it = *s_item;
      if (it >= total) break;
      if (it < 128) { kind = 0; a = it >> 2; h = it & 3; }
      else if (it < 672) { kind = 2; a = (it - 128) >> 2; h = (it - 128) & 3; }
      else { kind = 1; a = 255 - ((it - 672) >> 2); h = (it - 672) & 3; }
    }
    if (kind == 0) attn_item<true>(p, layer, a, h, smem);
    else if (kind == 1) attn_item<false>(p, layer, a, h, smem);
    else sgu_item(p, layer, a, h, smem);
  }
}

DI void phaseC1_tile(const Params& p, int layer, int mt, int nt, unsigned char* smem) {
  const int t = tid();
  const int c8 = (t & 15) * 8;
  const float* ct = (const float*)smem;
  f32x16 acc[2][2];
  uint4 ya[8], gma[8], gmb[8];
#pragma unroll
  for (int i = 0; i < 8; ++i) {
    const u16* hp = p.H + (size_t)(mt * 128 + (t >> 4) + 16 * i) * INW + nt * 128 + c8;
    gma[i] = *(const uint4*)(hp + C_MA); gmb[i] = *(const uint4*)(hp + C_MB);
  }
  zero_acc(acc);
  gemm_core(p.A1 + (size_t)mt * 128 * 512, 512, p.WoaT + ((size_t)layer * 1024 + nt * 128) * 512, 512, 512, acc, smem);
  acc_to_lds(acc, smem);
  __syncthreads();
#pragma unroll
  for (int i = 0; i < 8; ++i) {
    const int rl = (t >> 4) + 16 * i;
    const int row = mt * 128 + rl;
    const float* cp = ct + rl * CT_STRIDE + c8;
    const float4 v0 = *(const float4*)cp, v1 = *(const float4*)(cp + 4);
    const uint4 g = gma[i];
    ya[i] = make_uint4(pk(v0.x * sigmoidf_(bflo(g.x)), v0.y * sigmoidf_(bfhi(g.x))), pk(v0.z * sigmoidf_(bflo(g.y)), v0.w * sigmoidf_(bfhi(g.y))),
                       pk(v1.x * sigmoidf_(bflo(g.z)), v1.y * sigmoidf_(bfhi(g.z))), pk(v1.z * sigmoidf_(bflo(g.w)), v1.w * sigmoidf_(bfhi(g.w))));
  }
  zero_acc(acc);
  gemm_core(p.A2 + (size_t)mt * 128 * 512, 512, p.WogT + ((size_t)layer * 1024 + nt * 128) * 512, 512, 512, acc, smem);
  acc_to_lds(acc, smem);
  __syncthreads();
#pragma unroll
  for (int i = 0; i < 8; ++i) {
    const int rl = (t >> 4) + 16 * i;
    const int row = mt * 128 + rl;
    const float* cp = ct + rl * CT_STRIDE + c8;
    const float4 v0 = *(const float4*)cp, v1 = *(const float4*)(cp + 4);
    const uint4 g = gmb[i];
    float4 o0, o1;
    const float4 ma0 = make_float4(bflo(ya[i].x), bfhi(ya[i].x), bflo(ya[i].y), bfhi(ya[i].y));
    const float4 ma1 = make_float4(bflo(ya[i].z), bfhi(ya[i].z), bflo(ya[i].w), bfhi(ya[i].w));
    o0.x = ma0.x + v0.x * sigmoidf_(bflo(g.x)); o0.y = ma0.y + v0.y * sigmoidf_(bfhi(g.x));
    o0.z = ma0.z + v0.z * sigmoidf_(bflo(g.y)); o0.w = ma0.w + v0.w * sigmoidf_(bfhi(g.y));
    o1.x = ma1.x + v1.x * sigmoidf_(bflo(g.z)); o1.y = ma1.y + v1.y * sigmoidf_(bfhi(g.z));
    o1.z = ma1.z + v1.z * sigmoidf_(bflo(g.w)); o1.w = ma1.w + v1.w * sigmoidf_(bfhi(g.w));
    *(uint4*)(p.Mg + (size_t)row * 1024 + nt * 128 + c8) = pack8(o0, o1);
  }
}

DI void phaseC2_tile(const Params& p, int layer, int mt, int nt, unsigned char* smem) {
  const int t = tid();
  const int c8 = (t & 15) * 8;
  const float* ct = (const float*)smem;
  const float* xsrc = layer == 0 ? (mt < 128 ? p.x_prompt : p.x_sample - (size_t)SEQ * 1024) : p.Xf;
  float4 xr0[8], xr1[8];
#pragma unroll
  for (int i = 0; i < 8; ++i) {
    const float* xp = xsrc + (size_t)(mt * 128 + (t >> 4) + 16 * i) * 1024 + nt * 128 + c8;
    xr0[i] = *(const float4*)xp; xr1[i] = *(const float4*)(xp + 4);
  }
  f32x16 acc[2][2];
  zero_acc(acc);
  gemm_core(p.Mg + (size_t)mt * 128 * 1024, 1024, p.WoutT + ((size_t)layer * 1024 + nt * 128) * 1024, 1024, 1024, acc, smem);
  acc_to_lds(acc, smem);
  __syncthreads();
#pragma unroll
  for (int i = 0; i < 8; ++i) {
    const int rl = (t >> 4) + 16 * i;
    const int row = mt * 128 + rl;
    const float* cp = ct + rl * CT_STRIDE + c8;
    const float4 v0 = *(const float4*)cp, v1 = *(const float4*)(cp + 4);
    const float4 x0 = xr0[i], x1 = xr1[i];
    float* op = p.Xpre + (size_t)row * 1024 + nt * 128 + c8;
    *(float4*)op = make_float4(ALPHA_RES * x0.x + v0.x, ALPHA_RES * x0.y + v0.y, ALPHA_RES * x0.z + v0.z, ALPHA_RES * x0.w + v0.w);
    *(float4*)(op + 4) = make_float4(ALPHA_RES * x1.x + v1.x, ALPHA_RES * x1.y + v1.y, ALPHA_RES * x1.z + v1.z, ALPHA_RES * x1.w + v1.w);
  }
}

DI void phaseLN(const Params& p, int layer) {
  const int t = tid(), l = t & 63, w = t >> 6;
  const float* g = p.ln_g + layer * 1024;
  const float* b = p.ln_b + layer * 1024;
  float* dstf = layer == 3 ? p.out : p.Xf;
  for (int row = blockIdx.x * 4 + w; row < MTOK; row += gridDim.x * 4) {
    const float* src = p.Xpre + (size_t)row * 1024;
    float4 v[4];
    float s1 = 0.f;
#pragma unroll
    for (int i = 0; i < 4; ++i) { v[i] = *(const float4*)(src + i * 256 + l * 4); s1 += v[i].x + v[i].y + v[i].z + v[i].w; }
#pragma unroll
    for (int o = 32; o >= 1; o >>= 1) s1 += __shfl_xor(s1, o);
    const float mean = s1 * (1.f / 1024.f);
    float s2 = 0.f;
#pragma unroll
    for (int i = 0; i < 4; ++i) {
      v[i].x -= mean; v[i].y -= mean; v[i].z -= mean; v[i].w -= mean;
      s2 += v[i].x * v[i].x + v[i].y * v[i].y + v[i].z * v[i].z + v[i].w * v[i].w;
    }
#pragma unroll
    for (int o = 32; o >= 1; o >>= 1) s2 += __shfl_xor(s2, o);
    const float rstd = rsqrtf(s2 * (1.f / 1024.f) + LN_EPS);
#pragma unroll
    for (int i = 0; i < 4; ++i) {
      const int c = i * 256 + l * 4;
      const float4 gv = *(const float4*)(g + c), bv = *(const float4*)(b + c);
      const float y0 = v[i].x * rstd * gv.x + bv.x, y1 = v[i].y * rstd * gv.y + bv.y;
      const float y2 = v[i].z * rstd * gv.z + bv.z, y3 = v[i].w * rstd * gv.w + bv.w;
      *(float4*)(dstf + (size_t)row * 1024 + c) = make_float4(y0, y1, y2, y3);
      if (layer < 3) *(uint2*)(p.Xb + (size_t)row * 1024 + c) = make_uint2(pk(y0, y1), pk(y2, y3));
    }
  }
}

__global__ void __launch_bounds__(256, 2) fwd_megakernel(Params p) {
  __shared__ __attribute__((aligned(16))) unsigned char smem[SMEM_BYTES];
  __shared__ uint4 xb_words;
  cg::grid_group grid = cg::this_grid();
  if (threadIdx.x == 0) xb_words = make_uint4(0u, 0u, 0u, 0u);
  __syncthreads();
  XcdBarrier xb = xcd_barrier_post(p.bar, (volatile LAS unsigned*)&xb_words);
  for (int ph = p.ph_lo; ph < p.ph_hi; ++ph) {
    if (ph == 0) {
      phase0(p, smem);
    } else {
      const int layer = (ph - 1) / 5, sub = (ph - 1) % 5;
      const int nrep = (sub == PROBE_REP || (PROBE_REP == 6 && sub >= 2)) ? 2 : 1;
      for (int rep = 0; rep < nrep; ++rep) {
        if (rep) xcd_barrier(xb);
        if (sub == 0) {
          for (int tix = blockIdx.x; tix < 136 * 22; tix += gridDim.x) phaseA_tile(p, layer, tix / 22, tix % 22, smem);
        } else if (sub == 1) {
          phaseB(p, layer + 4 * rep, smem);
        } else if (sub == 2) {
          for (int tix = blockIdx.x; tix < 136 * 8; tix += gridDim.x) phaseC1_tile(p, layer, tix >> 3, tix & 7, smem);
        } else if (sub == 3) {
          for (int tix = blockIdx.x; tix < 136 * 8; tix += gridDim.x) phaseC2_tile(p, layer, tix >> 3, tix & 7, smem);
        } else {
          phaseLN(p, layer);
        }
      }
    }
    if (PROBE_REP == 5 && ph + 1 < p.ph_hi) xcd_barrier(xb);
    if (ph + 1 < p.ph_hi) { if (p.ph_hi < 0) grid.sync(); else xcd_barrier(xb); }
  }
}

extern "C" void kernel_launch(void* const* d_in, const int* in_sizes, int n_in, void* d_out, int out_size, void* d_ws, size_t ws_size, hipStream_t stream) {
  static int grid_blocks = 0;
  if (!grid_blocks) {
    int dev = 0, cus = 0, per_cu = 0;
    hipGetDevice(&dev);
    hipDeviceGetAttribute(&cus, hipDeviceAttributeMultiprocessorCount, dev);
    hipOccupancyMaxActiveBlocksPerMultiprocessor(&per_cu, fwd_megakernel, 256, 0);
    if (per_cu < 1) per_cu = 1;
    if (per_cu > 2) per_cu = 2;
    grid_blocks = cus * per_cu;
  }
  Params p{};
  const float** ins = (const float**)&p;
  for (int i = 0; i < 19; ++i) ins[i] = (const float*)d_in[i];
  p.out = (float*)d_out;
  unsigned char* ws = (unsigned char*)d_ws;
  size_t off = 0;
  auto take = [&](size_t bytes) { unsigned char* q = ws + off; off += (bytes + 255) & ~(size_t)255; return q; };
  p.WinT = (u16*)take((size_t)4 * 5632 * 1024 * 2);
  p.WoaT = (u16*)take((size_t)4 * 1024 * 512 * 2);
  p.WogT = (u16*)take((size_t)4 * 1024 * 512 * 2);
  p.WoutT = (u16*)take((size_t)4 * 1024 * 1024 * 2);
  p.Xb = (u16*)take((size_t)MTOK * 1024 * 2);
  p.H = (u16*)take((size_t)MTOK * INW * 2);
  p.A1 = (u16*)take((size_t)MTOK * 512 * 2);
  p.A2 = (u16*)take((size_t)MTOK * 512 * 2);
  p.Mg = (u16*)take((size_t)MTOK * 1024 * 2);
  p.Xf = (float*)take((size_t)MTOK * 1024 * 4);
  p.Xpre = (float*)take((size_t)MTOK * 1024 * 4);
  p.rope = (float*)take((size_t)SEQ * 32 * 2 * 4);
  p.lam = (float*)take(256);
  p.counters = (int*)take(256);
  p.bar = (unsigned*)take(XCD_BAR_WORDS * 4);
  hipMemsetAsync(p.bar, 0, XCD_BAR_WORDS * 4, stream);
#if MULTI_LAUNCH
  for (int ph = 0; ph < 21; ++ph) {
    p.ph_lo = ph; p.ph_hi = ph + 1;
    hipLaunchKernelGGL(fwd_megakernel, dim3(grid_blocks), dim3(256), 0, stream, p);
  }
#else
  p.ph_lo = 0; p.ph_hi = 21;
  void* args[] = {&p};
  hipError_t e = hipLaunchCooperativeKernel((void*)fwd_megakernel, dim3(grid_blocks), dim3(256), args, 0, stream);
  if (e != hipSuccess) fprintf(stderr, "cooperative launch failed: %s (grid %d)\n", hipGetErrorString(e), grid_blocks);
#endif
}
```

```cpp
#include <hip/hip_runtime.h>
#include <hip/hip_cooperative_groups.h>
#include <cstdio>
namespace cg = cooperative_groups;

#ifndef PROBE_REP
#define PROBE_REP -1
#endif
#ifndef MULTI_LAUNCH
#define MULTI_LAUNCH 0
#endif

#define DI __device__ __forceinline__
typedef unsigned short u16;
typedef __attribute__((ext_vector_type(8))) short bf16x8;
typedef __attribute__((ext_vector_type(4))) short s16x4;
typedef __attribute__((ext_vector_type(16))) float f32x16;
typedef __attribute__((ext_vector_type(2))) float f32x2;
typedef __attribute__((ext_vector_type(2))) __bf16 bf16x2_t;

constexpr int SEQ = 16384, MTOK = 17408, INW = 5632;
constexpr int C_K = 512, C_V = 1024, C_GA = 1536, C_U = 2048, C_VG = 2560, C_GG = 3072, C_MA = 3584, C_MB = 4608;
constexpr size_t OFF_KP = 17825792, OFF_VP = 51380224, OFF_KS = 84934656, OFF_VS = 87031808, OFF_GV = 89128960;
constexpr int SMEM_BYTES = 77824 + 64;
constexpr float ALPHA_RES = 1.681792830507429f;
constexpr float LN_EPS = 1e-5f;

struct Params {
  const float *x_prompt, *x_sample, *cache_k, *cache_v, *w_in, *w_oa, *w_og, *w_out;
  const float *lq1, *lk1, *lq2, *lk2, *subln_w, *sgu_g, *sgu_b, *w_s, *b_s, *ln_g, *ln_b;
  float* out;
  u16 *WinT, *WoaT, *WogT, *WoutT, *Xb, *H, *A1, *A2, *Mg, *Kc, *Vc;
  float *Xf, *Xpre, *rope, *lam;
  int* counters;
  unsigned* bar;
  int ph_lo, ph_hi;
};

DI unsigned pk(float a, float b) { f32x2 x = {a, b}; bf16x2_t y = __builtin_convertvector(x, bf16x2_t); return __builtin_bit_cast(unsigned, y); }
DI u16 f2bf(float a) { return (u16)(pk(a, 0.f) & 0xffffu); }
DI float bf2f(u16 h) { return __uint_as_float(((unsigned)h) << 16); }
DI float bflo(unsigned u) { return __uint_as_float(u << 16); }
DI float bfhi(unsigned u) { return __uint_as_float(u & 0xffff0000u); }
DI int tid() { int t = threadIdx.x; asm volatile("" : "+v"(t)); return t; }
DI int crow(int i, int hb) { return (i & 3) + 8 * (i >> 2) + 4 * hb; }
DI float sigmoidf_(float x) { return __builtin_amdgcn_rcpf(1.f + __expf(-x)); }
DI float siluf_(float x) { return x * __builtin_amdgcn_rcpf(1.f + __expf(-x)); }
#define MFMA(a, b, c) __builtin_amdgcn_mfma_f32_32x32x16_bf16((a), (b), (c), 0, 0, 0)
typedef __attribute__((address_space(3))) s16x4 lds_s16x4;
typedef __attribute__((address_space(3))) unsigned lds_u32;
DI void glds16(const void* g, unsigned lds_base) {
  unsigned sv;
  asm volatile("s_mov_b32 %0, m0\n\ts_mov_b32 m0, %2\n\ts_nop 0\n\tglobal_load_lds_dwordx4 %1, off\n\ts_mov_b32 m0, %0" : "=&s"(sv) : "v"(g), "s"(lds_base) : "memory");
}
DI void glds16s(const void* sbase, unsigned voff, unsigned lds_base) {
  unsigned sv;
  asm volatile("s_mov_b32 %0, m0\n\ts_mov_b32 m0, %3\n\ts_nop 0\n\tglobal_load_lds_dwordx4 %1, %2\n\ts_mov_b32 m0, %0" : "=&s"(sv) : "v"(voff), "s"(sbase), "s"(lds_base) : "memory");
}
DI unsigned lds_addr(const void* p) { return (unsigned)(size_t)(__attribute__((address_space(3))) const unsigned char*)p; }
DI s16x4 tr_read(const u16* p) { return __builtin_amdgcn_ds_read_tr16_b64_v4i16((lds_s16x4*)p); }
DI bf16x8 cat8(s16x4 lo, s16x4 hi) { return __builtin_shufflevector(lo, hi, 0, 1, 2, 3, 4, 5, 6, 7); }


#define XB_TMO      128
#define XB_XCNT(j)  (256  + 64 * (j))
#define XB_XSUB(j)  (1280 + 64 * (j))
#define XB_XGEN(j)  (2304 + 64 * (j))
#define XB_TOP      3328
#define XB_TOPGEN   3392
#define XCD_BAR_WORDS 3456
#define XB_SPIN_CAP (1u << 24)
#define LAS __attribute__((address_space(3)))
DI unsigned xb_ld(unsigned* p)              { return __hip_atomic_load(p, __ATOMIC_RELAXED, __HIP_MEMORY_SCOPE_AGENT); }
DI unsigned xb_add(unsigned* p, unsigned v) { return __hip_atomic_fetch_add(p, v, __ATOMIC_RELAXED, __HIP_MEMORY_SCOPE_AGENT); }
DI unsigned xb_xcc_id() { return (unsigned)__builtin_amdgcn_s_getreg((3 << 11) | 20) & 0xFu; }
#define XB_SPIN(cond, bar) do { unsigned _sp = 0; while (cond) { __builtin_amdgcn_s_sleep(1); \
    if ((++_sp & 255u) == 0u) { if (xb_ld(&(bar)[XB_TMO])) break; if (_sp > XB_SPIN_CAP) { atomicAdd(&(bar)[XB_TMO], 1u); break; } } } } while (0)
struct XcdBarrier { unsigned* bar; unsigned x; volatile LAS unsigned* st; };
DI XcdBarrier xcd_barrier_post(unsigned* bar, volatile LAS unsigned* st) {
  XcdBarrier b; b.bar = bar; b.x = xb_xcc_id(); b.st = st;
  if (threadIdx.x == 0) (void)xb_add(&bar[XB_XCNT(b.x)], 1u);
  return b;
}
DI void xcd_barrier_complete(unsigned* bar, unsigned x, unsigned& nloc, unsigned& nx) {
  const unsigned G = gridDim.x * gridDim.y * gridDim.z;
  unsigned sum, cnt, mine, sp = 0u;
  for (;;) {
    sum = 0u; cnt = 0u; mine = 0u;
#pragma unroll
    for (unsigned j = 0; j < 16; ++j) { const unsigned c = xb_ld(&bar[XB_XCNT(j)]); sum += c; cnt += (c > 0u) ? 1u : 0u; mine = (j == x) ? c : mine; }
    if (sum == G) break;
    __builtin_amdgcn_s_sleep(1);
    if ((++sp & 255u) == 0u) { if (xb_ld(&bar[XB_TMO])) break; if (sp > XB_SPIN_CAP) { atomicAdd(&bar[XB_TMO], 1u); break; } }
  }
  nloc = mine > 0u ? mine : 1u; nx = cnt > 0u ? cnt : 1u;
}
DI void xcd_barrier(const XcdBarrier& b) {
  asm volatile("s_waitcnt vmcnt(0)" ::: "memory");
  __syncthreads();
  if (threadIdx.x == 0) {
    unsigned* bar = b.bar;
    __builtin_amdgcn_s_waitcnt(0);
    unsigned nloc = b.st[0], nx = b.st[1];
    if (nloc == 0u) { xcd_barrier_complete(bar, b.x, nloc, nx); b.st[0] = nloc; b.st[1] = nx; }
    const unsigned old = xb_add(&bar[XB_XSUB(b.x)], 1u);
    const unsigned gen = old / nloc;
    if (old + 1u == (gen + 1u) * nloc) {
      __builtin_amdgcn_fence(__ATOMIC_RELEASE, "agent");
      asm volatile("s_waitcnt vmcnt(0)" ::: "memory");
      const unsigned og = xb_add(&bar[XB_TOP], 1u);
      const unsigned tg = og / nx;
      if (og + 1u == (tg + 1u) * nx) xb_add(&bar[XB_TOPGEN], 1u);
      else XB_SPIN(xb_ld(&bar[XB_TOPGEN]) == tg, bar);
      __builtin_amdgcn_fence(__ATOMIC_ACQUIRE, "agent");
      xb_add(&bar[XB_XGEN(b.x)], 1u);
      asm volatile("s_waitcnt vmcnt(0)" ::: "memory");
    } else {
      XB_SPIN(xb_ld(&bar[XB_XGEN(b.x)]) == gen, bar);
      __builtin_amdgcn_fence(__ATOMIC_ACQUIRE, "agent");
      asm volatile("s_waitcnt vmcnt(0)" ::: "memory");
    }
  }
  __syncthreads();
}

DI void gemm_core(const u16* __restrict__ A, int lda, const u16* __restrict__ Bt, int ldb, int K,
                  f32x16 (&acc)[2][2], unsigned char* smem) {
  const int t = tid(), l = t & 63, w = t >> 6, wm = w >> 1, wn = w & 1, hb = l >> 5, r = l & 31;
  const int grow = w * 8 + (l >> 3);
  const int gch = (l & 7) ^ ((grow >> 1) & 7);
  const u16* ag = A + (size_t)grow * lda + gch * 8;
  const u16* bg = Bt + (size_t)grow * ldb + gch * 8;
  const unsigned lbase = __builtin_amdgcn_readfirstlane(lds_addr(smem) + w * 1024);
#define GM_STAGE(BUF, KO)                                                                                        \
  {                                                                                                              \
    const unsigned sa_ = lbase + (BUF) * 32768;                                                                  \
    _Pragma("unroll") for (int i = 0; i < 4; ++i) {                                                              \
      glds16(ag + (size_t)(32 * i) * lda + (KO), sa_ + i * 4096);                                                \
      glds16(bg + (size_t)(32 * i) * ldb + (KO), sa_ + 16384 + i * 4096);                                        \
    }                                                                                                            \
  }
  __syncthreads();
  GM_STAGE(0, 0)
  asm volatile("s_waitcnt vmcnt(0)" ::: "memory");
  __syncthreads();
  const int sw = (r >> 1) & 7;
  const int o0 = ((0 + hb) ^ sw) * 8, o1 = ((2 + hb) ^ sw) * 8, o2 = ((4 + hb) ^ sw) * 8, o3 = ((6 + hb) ^ sw) * 8;
  const int nk = K >> 6;
  for (int kt = 0; kt < nk; ++kt) {
    const int buf = kt & 1;
    if (kt + 1 < nk) GM_STAGE(buf ^ 1, (kt + 1) * 64)
    __builtin_amdgcn_sched_barrier(0);
    const u16* as = (const u16*)(smem + buf * 32768) + (wm * 64 + r) * 64;
    const u16* bs = (const u16*)(smem + buf * 32768 + 16384) + (wn * 64 + r) * 64;
#define GM_LDF(A0, A1, B0, B1, OFF)                                                       \
    A0 = *(const bf16x8*)(as + (OFF)); A1 = *(const bf16x8*)(as + 32 * 64 + (OFF));       \
    B0 = *(const bf16x8*)(bs + (OFF)); B1 = *(const bf16x8*)(bs + 32 * 64 + (OFF));
#define GM_MM(A0, A1, B0, B1)                                                             \
    acc[0][0] = MFMA(A0, B0, acc[0][0]); acc[0][1] = MFMA(A0, B1, acc[0][1]);             \
    acc[1][0] = MFMA(A1, B0, acc[1][0]); acc[1][1] = MFMA(A1, B1, acc[1][1]);
    {
      bf16x8 xa0, xa1, xb0, xb1, ya0, ya1, yb0, yb1;
      GM_LDF(xa0, xa1, xb0, xb1, o0)
      GM_LDF(ya0, ya1, yb0, yb1, o1)
      __builtin_amdgcn_sched_barrier(0);
      GM_MM(xa0, xa1, xb0, xb1)
      __builtin_amdgcn_sched_barrier(0);
      GM_LDF(xa0, xa1, xb0, xb1, o2)
      __builtin_amdgcn_sched_barrier(0);
      GM_MM(ya0, ya1, yb0, yb1)
      __builtin_amdgcn_sched_barrier(0);
      GM_LDF(ya0, ya1, yb0, yb1, o3)
      __builtin_amdgcn_sched_barrier(0);
      GM_MM(xa0, xa1, xb0, xb1)
      __builtin_amdgcn_sched_barrier(0);
      GM_MM(ya0, ya1, yb0, yb1)
    }
    asm volatile("s_waitcnt vmcnt(0)" ::: "memory");
    __syncthreads();
  }
}


DI void gemm_core_wide(const u16* __restrict__ A, int lda, const u16* __restrict__ Bt, int ldb, int K,
                       f32x16 (&acc)[2][4], unsigned char* smem) {
  const int t = tid(), l = t & 63, w = t >> 6, wm = w >> 1, wn = w & 1, hb = l >> 5, r = l & 31;
  const int grow = w * 16 + (l >> 2);
  const int gch = (l & 3) ^ ((l >> 4) & 3);
  const u16* ag = A + (size_t)grow * lda + gch * 8;
  const u16* bg = Bt + (size_t)grow * ldb + gch * 8;
  const unsigned lbase = __builtin_amdgcn_readfirstlane(lds_addr(smem) + w * 1024);
#define GW_STAGE(SLOT, KO)                                                                  \
  {                                                                                         \
    const unsigned sa_ = lbase + (SLOT) * 24576;                                            \
    glds16(ag + (KO), sa_);                                                                 \
    glds16(ag + (size_t)64 * lda + (KO), sa_ + 4096);                                       \
    glds16(bg + (KO), sa_ + 8192);                                                          \
    glds16(bg + (size_t)64 * ldb + (KO), sa_ + 8192 + 4096);                                \
    glds16(bg + (size_t)128 * ldb + (KO), sa_ + 8192 + 8192);                               \
    glds16(bg + (size_t)192 * ldb + (KO), sa_ + 8192 + 12288);                              \
  }
  __syncthreads();
  GW_STAGE(0, 0)
  GW_STAGE(1, 32)
  const int sw = (r >> 2) & 3;
  const int o0 = ((0 + hb) ^ sw) * 8, o1 = ((2 + hb) ^ sw) * 8;
  const int nk = K >> 5;
  int slot = 0;
  for (int kt = 0; kt < nk; ++kt) {
    if (kt + 1 < nk) asm volatile("s_waitcnt vmcnt(6)" ::: "memory"); else asm volatile("s_waitcnt vmcnt(0)" ::: "memory");
    __syncthreads();
    if (kt + 2 < nk) { const int s2 = slot >= 1 ? slot - 1 : 2; GW_STAGE(s2, (kt + 2) * 32) }
    __builtin_amdgcn_sched_barrier(0);
    const u16* as = (const u16*)(smem + slot * 24576) + (wm * 64 + r) * 32;
    const u16* bs = (const u16*)(smem + slot * 24576 + 8192) + (wn * 128 + r) * 32;
    {
      bf16x8 a0 = *(const bf16x8*)(as + o0), a1 = *(const bf16x8*)(as + 32 * 32 + o0);
      bf16x8 b0 = *(const bf16x8*)(bs + o0), b1 = *(const bf16x8*)(bs + 32 * 32 + o0);
      bf16x8 b2 = *(const bf16x8*)(bs + 64 * 32 + o0), b3 = *(const bf16x8*)(bs + 96 * 32 + o0);
      bf16x8 c0 = *(const bf16x8*)(as + o1), c1 = *(const bf16x8*)(as + 32 * 32 + o1);
      bf16x8 d0 = *(const bf16x8*)(bs + o1), d1 = *(const bf16x8*)(bs + 32 * 32 + o1);
      bf16x8 d2 = *(const bf16x8*)(bs + 64 * 32 + o1), d3 = *(const bf16x8*)(bs + 96 * 32 + o1);
      acc[0][0] = MFMA(a0, b0, acc[0][0]); acc[0][1] = MFMA(a0, b1, acc[0][1]); acc[0][2] = MFMA(a0, b2, acc[0][2]); acc[0][3] = MFMA(a0, b3, acc[0][3]);
      acc[1][0] = MFMA(a1, b0, acc[1][0]); acc[1][1] = MFMA(a1, b1, acc[1][1]); acc[1][2] = MFMA(a1, b2, acc[1][2]); acc[1][3] = MFMA(a1, b3, acc[1][3]);
      acc[0][0] = MFMA(c0, d0, acc[0][0]); acc[0][1] = MFMA(c0, d1, acc[0][1]); acc[0][2] = MFMA(c0, d2, acc[0][2]); acc[0][3] = MFMA(c0, d3, acc[0][3]);
      acc[1][0] = MFMA(c1, d0, acc[1][0]); acc[1][1] = MFMA(c1, d1, acc[1][1]); acc[1][2] = MFMA(c1, d2, acc[1][2]); acc[1][3] = MFMA(c1, d3, acc[1][3]);
    }
    slot = slot == 2 ? 0 : slot + 1;
  }
}

constexpr int CT_STRIDE = 132;
DI void acc_to_lds(const f32x16 (&acc)[2][2], unsigned char* smem) {
  const int t = tid(), l = t & 63, w = t >> 6, wm = w >> 1, wn = w & 1, hb = l >> 5, r = l & 31;
  float* base = (float*)smem + (wm * 64 + 4 * hb) * CT_STRIDE + wn * 64 + r;
#pragma unroll
  for (int tm = 0; tm < 2; ++tm)
#pragma unroll
    for (int tn = 0; tn < 2; ++tn)
#pragma unroll
      for (int i = 0; i < 16; ++i) base[(tm * 32 + (i & 3) + 8 * (i >> 2)) * CT_STRIDE + tn * 32] = acc[tm][tn][i];
}
typedef __attribute__((ext_vector_type(4))) float f32x4_t;
DI void nt_store4(float* p, const float4& v) { f32x4_t x = {v.x, v.y, v.z, v.w}; __builtin_nontemporal_store(x, (f32x4_t*)p); }
DI uint4 pack8(const float4& a, const float4& b) { return make_uint4(pk(a.x, a.y), pk(a.z, a.w), pk(b.x, b.y), pk(b.z, b.w)); }

DI void zero_acc(f32x16 (&acc)[2][2]) {
#pragma unroll
  for (int a = 0; a < 2; ++a)
#pragma unroll
    for (int b = 0; b < 2; ++b)
#pragma unroll
      for (int i = 0; i < 16; ++i) acc[a][b][i] = 0.f;
}

DI void transpose_tile(const float* __restrict__ src, u16* __restrict__ dst, int K, int N, int kt, int nt, unsigned char* smem) {
  float* tile = (float*)smem;
  const int t = tid();
  __syncthreads();
#pragma unroll
  for (int i = 0; i < 4; ++i) {
    const int row = (t >> 4) + 16 * i, c4 = (t & 15) * 4;
    const float4 v = *(const float4*)(src + (size_t)(kt * 64 + row) * N + nt * 64 + c4);
    tile[row * 65 + c4 + 0] = v.x; tile[row * 65 + c4 + 1] = v.y; tile[row * 65 + c4 + 2] = v.z; tile[row * 65 + c4 + 3] = v.w;
  }
  __syncthreads();
  const int n = t >> 2, kseg = (t & 3) * 16;
  unsigned o[8];
#pragma unroll
  for (int e = 0; e < 8; ++e) o[e] = pk(tile[(kseg + 2 * e) * 65 + n], tile[(kseg + 2 * e + 1) * 65 + n]);
  u16* d = dst + (size_t)(nt * 64 + n) * K + kt * 64 + kseg;
  *(uint4*)d = make_uint4(o[0], o[1], o[2], o[3]);
  *(uint4*)(d + 8) = make_uint4(o[4], o[5], o[6], o[7]);
}

__device__ const float ROPE_INV[32] = {1.0f, 0.749894202f, 0.562341332f, 0.421696514f, 0.316227764f, 0.237137377f, 0.177827939f, 0.133352146f, 0.100000001f, 0.0749894232f, 0.0562341325f, 0.0421696492f, 0.0316227749f, 0.0237137377f, 0.0177827943f, 0.013335214f, 0.00999999978f, 0.00749894232f, 0.00562341325f, 0.00421696482f, 0.00316227763f, 0.00237137382f, 0.00177827943f, 0.00133352145f, 0.00100000005f, 0.000749894185f, 0.000562341302f, 0.000421696517f, 0.000316227757f, 0.00023713737f, 0.00017782794f, 0.00013335215f};

DI void phase0(const Params& p, unsigned char* smem) {
  const int t = tid();
  if (blockIdx.x == 0) {
    if (t < 4) {
      float s1 = 0.f, s2 = 0.f;
      for (int i = 0; i < 64; ++i) { s1 += p.lq1[t * 64 + i] * p.lk1[t * 64 + i]; s2 += p.lq2[t * 64 + i] * p.lk2[t * 64 + i]; }
      const float li = t == 0 ? 0.2f : (t == 1 ? 0.355509067590969f : (t == 2 ? 0.470713018343584f : 0.556058204155641f));
      p.lam[t] = expf(s1) - expf(s2) + li;
      p.lam[4 + t] = li;
      p.counters[t] = 0; p.counters[4 + t] = 0;
    }
  }
  {
    float* tile = (float*)smem;
    const int trow = t >> 4, tc4 = (t & 15) * 4;
    const int tn = t >> 2, tkseg = (t & 3) * 16;
    const float* tsrc; u16* tdst; int tK, tN, tkt, tnt;
#define TR_DECODE(J)                                                                                                                       \
    if ((J) < 5632) { const int l_ = (J) / 1408, r_ = (J) % 1408; tsrc = p.w_in + (size_t)l_ * 1024 * 5632; tdst = p.WinT + (size_t)l_ * 5632 * 1024; tK = 1024; tN = 5632; tkt = r_ / 88; tnt = r_ % 88; } \
    else if ((J) < 6144) { const int q_ = (J) - 5632, l_ = q_ >> 7, r_ = q_ & 127; tsrc = p.w_oa + (size_t)l_ * 512 * 1024; tdst = p.WoaT + (size_t)l_ * 1024 * 512; tK = 512; tN = 1024; tkt = r_ >> 4; tnt = r_ & 15; } \
    else if ((J) < 6656) { const int q_ = (J) - 6144, l_ = q_ >> 7, r_ = q_ & 127; tsrc = p.w_og + (size_t)l_ * 512 * 1024; tdst = p.WogT + (size_t)l_ * 1024 * 512; tK = 512; tN = 1024; tkt = r_ >> 4; tnt = r_ & 15; } \
    else { const int q_ = (J) - 6656, l_ = q_ >> 8, r_ = q_ & 255; tsrc = p.w_out + (size_t)l_ * 1024 * 1024; tdst = p.WoutT + (size_t)l_ * 1024 * 1024; tK = 1024; tN = 1024; tkt = r_ >> 4; tnt = r_ & 15; }
#define TR_LOAD()                                                                                                                          \
    { const float* s_ = tsrc + (size_t)(tkt * 64 + trow) * tN + tnt * 64 + tc4;                                                            \
      f0 = *(const float4*)s_; f1 = *(const float4*)(s_ + (size_t)16 * tN); f2 = *(const float4*)(s_ + (size_t)32 * tN); f3 = *(const float4*)(s_ + (size_t)48 * tN); }
    float4 f0, f1, f2, f3;
    int j = blockIdx.x;
    if (j < 7680) { TR_DECODE(j) TR_LOAD() }
    for (; j < 7680; j += gridDim.x) {
      u16* d = tdst + (size_t)(tnt * 64 + tn) * tK + tkt * 64 + tkseg;
      __syncthreads();
      float* w0 = tile + trow * 65 + tc4;
      w0[0] = f0.x; w0[1] = f0.y; w0[2] = f0.z; w0[3] = f0.w;
      w0[16 * 65 + 0] = f1.x; w0[16 * 65 + 1] = f1.y; w0[16 * 65 + 2] = f1.z; w0[16 * 65 + 3] = f1.w;
      w0[32 * 65 + 0] = f2.x; w0[32 * 65 + 1] = f2.y; w0[32 * 65 + 2] = f2.z; w0[32 * 65 + 3] = f2.w;
      w0[48 * 65 + 0] = f3.x; w0[48 * 65 + 1] = f3.y; w0[48 * 65 + 2] = f3.z; w0[48 * 65 + 3] = f3.w;
      __syncthreads();
      const int jn = j + gridDim.x;
      if (jn < 7680) { TR_DECODE(jn) TR_LOAD() }
      unsigned o0 = pk(tile[(tkseg + 0) * 65 + tn], tile[(tkseg + 1) * 65 + tn]), o1 = pk(tile[(tkseg + 2) * 65 + tn], tile[(tkseg + 3) * 65 + tn]);
      unsigned o2 = pk(tile[(tkseg + 4) * 65 + tn], tile[(tkseg + 5) * 65 + tn]), o3 = pk(tile[(tkseg + 6) * 65 + tn], tile[(tkseg + 7) * 65 + tn]);
      unsigned o4 = pk(tile[(tkseg + 8) * 65 + tn], tile[(tkseg + 9) * 65 + tn]), o5 = pk(tile[(tkseg + 10) * 65 + tn], tile[(tkseg + 11) * 65 + tn]);
      unsigned o6 = pk(tile[(tkseg + 12) * 65 + tn], tile[(tkseg + 13) * 65 + tn]), o7 = pk(tile[(tkseg + 14) * 65 + tn], tile[(tkseg + 15) * 65 + tn]);
      *(uint4*)d = make_uint4(o0, o1, o2, o3);
      *(uint4*)(d + 8) = make_uint4(o4, o5, o6, o7);
    }
  }
  const int gt = blockIdx.x * 256 + t, gs = gridDim.x * 256;
  for (int idx = gt; idx < MTOK * 128; idx += gs) {
    const int row = idx >> 7, c8 = (idx & 127) * 8;
    const float* src = row < SEQ ? p.x_prompt + (size_t)row * 1024 + c8 : p.x_sample + (size_t)(row - SEQ) * 1024 + c8;
    const float4 a = *(const float4*)src, b = *(const float4*)(src + 4);
    *(uint4*)(p.Xb + (size_t)row * 1024 + c8) = make_uint4(pk(a.x, a.y), pk(a.z, a.w), pk(b.x, b.y), pk(b.z, b.w));
  }
  for (int idx = gt; idx < SEQ * 32; idx += gs) {
    const int pos = idx >> 5, j = idx & 31;
    const float inv = ROPE_INV[j];
    const float ang = (float)pos * inv;
    double rev = (double)ang * 0.15915494309189535;
    rev -= rint(rev);
    const float rf = (float)rev;
    p.rope[2 * idx] = __builtin_amdgcn_cosf(rf);
    p.rope[2 * idx + 1] = __builtin_amdgcn_sinf(rf);
  }
}

constexpr int CW_STRIDE = 260;
DI void phaseA_tile(const Params& p, int layer, int mt, int nt, unsigned char* smem) {
  f32x16 acc[2][4];
#pragma unroll
  for (int a = 0; a < 2; ++a)
#pragma unroll
    for (int b = 0; b < 4; ++b)
#pragma unroll
      for (int i = 0; i < 16; ++i) acc[a][b][i] = 0.f;
  gemm_core_wide(p.Xb + (size_t)mt * 128 * 1024, 1024, p.WinT + ((size_t)layer * 5632 + nt * 256) * 1024, 1024, 1024, acc, smem);
  const int t = tid(), l = t & 63, w = t >> 6, wm = w >> 1, wn = w & 1, hb = l >> 5, r = l & 31;
  const int n0 = nt * 256, seg = n0 >> 9;
  const bool samp = mt >= 128;
  float* ct = (float*)smem;
#pragma unroll
  for (int h = 0; h < 2; ++h) {
    __syncthreads();
    if (wm == h) {
      float* base = ct + (4 * hb) * CW_STRIDE + wn * 128 + r;
#pragma unroll
      for (int tm = 0; tm < 2; ++tm)
#pragma unroll
        for (int tn = 0; tn < 4; ++tn)
#pragma unroll
          for (int i = 0; i < 16; ++i) base[(tm * 32 + (i & 3) + 8 * (i >> 2)) * CW_STRIDE + tn * 32] = acc[tm][tn][i];
    }
    __syncthreads();
    if (seg <= 1) {
      const int j = t & 15, head = j >> 2, c8 = (j & 3) * 8;
#pragma unroll
      for (int i = 0; i < 4; ++i) {
        const int rl = (t >> 4) + 16 * i;
        const int row = mt * 128 + h * 64 + rl;
        const int pos = samp ? 1024 + ((row - SEQ) & 31) : row;
        const float* cp = ct + rl * CW_STRIDE + head * 64 + c8;
        const float4 xa0 = *(const float4*)cp, xa1 = *(const float4*)(cp + 4);
        const float4 xb0 = *(const float4*)(cp + 32), xb1 = *(const float4*)(cp + 36);
        const float4* rp = (const float4*)(p.rope + ((size_t)pos * 32 + c8) * 2);
        const float4 r0 = rp[0], r1 = rp[1], r2 = rp[2], r3 = rp[3];
        float4 ya0, ya1, yb0, yb1;
        ya0.x = xa0.x * r0.x - xb0.x * r0.y; yb0.x = xb0.x * r0.x + xa0.x * r0.y;
        ya0.y = xa0.y * r0.z - xb0.y * r0.w; yb0.y = xb0.y * r0.z + xa0.y * r0.w;
        ya0.z = xa0.z * r1.x - xb0.z * r1.y; yb0.z = xb0.z * r1.x + xa0.z * r1.y;
        ya0.w = xa0.w * r1.z - xb0.w * r1.w; yb0.w = xb0.w * r1.z + xa0.w * r1.w;
        ya1.x = xa1.x * r2.x - xb1.x * r2.y; yb1.x = xb1.x * r2.x + xa1.x * r2.y;
        ya1.y = xa1.y * r2.z - xb1.y * r2.w; yb1.y = xb1.y * r2.z + xa1.y * r2.w;
        ya1.z = xa1.z * r3.x - xb1.z * r3.y; yb1.z = xb1.z * r3.x + xa1.z * r3.y;
        ya1.w = xa1.w * r3.z - xb1.w * r3.w; yb1.w = xb1.w * r3.z + xa1.w * r3.w;
        const int col = n0 + head * 64 + c8;
        u16* hp = seg == 1 ? p.Kc + ((size_t)((col - C_K) >> 7) * MTOK + row) * 128 + ((col - C_K) & 127) : p.H + (size_t)row * INW + col;
        if (seg == 0) {
          const float qs = 0.125f * 1.4426950408889634f;
          *(uint4*)hp = make_uint4(pk(ya0.x * qs, ya0.y * qs), pk(ya0.z * qs, ya0.w * qs), pk(ya1.x * qs, ya1.y * qs), pk(ya1.z * qs, ya1.w * qs));
          *(uint4*)(hp + 32) = make_uint4(pk(yb0.x * qs, yb0.y * qs), pk(yb0.z * qs, yb0.w * qs), pk(yb1.x * qs, yb1.y * qs), pk(yb1.z * qs, yb1.w * qs));
        } else {
          *(uint4*)hp = pack8(ya0, ya1);
          *(uint4*)(hp + 32) = pack8(yb0, yb1);
        }
        if (seg == 1) {
          float* o = samp ? p.out + OFF_KS + ((size_t)layer * 1024 + (row - SEQ)) * 512 + (col - C_K)
                          : p.out + OFF_KP + ((size_t)layer * SEQ + row) * 512 + (col - C_K);
          nt_store4(o, ya0); nt_store4(o + 4, ya1); nt_store4(o + 32, yb0); nt_store4(o + 36, yb1);
        }
      }
    } else {
      const int c8 = (t & 31) * 8;
#pragma unroll
      for (int i = 0; i < 8; ++i) {
        const int rl = (t >> 5) + 8 * i;
        const int row = mt * 128 + h * 64 + rl;
        const float* cp = ct + rl * CW_STRIDE + c8;
        const float4 v0 = *(const float4*)cp, v1 = *(const float4*)(cp + 4);
        const int col = n0 + c8;
        if (seg == 2) *(uint4*)(p.Vc + ((size_t)((col - C_V) >> 7) * MTOK + row) * 128 + ((col - C_V) & 127)) = pack8(v0, v1);
        else *(uint4*)(p.H + (size_t)row * INW + col) = pack8(v0, v1);
        if (seg == 2) {
          float* o = samp ? p.out + OFF_VS + ((size_t)layer * 1024 + (row - SEQ)) * 512 + (col - C_V)
                          : p.out + OFF_VP + ((size_t)layer * SEQ + row) * 512 + (col - C_V);
          nt_store4(o, v0); nt_store4(o + 4, v1);
        }
      }
    }
  }
}

constexpr int KS_STRIDE = 72;
constexpr int VS_STRIDE = 160;
constexpr int ST_K = 2 * 64 * KS_STRIDE;
constexpr int ST_BYTES = ST_K * 2 + 64 * VS_STRIDE * 2;

#define LOADV(D0, D1, D2, D3, G)                                                             \
  {                                                                                          \
    const u16* vk_ = vp + ((G) * 16) * VROW;                                                 \
    D0 = cat8(tr_read(vk_ + vo0), tr_read(vk_ + 8 * VROW + vo0));                            \
    D1 = cat8(tr_read(vk_ + vo1), tr_read(vk_ + 8 * VROW + vo1));                            \
    D2 = cat8(tr_read(vk_ + vo2), tr_read(vk_ + 8 * VROW + vo2));                            \
    D3 = cat8(tr_read(vk_ + vo3), tr_read(vk_ + 8 * VROW + vo3));                            \
  }
#define PACKP(S, U) __builtin_bit_cast(bf16x8, make_uint4(pk(S[8 * (U) + 0], S[8 * (U) + 1]), pk(S[8 * (U) + 2], S[8 * (U) + 3]), pk(S[8 * (U) + 4], S[8 * (U) + 5]), pk(S[8 * (U) + 6], S[8 * (U) + 7])))
#define PVMFMA(D0, D1, D2, D3, PB) { O[0] = MFMA(D0, PB, O[0]); O[1] = MFMA(D1, PB, O[1]); O[2] = MFMA(D2, PB, O[2]); O[3] = MFMA(D3, PB, O[3]); }
template <bool SWZ>
DI void attn_compute(const u16* Kb, const u16* Vb, const bf16x8 (&qf)[4], f32x16 (&O)[4], f32x16& Mneg, float& m_run, float& l_run, bool two, int s) {
  const int l = tid() & 63, hb = l >> 5, r = l & 31;
  f32x16 S0, S1;
  constexpr int KROW = SWZ ? 64 : KS_STRIDE, VROW = SWZ ? 128 : VS_STRIDE;
  const int q4 = (l & 15) >> 2, p4 = l & 3, blk = (l >> 4) & 1;
  const int ksw = SWZ ? ((r >> 1) & 7) : 0;
  const u16* kp = Kb + (s * 64 + r) * KROW;
  const int ko0 = ((0 + hb) ^ ksw) * 8, ko1 = ((2 + hb) ^ ksw) * 8, ko2 = ((4 + hb) ^ ksw) * 8, ko3 = ((6 + hb) ^ ksw) * 8;
  const u16* vp = Vb + (4 * hb + q4) * VROW + blk * 16 + p4 * 4;
  const int vsw = SWZ ? q4 : 0;
  const int vo0 = (0 ^ vsw) * 32, vo1 = (1 ^ vsw) * 32, vo2 = (2 ^ vsw) * 32, vo3 = (3 ^ vsw) * 32;
  bf16x8 ka0, ka1, ka2, ka3, kb0, kb1, kb2, kb3, va0, va1, va2, va3, vb0, vb1, vb2, vb3;
  ka0 = *(const bf16x8*)(kp + ko0); ka1 = *(const bf16x8*)(kp + ko1); ka2 = *(const bf16x8*)(kp + ko2); ka3 = *(const bf16x8*)(kp + ko3);
  if (two) {
    kb0 = *(const bf16x8*)(kp + 32 * KROW + ko0); kb1 = *(const bf16x8*)(kp + 32 * KROW + ko1);
    kb2 = *(const bf16x8*)(kp + 32 * KROW + ko2); kb3 = *(const bf16x8*)(kp + 32 * KROW + ko3);
  }
  LOADV(va0, va1, va2, va3, 0)
  __builtin_amdgcn_sched_barrier(0);
  S0 = MFMA(ka0, qf[0], Mneg); S0 = MFMA(ka1, qf[1], S0); S0 = MFMA(ka2, qf[2], S0); S0 = MFMA(ka3, qf[3], S0);
  if (two) { S1 = MFMA(kb0, qf[0], Mneg); S1 = MFMA(kb1, qf[1], S1); S1 = MFMA(kb2, qf[2], S1); S1 = MFMA(kb3, qf[3], S1); }
  float ls = 0.f;
#pragma unroll
  for (int i = 0; i < 16; ++i) { S0[i] = __builtin_amdgcn_exp2f(S0[i]); ls += S0[i]; }
  if (two) {
#pragma unroll
    for (int i = 0; i < 16; ++i) { S1[i] = __builtin_amdgcn_exp2f(S1[i]); ls += S1[i]; }
  }
  if (__any(!(ls <= 4194304.f))) {
    bf16x8 ra0 = *(const bf16x8*)(kp + ko0), ra1 = *(const bf16x8*)(kp + ko1), ra2 = *(const bf16x8*)(kp + ko2), ra3 = *(const bf16x8*)(kp + ko3);
#pragma unroll
    for (int i = 0; i < 16; ++i) { S0[i] = 0.f; S1[i] = 0.f; }
    S0 = MFMA(ra0, qf[0], S0); S0 = MFMA(ra1, qf[1], S0); S0 = MFMA(ra2, qf[2], S0); S0 = MFMA(ra3, qf[3], S0);
    if (two) {
      ra0 = *(const bf16x8*)(kp + 32 * KROW + ko0); ra1 = *(const bf16x8*)(kp + 32 * KROW + ko1);
      ra2 = *(const bf16x8*)(kp + 32 * KROW + ko2); ra3 = *(const bf16x8*)(kp + 32 * KROW + ko3);
      S1 = MFMA(ra0, qf[0], S1); S1 = MFMA(ra1, qf[1], S1); S1 = MFMA(ra2, qf[2], S1); S1 = MFMA(ra3, qf[3], S1);
    }
    float mx = S0[0];
#pragma unroll
    for (int i = 1; i < 16; ++i) mx = fmaxf(mx, S0[i]);
    if (two) {
#pragma unroll
      for (int i = 0; i < 16; ++i) mx = fmaxf(mx, S1[i]);
    }
    mx = fmaxf(mx, __shfl_xor(mx, 32));
    const float m_new = fmaxf(m_run, mx);
    const float alpha = __builtin_amdgcn_exp2f(m_run - m_new);
    m_run = m_new;
#pragma unroll
    for (int i = 0; i < 16; ++i) Mneg[i] = -m_new;
    l_run *= alpha;
#pragma unroll
    for (int dt = 0; dt < 4; ++dt)
#pragma unroll
      for (int i = 0; i < 16; ++i) O[dt][i] *= alpha;
    ls = 0.f;
#pragma unroll
    for (int i = 0; i < 16; ++i) { S0[i] = __builtin_amdgcn_exp2f(S0[i] - m_new); ls += S0[i]; }
    if (two) {
#pragma unroll
      for (int i = 0; i < 16; ++i) { S1[i] = __builtin_amdgcn_exp2f(S1[i] - m_new); ls += S1[i]; }
    }
  }
  l_run += ls;
  {
    const bf16x8 pb0 = PACKP(S0, 0);
    __builtin_amdgcn_sched_barrier(0);
    LOADV(vb0, vb1, vb2, vb3, 1)
    __builtin_amdgcn_sched_barrier(0);
    PVMFMA(va0, va1, va2, va3, pb0)
    const bf16x8 pb1 = PACKP(S0, 1);
    __builtin_amdgcn_sched_barrier(0);
    if (two) LOADV(va0, va1, va2, va3, 2)
    __builtin_amdgcn_sched_barrier(0);
    PVMFMA(vb0, vb1, vb2, vb3, pb1)
    if (two) {
      const bf16x8 pb2 = PACKP(S1, 0);
      __builtin_amdgcn_sched_barrier(0);
      LOADV(vb0, vb1, vb2, vb3, 3)
      __builtin_amdgcn_sched_barrier(0);
      PVMFMA(va0, va1, va2, va3, pb2)
      const bf16x8 pb3 = PACKP(S1, 1);
      __builtin_amdgcn_sched_barrier(0);
      PVMFMA(vb0, vb1, vb2, vb3, pb3)
    }
  }
}

template <bool SAMPLE>
DI void attn_item(const Params& p, int layer, int a, int h, unsigned char* smem) {
  const int t = tid(), l = t & 63, w = t >> 6, rg = w & 1, s = w >> 1, hb = l >> 5, r = l & 31;
  const int hh = 2 * h + s;
  const int qrow0 = SAMPLE ? SEQ + a * 32 : a * 64 + rg * 32;
  const bool active = SAMPLE ? (rg == 0) : true;
  const u16* H = p.H;
  bf16x8 qf[4];
  {
    const u16* qp = H + (size_t)(qrow0 + r) * INW + hh * 64 + hb * 8;
#pragma unroll
    for (int ks = 0; ks < 4; ++ks) qf[ks] = *(const bf16x8*)(qp + ks * 16);
  }
  f32x16 O[4];
#pragma unroll
  for (int dt = 0; dt < 4; ++dt)
#pragma unroll
    for (int i = 0; i < 16; ++i) O[dt][i] = 0.f;
  float m_run = -1e30f, l_run = 0.f;
  f32x16 Mneg;
#pragma unroll
  for (int i = 0; i < 16; ++i) Mneg[i] = 1e30f;
  u16* sm = (u16*)smem;

  __syncthreads();
  if (!SAMPLE) {
    const int ntiles = a + 1;
    const u16* kg = p.Kc + (size_t)h * MTOK * 128;
    const u16* vg = p.Vc + (size_t)h * MTOK * 128;
    const int krow = w * 8 + (l >> 3);
    const unsigned kqo = (unsigned)(krow * 128 + ((l & 7) ^ ((krow >> 1) & 7)) * 8) * 2u;
    const int vrow = w * 4 + (l >> 4);
    const unsigned vqo = (unsigned)(vrow * 128 + ((l & 15) ^ (((l >> 4) & 3) << 2)) * 8) * 2u;
    const unsigned lb = __builtin_amdgcn_readfirstlane(lds_addr(smem) + w * 1024);
#define ATT_STAGE(BUF, KT)                                                                                \
    {                                                                                                     \
      const unsigned sb_ = lb + (BUF) * 32768;                                                            \
      const unsigned ko_ = kqo + (unsigned)(KT) * (64u * 128u * 2u);                                      \
      const unsigned vo_ = vqo + (unsigned)(KT) * (64u * 128u * 2u);                                      \
      glds16s(kg, ko_, sb_); glds16s(kg, ko_ + 32u * 256u, sb_ + 4096);                                   \
      glds16s(kg, ko_ + 128u, sb_ + 8192); glds16s(kg, ko_ + 32u * 256u + 128u, sb_ + 12288);             \
      glds16s(vg, vo_, sb_ + 16384); glds16s(vg, vo_ + 16u * 256u, sb_ + 16384 + 4096);                   \
      glds16s(vg, vo_ + 32u * 256u, sb_ + 16384 + 8192); glds16s(vg, vo_ + 48u * 256u, sb_ + 16384 + 12288); \
    }
    ATT_STAGE(0, 0)
    asm volatile("s_waitcnt vmcnt(0)" ::: "memory");
    __syncthreads();
    for (int kt = 0; kt < ntiles; ++kt) {
      const int buf = kt & 1;
      if (kt + 1 < ntiles) ATT_STAGE(buf ^ 1, kt + 1)
      __builtin_amdgcn_sched_barrier(0);
      const u16* kb = sm + buf * 16384;
      attn_compute<true>(kb, kb + 8192, qf, O, Mneg, m_run, l_run, true, s);
      asm volatile("s_waitcnt vmcnt(0)" ::: "memory");
      __syncthreads();
    }
  } else {
    const float* ck = p.cache_k + ((size_t)(layer * 32 + a) * 1024) * 512 + (2 * h) * 64;
    const float* cv = p.cache_v + ((size_t)(layer * 32 + a) * 1024) * 512 + h * 128;
    for (int j = 0; j < 9; ++j) {
      for (int g = 0; g < 2; ++g) {
        const int kt = 2 * j + g;
        u16* kb = sm + g * (ST_BYTES / 2);
        u16* vb = kb + ST_K;
        if (kt < 16) {
#pragma unroll
          for (int i = 0; i < 8; ++i) {
            const int cc = t + 256 * i;
            const int sh = cc >> 10, key = (cc >> 4) & 63, ch = cc & 15;
            const float4 v = *(const float4*)(ck + (size_t)(kt * 64 + key) * 512 + sh * 64 + ch * 4);
            *(uint2*)(kb + (sh * 64 + key) * KS_STRIDE + ch * 4) = make_uint2(pk(v.x, v.y), pk(v.z, v.w));
            const int vkey = cc >> 5, vch = cc & 31;
            const float4 u = *(const float4*)(cv + (size_t)(kt * 64 + vkey) * 512 + vch * 4);
            *(uint2*)(vb + vkey * VS_STRIDE + vch * 4) = make_uint2(pk(u.x, u.y), pk(u.z, u.w));
          }
        } else if (kt == 16) {
          const u16* kg = p.Kc + ((size_t)h * MTOK + SEQ + a * 32) * 128;
          const u16* vg = p.Vc + ((size_t)h * MTOK + SEQ + a * 32) * 128;
#pragma unroll
          for (int i = 0; i < 2; ++i) {
            const int cc = t + 256 * i;
            const int sh = cc >> 8, key = (cc >> 3) & 31, ch = cc & 7;
            *(uint4*)(kb + (sh * 64 + key) * KS_STRIDE + ch * 8) = *(const uint4*)(kg + (size_t)key * 128 + sh * 64 + ch * 8);
            const int vkey = cc >> 4, vch = cc & 15;
            *(uint4*)(vb + vkey * VS_STRIDE + vch * 8) = *(const uint4*)(vg + (size_t)vkey * 128 + vch * 8);
          }
        }
      }
      __syncthreads();
      {
        const int kt = 2 * j + rg;
        const u16* kb = sm + rg * (ST_BYTES / 2);
        if (kt <= 16) attn_compute<false>(kb, kb + ST_K, qf, O, Mneg, m_run, l_run, kt < 16, s);
      }
      __syncthreads();
    }
    float* mgO = (float*)smem;
    float* mgML = (float*)(smem + 32768);
    if (rg == 1) {
#pragma unroll
      for (int dt = 0; dt < 4; ++dt)
#pragma unroll
        for (int i = 0; i < 16; ++i) mgO[(s * 128 + dt * 32 + crow(i, hb)) * 32 + r] = O[dt][i];
      mgML[(s * 64 + l) * 2] = m_run; mgML[(s * 64 + l) * 2 + 1] = l_run;
    }
    __syncthreads();
    if (rg == 0) {
      const float m1 = mgML[(s * 64 + l) * 2], l1 = mgML[(s * 64 + l) * 2 + 1];
      const float mm = fmaxf(m_run, m1);
      const float a0 = __builtin_amdgcn_exp2f(m_run - mm), a1 = __builtin_amdgcn_exp2f(m1 - mm);
#pragma unroll
      for (int dt = 0; dt < 4; ++dt)
#pragma unroll
        for (int i = 0; i < 16; ++i) O[dt][i] = O[dt][i] * a0 + mgO[(s * 128 + dt * 32 + crow(i, hb)) * 32 + r] * a1;
      l_run = l_run * a0 + l1 * a1;
      m_run = mm;
    }
    __syncthreads();
  }
  const int te = tid(), le = te & 63, re = le & 31, hbe = le >> 5, rge = (te >> 6) & 1, se = te >> 7;
  const bool acte = SAMPLE ? (rge == 0) : true;
  float lt = l_run + __shfl_xor(l_run, 32);
  const float inv_l = 1.f / lt;
  float* ex = (float*)smem;
  if (se == 1 && acte) {
#pragma unroll
    for (int dt = 0; dt < 4; ++dt)
#pragma unroll
      for (int i = 0; i < 16; ++i) ex[(rge * 128 + dt * 32 + crow(i, hbe)) * 32 + re] = O[dt][i] * inv_l;
  }
  __syncthreads();
  if (se == 0 && acte) {
    const float lam = __hip_atomic_load(p.lam + layer, __ATOMIC_RELAXED, __HIP_MEMORY_SCOPE_AGENT);
    const float li = __hip_atomic_load(p.lam + 4 + layer, __ATOMIC_RELAXED, __HIP_MEMORY_SCOPE_AGENT);
    float ss = 0.f;
#pragma unroll
    for (int dt = 0; dt < 4; ++dt)
#pragma unroll
      for (int i = 0; i < 16; ++i) {
        const float o = O[dt][i] * inv_l - lam * ex[(rge * 128 + dt * 32 + crow(i, hbe)) * 32 + re];
        O[dt][i] = o; ss += o * o;
      }
    ss += __shfl_xor(ss, 32);
    const float rs = rsqrtf(ss * (1.f / 128.f) + LN_EPS) * (1.f - li);
    const int row = (SAMPLE ? SEQ + a * 32 : a * 64 + rge * 32) + re;
    const u16* gp = H + (size_t)row * INW + C_GA + h * 128;
    u16* op = p.A1 + (size_t)row * 512 + h * 128;
    const float* sw = p.subln_w + layer * 128;
#pragma unroll
    for (int dt = 0; dt < 4; ++dt)
#pragma unroll
      for (int g4 = 0; g4 < 4; ++g4) {
        const int d = dt * 32 + 8 * g4 + 4 * hbe;
        const uint2 gv = *(const uint2*)(gp + d);
        const float4 wv = *(const float4*)(sw + d);
        const float y0 = O[dt][4 * g4 + 0] * rs * wv.x * siluf_(bflo(gv.x));
        const float y1 = O[dt][4 * g4 + 1] * rs * wv.y * siluf_(bfhi(gv.x));
        const float y2 = O[dt][4 * g4 + 2] * rs * wv.z * siluf_(bflo(gv.y));
        const float y3 = O[dt][4 * g4 + 3] * rs * wv.w * siluf_(bfhi(gv.y));
        *(uint2*)(op + d) = make_uint2(pk(y0, y1), pk(y2, y3));
      }
  }
}

DI void sgu_item(const Params& p, int layer, int chunk, int g, unsigned char* smem) {
  const int t = tid(), l = t & 63, w = t >> 6, wm = w >> 1, wn = w & 1, hb = l >> 5, r = l & 31;
  const int m0 = chunk * 128;
  const bool samp = chunk >= 128;
  u16* Asg = (u16*)smem;
  u16* Bsg = Asg + 128 * 72;
  float* st = (float*)(smem + 38912);
  const u16* H = p.H;
  const float* Wg = p.w_s + ((size_t)(layer * 4 + g) * 128) * 128;
  float4 wv[2][8];
  uint4 bv[2][4], puu[8], pgg[8];
#pragma unroll
  for (int kh = 0; kh < 2; ++kh) {
#pragma unroll
    for (int i8 = 0; i8 < 8; ++i8) {
      const int cc = t + 256 * i8;
      const int i = cc >> 4, j = kh * 64 + (cc & 15) * 4;
      wv[kh][i8] = samp ? *(const float4*)(Wg + (i & 31) * 128 + (j & 31)) : *(const float4*)(Wg + i * 128 + j);
    }
#pragma unroll
    for (int i4 = 0; i4 < 4; ++i4) {
      const int cc = t + 256 * i4;
      bv[kh][i4] = *(const uint4*)(H + (size_t)(m0 + kh * 64 + (cc >> 4)) * INW + C_VG + g * 128 + (cc & 15) * 8);
    }
  }
#pragma unroll
  for (int i = 0; i < 8; ++i) {
    const u16* hp = H + (size_t)(m0 + (t >> 4) + 16 * i) * INW + g * 128 + (t & 15) * 8;
    puu[i] = *(const uint4*)(hp + C_U); pgg[i] = *(const uint4*)(hp + C_GG);
  }
  __syncthreads();
#pragma unroll 8
  for (int rr = 0; rr < 32; ++rr) {
    const int row = w * 32 + rr;
    const uint4 v = *(const uint4*)(H + (size_t)(m0 + row) * INW + C_VG + l * 8);
    float x[8] = {bflo(v.x), bfhi(v.x), bflo(v.y), bfhi(v.y), bflo(v.z), bfhi(v.z), bflo(v.w), bfhi(v.w)};
    float s1 = 0.f, s2 = 0.f;
#pragma unroll
    for (int e = 0; e < 8; ++e) { s1 += x[e]; s2 += x[e] * x[e]; }
#pragma unroll
    for (int o = 32; o >= 1; o >>= 1) { s1 += __shfl_xor(s1, o); s2 += __shfl_xor(s2, o); }
    if (l == 0) {
      const float mean = s1 * (1.f / 512.f);
      const float var = fmaxf(s2 * (1.f / 512.f) - mean * mean, 0.f);
      st[row] = mean; st[128 + row] = rsqrtf(var + LN_EPS);
    }
  }
  __syncthreads();
  f32x16 acc[2][2];
  zero_acc(acc);
  const float* gam = p.sgu_g + layer * 512 + g * 128;
  const float* bet = p.sgu_b + layer * 512 + g * 128;
  const int q4 = (l & 15) >> 2, p4 = l & 3, blk = (l >> 4) & 1;
#pragma unroll
  for (int kh = 0; kh < 2; ++kh) {
#pragma unroll
    for (int i8 = 0; i8 < 8; ++i8) {
      const int cc = t + 256 * i8;
      const int i = cc >> 4, j4 = (cc & 15) * 4, j = kh * 64 + j4;
      const float4 v = wv[kh][i8];
      float e0, e1, e2, e3;
      if (!samp) {
        e0 = (j + 0 <= i) ? v.x : 0.f; e1 = (j + 1 <= i) ? v.y : 0.f; e2 = (j + 2 <= i) ? v.z : 0.f; e3 = (j + 3 <= i) ? v.w : 0.f;
      } else {
        const int i32 = i & 31, j32 = j & 31;
        const bool same = (i >> 5) == (j >> 5);
        e0 = (same && j32 + 0 <= i32) ? v.x : 0.f; e1 = (same && j32 + 1 <= i32) ? v.y : 0.f;
        e2 = (same && j32 + 2 <= i32) ? v.z : 0.f; e3 = (same && j32 + 3 <= i32) ? v.w : 0.f;
      }
      *(uint2*)(Asg + i * 72 + j4) = make_uint2(pk(e0, e1), pk(e2, e3));
    }
#pragma unroll
    for (int i4 = 0; i4 < 4; ++i4) {
      const int cc = t + 256 * i4;
      const int jj = cc >> 4, dc = (cc & 15) * 8;
      const int jrow = kh * 64 + jj;
      const uint4 v = bv[kh][i4];
      const float mean = st[jrow], rstd = st[128 + jrow];
      const float4 g0 = *(const float4*)(gam + dc), g1 = *(const float4*)(gam + dc + 4);
      const float4 b0 = *(const float4*)(bet + dc), b1 = *(const float4*)(bet + dc + 4);
      const float y0 = (bflo(v.x) - mean) * rstd * g0.x + b0.x, y1 = (bfhi(v.x) - mean) * rstd * g0.y + b0.y;
      const float y2 = (bflo(v.y) - mean) * rstd * g0.z + b0.z, y3 = (bfhi(v.y) - mean) * rstd * g0.w + b0.w;
      const float y4 = (bflo(v.z) - mean) * rstd * g1.x + b1.x, y5 = (bfhi(v.z) - mean) * rstd * g1.y + b1.y;
      const float y6 = (bflo(v.w) - mean) * rstd * g1.z + b1.z, y7 = (bfhi(v.w) - mean) * rstd * g1.w + b1.w;
      *(uint4*)(Bsg + jj * VS_STRIDE + dc) = make_uint4(pk(y0, y1), pk(y2, y3), pk(y4, y5), pk(y6, y7));
      if (samp) {
        float* o = p.out + OFF_GV + ((size_t)layer * 1024 + (m0 - SEQ) + jrow) * 512 + g * 128 + dc;
        *(float4*)o = make_float4(y0, y1, y2, y3);
        *(float4*)(o + 4) = make_float4(y4, y5, y6, y7);
      }
    }
    __syncthreads();
    const u16* as = Asg + (wm * 64 + r) * 72 + hb * 8;
    const u16* bs = Bsg + (8 * hb + q4) * VS_STRIDE + wn * 64 + blk * 16 + p4 * 4;
#pragma unroll
    for (int ks = 0; ks < 4; ++ks) {
      bf16x8 a0 = *(const bf16x8*)(as + ks * 16), a1 = *(const bf16x8*)(as + 32 * 72 + ks * 16);
      const u16* bk = bs + ks * 16 * VS_STRIDE;
      bf16x8 b0 = cat8(tr_read(bk), tr_read(bk + 4 * VS_STRIDE));
      bf16x8 b1 = cat8(tr_read(bk + 32), tr_read(bk + 4 * VS_STRIDE + 32));
      acc[0][0] = MFMA(a0, b0, acc[0][0]); acc[0][1] = MFMA(a0, b1, acc[0][1]);
      acc[1][0] = MFMA(a1, b0, acc[1][0]); acc[1][1] = MFMA(a1, b1, acc[1][1]);
    }
    __syncthreads();
  }
  const float* bsp = p.b_s + (size_t)(layer * 4 + g) * 128;
  acc_to_lds(acc, smem);
  __syncthreads();
  {
    const float* ct = (const float*)smem;
    const int c8 = (t & 15) * 8;
#pragma unroll
    for (int i = 0; i < 8; ++i) {
      const int rl = (t >> 4) + 16 * i;
      const int row = m0 + rl;
      const float* cp = ct + rl * CT_STRIDE + c8;
      const float4 v0 = *(const float4*)cp, v1 = *(const float4*)(cp + 4);
      const float bias = bsp[samp ? (rl & 31) : rl];
      const uint4 uu = puu[i], gg = pgg[i];
      float4 o0, o1;
      o0.x = (v0.x + bias) * bflo(uu.x) * siluf_(bflo(gg.x)); o0.y = (v0.y + bias) * bfhi(uu.x) * siluf_(bfhi(gg.x));
      o0.z = (v0.z + bias) * bflo(uu.y) * siluf_(bflo(gg.y)); o0.w = (v0.w + bias) * bfhi(uu.y) * siluf_(bfhi(gg.y));
      o1.x = (v1.x + bias) * bflo(uu.z) * siluf_(bflo(gg.z)); o1.y = (v1.y + bias) * bfhi(uu.z) * siluf_(bfhi(gg.z));
      o1.z = (v1.z + bias) * bflo(uu.w) * siluf_(bflo(gg.w)); o1.w = (v1.w + bias) * bfhi(uu.w) * siluf_(bfhi(gg.w));
      *(uint4*)(p.A2 + (size_t)row * 512 + g * 128 + c8) = pack8(o0, o1);
    }
  }
}

DI void phaseB(const Params& p, int layer_slot, unsigned char* smem) {
  const int layer = layer_slot & 3;
  int* s_item = (int*)(smem + 77824);
  const bool stat = gridDim.x == 512;
  const int sq = 2 * (blockIdx.x >> 3) + ((blockIdx.x >> 2) & 1), sh = blockIdx.x & 3;
  const int total = stat ? 672 : 1696;
  for (int n = 0;; ++n) {
    int kind, a, h;
    if (stat && n < 2) { kind = 1; a = n ? sq : 255 - sq; h = sh; }
    else {
      __syncthreads();
      if (threadIdx.x == 0) *s_item = atomicAdd(p.counters + layer_slot, 1);
      __syncthreads();
      const int it = *s_item;
      if (it >= total) break;
      if (it < 128) { kind = 0; a = it >> 2; h = it & 3; }
      else if (it < 672) { kind = 2; a = (it - 128) >> 2; h = (it - 128) & 3; }
      else { kind = 1; a = 255 - ((it - 672) >> 2); h = (it - 672) & 3; }
    }
    if (kind == 0) attn_item<true>(p, layer, a, h, smem);
    else if (kind == 1) attn_item<false>(p, layer, a, h, smem);
    else sgu_item(p, layer, a, h, smem);
  }
}

DI void phaseC1_tile(const Params& p, int layer, int mt, int nt, unsigned char* smem) {
  const int t = tid();
  const int c8 = (t & 15) * 8;
  const float* ct = (const float*)smem;
  f32x16 acc[2][2];
  uint4 ya[8], gma[8], gmb[8];
#pragma unroll
  for (int i = 0; i < 8; ++i) {
    const u16* hp = p.H + (size_t)(mt * 128 + (t >> 4) + 16 * i) * INW + nt * 128 + c8;
    gma[i] = *(const uint4*)(hp + C_MA); gmb[i] = *(const uint4*)(hp + C_MB);
  }
  zero_acc(acc);
  gemm_core(p.A1 + (size_t)mt * 128 * 512, 512, p.WoaT + ((size_t)layer * 1024 + nt * 128) * 512, 512, 512, acc, smem);
  acc_to_lds(acc, smem);
  __syncthreads();
#pragma unroll
  for (int i = 0; i < 8; ++i) {
    const int rl = (t >> 4) + 16 * i;
    const int row = mt * 128 + rl;
    const float* cp = ct + rl * CT_STRIDE + c8;
    const float4 v0 = *(const float4*)cp, v1 = *(const float4*)(cp + 4);
    const uint4 g = gma[i];
    ya[i] = make_uint4(pk(v0.x * sigmoidf_(bflo(g.x)), v0.y * sigmoidf_(bfhi(g.x))), pk(v0.z * sigmoidf_(bflo(g.y)), v0.w * sigmoidf_(bfhi(g.y))),
                       pk(v1.x * sigmoidf_(bflo(g.z)), v1.y * sigmoidf_(bfhi(g.z))), pk(v1.z * sigmoidf_(bflo(g.w)), v1.w * sigmoidf_(bfhi(g.w))));
  }
  zero_acc(acc);
  gemm_core(p.A2 + (size_t)mt * 128 * 512, 512, p.WogT + ((size_t)layer * 1024 + nt * 128) * 512, 512, 512, acc, smem);
  acc_to_lds(acc, smem);
  __syncthreads();
#pragma unroll
  for (int i = 0; i < 8; ++i) {
    const int rl = (t >> 4) + 16 * i;
    const int row = mt * 128 + rl;
    const float* cp = ct + rl * CT_STRIDE + c8;
    const float4 v0 = *(const float4*)cp, v1 = *(const float4*)(cp + 4);
    const uint4 g = gmb[i];
    float4 o0, o1;
    const float4 ma0 = make_float4(bflo(ya[i].x), bfhi(ya[i].x), bflo(ya[i].y), bfhi(ya[i].y));
    const float4 ma1 = make_float4(bflo(ya[i].z), bfhi(ya[i].z), bflo(ya[i].w), bfhi(ya[i].w));
    o0.x = ma0.x + v0.x * sigmoidf_(bflo(g.x)); o0.y = ma0.y + v0.y * sigmoidf_(bfhi(g.x));
    o0.z = ma0.z + v0.z * sigmoidf_(bflo(g.y)); o0.w = ma0.w + v0.w * sigmoidf_(bfhi(g.y));
    o1.x = ma1.x + v1.x * sigmoidf_(bflo(g.z)); o1.y = ma1.y + v1.y * sigmoidf_(bfhi(g.z));
    o1.z = ma1.z + v1.z * sigmoidf_(bflo(g.w)); o1.w = ma1.w + v1.w * sigmoidf_(bfhi(g.w));
    *(uint4*)(p.Mg + (size_t)row * 1024 + nt * 128 + c8) = pack8(o0, o1);
  }
}

DI void phaseC2_tile(const Params& p, int layer, int mt, int nt, unsigned char* smem) {
  const int t = tid();
  const int c8 = (t & 15) * 8;
  const float* ct = (const float*)smem;
  const float* xsrc = layer == 0 ? (mt < 128 ? p.x_prompt : p.x_sample - (size_t)SEQ * 1024) : p.Xf;
  float4 xr0[8], xr1[8];
#pragma unroll
  for (int i = 0; i < 8; ++i) {
    const float* xp = xsrc + (size_t)(mt * 128 + (t >> 4) + 16 * i) * 1024 + nt * 128 + c8;
    xr0[i] = *(const float4*)xp; xr1[i] = *(const float4*)(xp + 4);
  }
  f32x16 acc[2][2];
  zero_acc(acc);
  gemm_core(p.Mg + (size_t)mt * 128 * 1024, 1024, p.WoutT + ((size_t)layer * 1024 + nt * 128) * 1024, 1024, 1024, acc, smem);
  acc_to_lds(acc, smem);
  __syncthreads();
#pragma unroll
  for (int i = 0; i < 8; ++i) {
    const int rl = (t >> 4) + 16 * i;
    const int row = mt * 128 + rl;
    const float* cp = ct + rl * CT_STRIDE + c8;
    const float4 v0 = *(const float4*)cp, v1 = *(const float4*)(cp + 4);
    const float4 x0 = xr0[i], x1 = xr1[i];
    float* op = p.Xpre + (size_t)row * 1024 + nt * 128 + c8;
    *(float4*)op = make_float4(ALPHA_RES * x0.x + v0.x, ALPHA_RES * x0.y + v0.y, ALPHA_RES * x0.z + v0.z, ALPHA_RES * x0.w + v0.w);
    *(float4*)(op + 4) = make_float4(ALPHA_RES * x1.x + v1.x, ALPHA_RES * x1.y + v1.y, ALPHA_RES * x1.z + v1.z, ALPHA_RES * x1.w + v1.w);
  }
}

DI void phaseLN(const Params& p, int layer) {
  const int t = tid(), l = t & 63, w = t >> 6;
  const float* g = p.ln_g + layer * 1024;
  const float* b = p.ln_b + layer * 1024;
  float* dstf = layer == 3 ? p.out : p.Xf;
  for (int row = blockIdx.x * 4 + w; row < MTOK; row += gridDim.x * 4) {
    const float* src = p.Xpre + (size_t)row * 1024;
    float4 v[4];
    float s1 = 0.f;
#pragma unroll
    for (int i = 0; i < 4; ++i) { v[i] = *(const float4*)(src + i * 256 + l * 4); s1 += v[i].x + v[i].y + v[i].z + v[i].w; }
#pragma unroll
    for (int o = 32; o >= 1; o >>= 1) s1 += __shfl_xor(s1, o);
    const float mean = s1 * (1.f / 1024.f);
    float s2 = 0.f;
#pragma unroll
    for (int i = 0; i < 4; ++i) {
      v[i].x -= mean; v[i].y -= mean; v[i].z -= mean; v[i].w -= mean;
      s2 += v[i].x * v[i].x + v[i].y * v[i].y + v[i].z * v[i].z + v[i].w * v[i].w;
    }
#pragma unroll
    for (int o = 32; o >= 1; o >>= 1) s2 += __shfl_xor(s2, o);
    const float rstd = rsqrtf(s2 * (1.f / 1024.f) + LN_EPS);
#pragma unroll
    for (int i = 0; i < 4; ++i) {
      const int c = i * 256 + l * 4;
      const float4 gv = *(const float4*)(g + c), bv = *(const float4*)(b + c);
      const float y0 = v[i].x * rstd * gv.x + bv.x, y1 = v[i].y * rstd * gv.y + bv.y;
      const float y2 = v[i].z * rstd * gv.z + bv.z, y3 = v[i].w * rstd * gv.w + bv.w;
      *(float4*)(dstf + (size_t)row * 1024 + c) = make_float4(y0, y1, y2, y3);
      if (layer < 3) *(uint2*)(p.Xb + (size_t)row * 1024 + c) = make_uint2(pk(y0, y1), pk(y2, y3));
    }
  }
}

__global__ void __launch_bounds__(256, 2) fwd_megakernel(Params p) {
  __shared__ __attribute__((aligned(16))) unsigned char smem[SMEM_BYTES];
  __shared__ uint4 xb_words;
  cg::grid_group grid = cg::this_grid();
  if (threadIdx.x == 0) xb_words = make_uint4(0u, 0u, 0u, 0u);
  __syncthreads();
  XcdBarrier xb = xcd_barrier_post(p.bar, (volatile LAS unsigned*)&xb_words);
  for (int ph = p.ph_lo; ph < p.ph_hi; ++ph) {
    if (ph == 0) {
      phase0(p, smem);
    } else {
      const int layer = (ph - 1) / 5, sub = (ph - 1) % 5;
      const int nrep = (sub == PROBE_REP || (PROBE_REP == 6 && sub >= 2)) ? 2 : 1;
      for (int rep = 0; rep < nrep; ++rep) {
        if (rep) xcd_barrier(xb);
        if (sub == 0) {
          for (int tix = blockIdx.x; tix < 136 * 22; tix += gridDim.x) phaseA_tile(p, layer, tix / 22, tix % 22, smem);
        } else if (sub == 1) {
          phaseB(p, layer + 4 * rep, smem);
        } else if (sub == 2) {
          for (int tix = blockIdx.x; tix < 136 * 8; tix += gridDim.x) phaseC1_tile(p, layer, tix >> 3, tix & 7, smem);
        } else if (sub == 3) {
          for (int tix = blockIdx.x; tix < 136 * 8; tix += gridDim.x) phaseC2_tile(p, layer, tix >> 3, tix & 7, smem);
        } else {
          phaseLN(p, layer);
        }
      }
    }
    if (PROBE_REP == 5 && ph + 1 < p.ph_hi) xcd_barrier(xb);
    if (ph + 1 < p.ph_hi) { if (p.ph_hi < 0) grid.sync(); else xcd_barrier(xb); }
  }
}

extern "C" void kernel_launch(void* const* d_in, const int* in_sizes, int n_in, void* d_out, int out_size, void* d_ws, size_t ws_size, hipStream_t stream) {
  static int grid_blocks = 0;
  if (!grid_blocks) {
    int dev = 0, cus = 0, per_cu = 0;
    hipGetDevice(&dev);
    hipDeviceGetAttribute(&cus, hipDeviceAttributeMultiprocessorCount, dev);
    hipOccupancyMaxActiveBlocksPerMultiprocessor(&per_cu, fwd_megakernel, 256, 0);
    if (per_cu < 1) per_cu = 1;
    if (per_cu > 2) per_cu = 2;
    grid_blocks = cus * per_cu;
  }
  Params p{};
  const float** ins = (const float**)&p;
  for (int i = 0; i < 19; ++i) ins[i] = (const float*)d_in[i];
  p.out = (float*)d_out;
  unsigned char* ws = (unsigned char*)d_ws;
  size_t off = 0;
  auto take = [&](size_t bytes) { unsigned char* q = ws + off; off += (bytes + 255) & ~(size_t)255; return q; };
  p.WinT = (u16*)take((size_t)4 * 5632 * 1024 * 2);
  p.WoaT = (u16*)take((size_t)4 * 1024 * 512 * 2);
  p.WogT = (u16*)take((size_t)4 * 1024 * 512 * 2);
  p.WoutT = (u16*)take((size_t)4 * 1024 * 1024 * 2);
  p.Xb = (u16*)take((size_t)MTOK * 1024 * 2);
  p.H = (u16*)take((size_t)MTOK * INW * 2);
  p.A1 = (u16*)take((size_t)MTOK * 512 * 2);
  p.A2 = (u16*)take((size_t)MTOK * 512 * 2);
  p.Mg = (u16*)take((size_t)MTOK * 1024 * 2);
  p.Kc = (u16*)take((size_t)4 * MTOK * 128 * 2);
  p.Vc = (u16*)take((size_t)4 * MTOK * 128 * 2);
  p.Xf = (float*)take((size_t)MTOK * 1024 * 4);
  p.Xpre = (float*)take((size_t)MTOK * 1024 * 4);
  p.rope = (float*)take((size_t)SEQ * 32 * 2 * 4);
  p.lam = (float*)take(256);
  p.counters = (int*)take(256);
  p.bar = (unsigned*)take(XCD_BAR_WORDS * 4);
  hipMemsetAsync(p.bar, 0, XCD_BAR_WORDS * 4, stream);
#if MULTI_LAUNCH
  for (int ph = 0; ph < 21; ++ph) {
    p.ph_lo = ph; p.ph_hi = ph + 1;
    hipLaunchKernelGGL(fwd_megakernel, dim3(grid_blocks), dim3(256), 0, stream, p);
  }
#else
  p.ph_lo = 0; p.ph_hi = 21;
  void* args[] = {&p};
  hipError_t e = hipLaunchCooperativeKernel((void*)fwd_megakernel, dim3(grid_blocks), dim3(256), args, 0, stream);
  if (e != hipSuccess) fprintf(stderr, "cooperative launch failed: %s (grid %d)\n", hipGetErrorString(e), grid_blocks);
#endif
}
```

```cpp
#include <hip/hip_runtime.h>
#include <hip/hip_cooperative_groups.h>
#include <cstdio>
namespace cg = cooperative_groups;

#ifndef PROBE_REP
#define PROBE_REP -1
#endif
#ifndef MULTI_LAUNCH
#define MULTI_LAUNCH 0
#endif

#define DI __device__ __forceinline__
typedef unsigned short u16;
typedef __attribute__((ext_vector_type(8))) short bf16x8;
typedef __attribute__((ext_vector_type(4))) short s16x4;
typedef __attribute__((ext_vector_type(16))) float f32x16;
typedef __attribute__((ext_vector_type(2))) float f32x2;
typedef __attribute__((ext_vector_type(2))) __bf16 bf16x2_t;

constexpr int SEQ = 16384, MTOK = 17408, INW = 5632;
constexpr int C_K = 512, C_V = 1024, C_GA = 1536, C_U = 2048, C_VG = 2560, C_GG = 3072, C_MA = 3584, C_MB = 4608;
constexpr size_t OFF_KP = 17825792, OFF_VP = 51380224, OFF_KS = 84934656, OFF_VS = 87031808, OFF_GV = 89128960;
constexpr int SMEM_BYTES = 77824 + 64;
constexpr float ALPHA_RES = 1.681792830507429f;
constexpr float LN_EPS = 1e-5f;

struct Params {
  const float *x_prompt, *x_sample, *cache_k, *cache_v, *w_in, *w_oa, *w_og, *w_out;
  const float *lq1, *lk1, *lq2, *lk2, *subln_w, *sgu_g, *sgu_b, *w_s, *b_s, *ln_g, *ln_b;
  float* out;
  u16 *WinT, *WoaT, *WogT, *WoutT, *Xb, *H, *A1, *A2, *Mg, *Kc, *Vc;
  float *Xf, *Xpre, *rope, *lam;
  int* counters;
  unsigned* bar;
  int ph_lo, ph_hi;
};

DI unsigned pk(float a, float b) { f32x2 x = {a, b}; bf16x2_t y = __builtin_convertvector(x, bf16x2_t); return __builtin_bit_cast(unsigned, y); }
DI u16 f2bf(float a) { return (u16)(pk(a, 0.f) & 0xffffu); }
DI float bf2f(u16 h) { return __uint_as_float(((unsigned)h) << 16); }
DI float bflo(unsigned u) { return __uint_as_float(u << 16); }
DI float bfhi(unsigned u) { return __uint_as_float(u & 0xffff0000u); }
DI int tid() { int t = threadIdx.x; asm volatile("" : "+v"(t)); return t; }
DI int crow(int i, int hb) { return (i & 3) + 8 * (i >> 2) + 4 * hb; }
DI float sigmoidf_(float x) { return __builtin_amdgcn_rcpf(1.f + __expf(-x)); }
DI float siluf_(float x) { return x * __builtin_amdgcn_rcpf(1.f + __expf(-x)); }
#define MFMA(a, b, c) __builtin_amdgcn_mfma_f32_32x32x16_bf16((a), (b), (c), 0, 0, 0)
typedef __attribute__((address_space(3))) s16x4 lds_s16x4;
typedef __attribute__((address_space(3))) unsigned lds_u32;
DI void glds16(const void* g, unsigned lds_base) {
  unsigned sv;
  asm volatile("s_mov_b32 %0, m0\n\ts_mov_b32 m0, %2\n\ts_nop 0\n\tglobal_load_lds_dwordx4 %1, off\n\ts_mov_b32 m0, %0" : "=&s"(sv) : "v"(g), "s"(lds_base) : "memory");
}
DI void glds16s(const void* sbase, unsigned voff, unsigned lds_base) {
  unsigned sv;
  asm volatile("s_mov_b32 %0, m0\n\ts_mov_b32 m0, %3\n\ts_nop 0\n\tglobal_load_lds_dwordx4 %1, %2\n\ts_mov_b32 m0, %0" : "=&s"(sv) : "v"(voff), "s"(sbase), "s"(lds_base) : "memory");
}
DI unsigned lds_addr(const void* p) { return (unsigned)(size_t)(__attribute__((address_space(3))) const unsigned char*)p; }
DI s16x4 tr_read(const u16* p) { return __builtin_amdgcn_ds_read_tr16_b64_v4i16((lds_s16x4*)p); }
DI bf16x8 cat8(s16x4 lo, s16x4 hi) { return __builtin_shufflevector(lo, hi, 0, 1, 2, 3, 4, 5, 6, 7); }


#define XB_TMO      128
#define XB_XCNT(j)  (256  + 64 * (j))
#define XB_XSUB(j)  (1280 + 64 * (j))
#define XB_XGEN(j)  (2304 + 64 * (j))
#define XB_TOP      3328
#define XB_TOPGEN   3392
#define XCD_BAR_WORDS 3456
#define XB_SPIN_CAP (1u << 24)
#define LAS __attribute__((address_space(3)))
DI unsigned xb_ld(unsigned* p)              { return __hip_atomic_load(p, __ATOMIC_RELAXED, __HIP_MEMORY_SCOPE_AGENT); }
DI unsigned xb_add(unsigned* p, unsigned v) { return __hip_atomic_fetch_add(p, v, __ATOMIC_RELAXED, __HIP_MEMORY_SCOPE_AGENT); }
DI unsigned xb_xcc_id() { return (unsigned)__builtin_amdgcn_s_getreg((3 << 11) | 20) & 0xFu; }
#define XB_SPIN(cond, bar) do { unsigned _sp = 0; while (cond) { __builtin_amdgcn_s_sleep(1); \
    if ((++_sp & 255u) == 0u) { if (xb_ld(&(bar)[XB_TMO])) break; if (_sp > XB_SPIN_CAP) { atomicAdd(&(bar)[XB_TMO], 1u); break; } } } } while (0)
struct XcdBarrier { unsigned* bar; unsigned x; volatile LAS unsigned* st; };
DI XcdBarrier xcd_barrier_post(unsigned* bar, volatile LAS unsigned* st) {
  XcdBarrier b; b.bar = bar; b.x = xb_xcc_id(); b.st = st;
  if (threadIdx.x == 0) (void)xb_add(&bar[XB_XCNT(b.x)], 1u);
  return b;
}
DI void xcd_barrier_complete(unsigned* bar, unsigned x, unsigned& nloc, unsigned& nx) {
  const unsigned G = gridDim.x * gridDim.y * gridDim.z;
  unsigned sum, cnt, mine, sp = 0u;
  for (;;) {
    sum = 0u; cnt = 0u; mine = 0u;
#pragma unroll
    for (unsigned j = 0; j < 16; ++j) { const unsigned c = xb_ld(&bar[XB_XCNT(j)]); sum += c; cnt += (c > 0u) ? 1u : 0u; mine = (j == x) ? c : mine; }
    if (sum == G) break;
    __builtin_amdgcn_s_sleep(1);
    if ((++sp & 255u) == 0u) { if (xb_ld(&bar[XB_TMO])) break; if (sp > XB_SPIN_CAP) { atomicAdd(&bar[XB_TMO], 1u); break; } }
  }
  nloc = mine > 0u ? mine : 1u; nx = cnt > 0u ? cnt : 1u;
}
DI void xcd_barrier(const XcdBarrier& b) {
  asm volatile("s_waitcnt vmcnt(0)" ::: "memory");
  __syncthreads();
  if (threadIdx.x == 0) {
    unsigned* bar = b.bar;
    __builtin_amdgcn_s_waitcnt(0);
    unsigned nloc = b.st[0], nx = b.st[1];
    if (nloc == 0u) { xcd_barrier_complete(bar, b.x, nloc, nx); b.st[0] = nloc; b.st[1] = nx; }
    const unsigned old = xb_add(&bar[XB_XSUB(b.x)], 1u);
    const unsigned gen = old / nloc;
    if (old + 1u == (gen + 1u) * nloc) {
      __builtin_amdgcn_fence(__ATOMIC_RELEASE, "agent");
      asm volatile("s_waitcnt vmcnt(0)" ::: "memory");
      const unsigned og = xb_add(&bar[XB_TOP], 1u);
      const unsigned tg = og / nx;
      if (og + 1u == (tg + 1u) * nx) xb_add(&bar[XB_TOPGEN], 1u);
      else XB_SPIN(xb_ld(&bar[XB_TOPGEN]) == tg, bar);
      __builtin_amdgcn_fence(__ATOMIC_ACQUIRE, "agent");
      xb_add(&bar[XB_XGEN(b.x)], 1u);
      asm volatile("s_waitcnt vmcnt(0)" ::: "memory");
    } else {
      XB_SPIN(xb_ld(&bar[XB_XGEN(b.x)]) == gen, bar);
      __builtin_amdgcn_fence(__ATOMIC_ACQUIRE, "agent");
      asm volatile("s_waitcnt vmcnt(0)" ::: "memory");
    }
  }
  __syncthreads();
}

DI void gemm_core(const u16* __restrict__ A, int lda, const u16* __restrict__ Bt, int ldb, int K,
                  f32x16 (&acc)[2][2], unsigned char* smem) {
  const int t = tid(), l = t & 63, w = t >> 6, wm = w >> 1, wn = w & 1, hb = l >> 5, r = l & 31;
  const int grow = w * 8 + (l >> 3);
  const int gch = (l & 7) ^ ((grow >> 1) & 7);
  const u16* ag = A + (size_t)grow * lda + gch * 8;
  const u16* bg = Bt + (size_t)grow * ldb + gch * 8;
  const unsigned lbase = __builtin_amdgcn_readfirstlane(lds_addr(smem) + w * 1024);
#define GM_STAGE(BUF, KO)                                                                                        \
  {                                                                                                              \
    const unsigned sa_ = lbase + (BUF) * 32768;                                                                  \
    _Pragma("unroll") for (int i = 0; i < 4; ++i) {                                                              \
      glds16(ag + (size_t)(32 * i) * lda + (KO), sa_ + i * 4096);                                                \
      glds16(bg + (size_t)(32 * i) * ldb + (KO), sa_ + 16384 + i * 4096);                                        \
    }                                                                                                            \
  }
  __syncthreads();
  GM_STAGE(0, 0)
  asm volatile("s_waitcnt vmcnt(0)" ::: "memory");
  __syncthreads();
  const int sw = (r >> 1) & 7;
  const int o0 = ((0 + hb) ^ sw) * 8, o1 = ((2 + hb) ^ sw) * 8, o2 = ((4 + hb) ^ sw) * 8, o3 = ((6 + hb) ^ sw) * 8;
  const int nk = K >> 6;
  for (int kt = 0; kt < nk; ++kt) {
    const int buf = kt & 1;
    if (kt + 1 < nk) GM_STAGE(buf ^ 1, (kt + 1) * 64)
    __builtin_amdgcn_sched_barrier(0);
    const u16* as = (const u16*)(smem + buf * 32768) + (wm * 64 + r) * 64;
    const u16* bs = (const u16*)(smem + buf * 32768 + 16384) + (wn * 64 + r) * 64;
#define GM_LDF(A0, A1, B0, B1, OFF)                                                       \
    A0 = *(const bf16x8*)(as + (OFF)); A1 = *(const bf16x8*)(as + 32 * 64 + (OFF));       \
    B0 = *(const bf16x8*)(bs + (OFF)); B1 = *(const bf16x8*)(bs + 32 * 64 + (OFF));
#define GM_MM(A0, A1, B0, B1)                                                             \
    acc[0][0] = MFMA(A0, B0, acc[0][0]); acc[0][1] = MFMA(A0, B1, acc[0][1]);             \
    acc[1][0] = MFMA(A1, B0, acc[1][0]); acc[1][1] = MFMA(A1, B1, acc[1][1]);
    {
      bf16x8 xa0, xa1, xb0, xb1, ya0, ya1, yb0, yb1;
      GM_LDF(xa0, xa1, xb0, xb1, o0)
      GM_LDF(ya0, ya1, yb0, yb1, o1)
      __builtin_amdgcn_sched_barrier(0);
      GM_MM(xa0, xa1, xb0, xb1)
      __builtin_amdgcn_sched_barrier(0);
      GM_LDF(xa0, xa1, xb0, xb1, o2)
      __builtin_amdgcn_sched_barrier(0);
      GM_MM(ya0, ya1, yb0, yb1)
      __builtin_amdgcn_sched_barrier(0);
      GM_LDF(ya0, ya1, yb0, yb1, o3)
      __builtin_amdgcn_sched_barrier(0);
      GM_MM(xa0, xa1, xb0, xb1)
      __builtin_amdgcn_sched_barrier(0);
      GM_MM(ya0, ya1, yb0, yb1)
    }
    asm volatile("s_waitcnt vmcnt(0)" ::: "memory");
    __syncthreads();
  }
}


DI void gemm_core_wide(const u16* __restrict__ A, int lda, const u16* __restrict__ Bt, int ldb, int K,
                       f32x16 (&acc)[2][4], unsigned char* smem) {
  const int t = tid(), l = t & 63, w = t >> 6, wm = w >> 1, wn = w & 1, hb = l >> 5, r = l & 31;
  const int grow = w * 16 + (l >> 2);
  const int gch = (l & 3) ^ ((l >> 4) & 3);
  const u16* ag = A + (size_t)grow * lda + gch * 8;
  const u16* bg = Bt + (size_t)grow * 32 + gch * 8;
  const unsigned lbase = __builtin_amdgcn_readfirstlane(lds_addr(smem) + w * 1024);
#define GW_STAGE(SLOT, KO)                                                                  \
  {                                                                                         \
    const unsigned sa_ = lbase + (SLOT) * 24576;                                            \
    glds16(ag + (KO), sa_);                                                                 \
    glds16(ag + (size_t)64 * lda + (KO), sa_ + 4096);                                       \
    glds16(bg + (size_t)(KO) * ldb, sa_ + 8192);                                            \
    glds16(bg + (size_t)(KO) * ldb + 64 * 32, sa_ + 8192 + 4096);                           \
    glds16(bg + (size_t)(KO) * ldb + 128 * 32, sa_ + 8192 + 8192);                          \
    glds16(bg + (size_t)(KO) * ldb + 192 * 32, sa_ + 8192 + 12288);                         \
  }
  __syncthreads();
  GW_STAGE(0, 0)
  GW_STAGE(1, 32)
  const int sw = (r >> 2) & 3;
  const int o0 = ((0 + hb) ^ sw) * 8, o1 = ((2 + hb) ^ sw) * 8;
  const int nk = K >> 5;
  int slot = 0;
  for (int kt = 0; kt < nk; ++kt) {
    if (kt + 1 < nk) asm volatile("s_waitcnt vmcnt(6)" ::: "memory"); else asm volatile("s_waitcnt vmcnt(0)" ::: "memory");
    __syncthreads();
    if (kt + 2 < nk) { const int s2 = slot >= 1 ? slot - 1 : 2; GW_STAGE(s2, (kt + 2) * 32) }
    __builtin_amdgcn_sched_barrier(0);
    const u16* as = (const u16*)(smem + slot * 24576) + (wm * 64 + r) * 32;
    const u16* bs = (const u16*)(smem + slot * 24576 + 8192) + (wn * 128 + r) * 32;
    {
      bf16x8 a0 = *(const bf16x8*)(as + o0), a1 = *(const bf16x8*)(as + 32 * 32 + o0);
      bf16x8 b0 = *(const bf16x8*)(bs + o0), b1 = *(const bf16x8*)(bs + 32 * 32 + o0);
      bf16x8 b2 = *(const bf16x8*)(bs + 64 * 32 + o0), b3 = *(const bf16x8*)(bs + 96 * 32 + o0);
      bf16x8 c0 = *(const bf16x8*)(as + o1), c1 = *(const bf16x8*)(as + 32 * 32 + o1);
      bf16x8 d0 = *(const bf16x8*)(bs + o1), d1 = *(const bf16x8*)(bs + 32 * 32 + o1);
      bf16x8 d2 = *(const bf16x8*)(bs + 64 * 32 + o1), d3 = *(const bf16x8*)(bs + 96 * 32 + o1);
      acc[0][0] = MFMA(a0, b0, acc[0][0]); acc[0][1] = MFMA(a0, b1, acc[0][1]); acc[0][2] = MFMA(a0, b2, acc[0][2]); acc[0][3] = MFMA(a0, b3, acc[0][3]);
      acc[1][0] = MFMA(a1, b0, acc[1][0]); acc[1][1] = MFMA(a1, b1, acc[1][1]); acc[1][2] = MFMA(a1, b2, acc[1][2]); acc[1][3] = MFMA(a1, b3, acc[1][3]);
      acc[0][0] = MFMA(c0, d0, acc[0][0]); acc[0][1] = MFMA(c0, d1, acc[0][1]); acc[0][2] = MFMA(c0, d2, acc[0][2]); acc[0][3] = MFMA(c0, d3, acc[0][3]);
      acc[1][0] = MFMA(c1, d0, acc[1][0]); acc[1][1] = MFMA(c1, d1, acc[1][1]); acc[1][2] = MFMA(c1, d2, acc[1][2]); acc[1][3] = MFMA(c1, d3, acc[1][3]);
    }
    slot = slot == 2 ? 0 : slot + 1;
  }
}

constexpr int CT_STRIDE = 132;
DI void acc_to_lds(const f32x16 (&acc)[2][2], unsigned char* smem) {
  const int t = tid(), l = t & 63, w = t >> 6, wm = w >> 1, wn = w & 1, hb = l >> 5, r = l & 31;
  float* base = (float*)smem + (wm * 64 + 4 * hb) * CT_STRIDE + wn * 64 + r;
#pragma unroll
  for (int tm = 0; tm < 2; ++tm)
#pragma unroll
    for (int tn = 0; tn < 2; ++tn)
#pragma unroll
      for (int i = 0; i < 16; ++i) base[(tm * 32 + (i & 3) + 8 * (i >> 2)) * CT_STRIDE + tn * 32] = acc[tm][tn][i];
}
typedef __attribute__((ext_vector_type(4))) float f32x4_t;
DI void nt_store4(float* p, const float4& v) { f32x4_t x = {v.x, v.y, v.z, v.w}; __builtin_nontemporal_store(x, (f32x4_t*)p); }
DI uint4 pack8(const float4& a, const float4& b) { return make_uint4(pk(a.x, a.y), pk(a.z, a.w), pk(b.x, b.y), pk(b.z, b.w)); }

DI void zero_acc(f32x16 (&acc)[2][2]) {
#pragma unroll
  for (int a = 0; a < 2; ++a)
#pragma unroll
    for (int b = 0; b < 2; ++b)
#pragma unroll
      for (int i = 0; i < 16; ++i) acc[a][b][i] = 0.f;
}

DI void transpose_tile(const float* __restrict__ src, u16* __restrict__ dst, int K, int N, int kt, int nt, unsigned char* smem) {
  float* tile = (float*)smem;
  const int t = tid();
  __syncthreads();
#pragma unroll
  for (int i = 0; i < 4; ++i) {
    const int row = (t >> 4) + 16 * i, c4 = (t & 15) * 4;
    const float4 v = *(const float4*)(src + (size_t)(kt * 64 + row) * N + nt * 64 + c4);
    tile[row * 65 + c4 + 0] = v.x; tile[row * 65 + c4 + 1] = v.y; tile[row * 65 + c4 + 2] = v.z; tile[row * 65 + c4 + 3] = v.w;
  }
  __syncthreads();
  const int n = t >> 2, kseg = (t & 3) * 16;
  unsigned o[8];
#pragma unroll
  for (int e = 0; e < 8; ++e) o[e] = pk(tile[(kseg + 2 * e) * 65 + n], tile[(kseg + 2 * e + 1) * 65 + n]);
  u16* d = dst + (size_t)(nt * 64 + n) * K + kt * 64 + kseg;
  *(uint4*)d = make_uint4(o[0], o[1], o[2], o[3]);
  *(uint4*)(d + 8) = make_uint4(o[4], o[5], o[6], o[7]);
}

__device__ const float ROPE_INV[32] = {1.0f, 0.749894202f, 0.562341332f, 0.421696514f, 0.316227764f, 0.237137377f, 0.177827939f, 0.133352146f, 0.100000001f, 0.0749894232f, 0.0562341325f, 0.0421696492f, 0.0316227749f, 0.0237137377f, 0.0177827943f, 0.013335214f, 0.00999999978f, 0.00749894232f, 0.00562341325f, 0.00421696482f, 0.00316227763f, 0.00237137382f, 0.00177827943f, 0.00133352145f, 0.00100000005f, 0.000749894185f, 0.000562341302f, 0.000421696517f, 0.000316227757f, 0.00023713737f, 0.00017782794f, 0.00013335215f};

DI void phase0(const Params& p, unsigned char* smem) {
  const int t = tid();
  if (blockIdx.x == 0) {
    if (t < 4) {
      float s1 = 0.f, s2 = 0.f;
      for (int i = 0; i < 64; ++i) { s1 += p.lq1[t * 64 + i] * p.lk1[t * 64 + i]; s2 += p.lq2[t * 64 + i] * p.lk2[t * 64 + i]; }
      const float li = t == 0 ? 0.2f : (t == 1 ? 0.355509067590969f : (t == 2 ? 0.470713018343584f : 0.556058204155641f));
      p.lam[t] = expf(s1) - expf(s2) + li;
      p.lam[4 + t] = li;
      p.counters[t] = 0; p.counters[4 + t] = 0;
    }
  }
  {
    float* tile = (float*)smem;
    const int trow = t >> 4, tc4 = (t & 15) * 4;
    const int tn = t >> 2, tkseg = (t & 3) * 16;
    const float* tsrc; u16* tdst; int tK, tN, tkt, tnt;
#define TR_DECODE(J)                                                                                                                       \
    if ((J) < 5632) { const int l_ = (J) / 1408, r_ = (J) % 1408; tsrc = p.w_in + (size_t)l_ * 1024 * 5632; tdst = p.WinT + (size_t)l_ * 5632 * 1024; tK = 1024; tN = 5632; tkt = r_ / 88; tnt = r_ % 88; } \
    else if ((J) < 6144) { const int q_ = (J) - 5632, l_ = q_ >> 7, r_ = q_ & 127; tsrc = p.w_oa + (size_t)l_ * 512 * 1024; tdst = p.WoaT + (size_t)l_ * 1024 * 512; tK = 512; tN = 1024; tkt = r_ >> 4; tnt = r_ & 15; } \
    else if ((J) < 6656) { const int q_ = (J) - 6144, l_ = q_ >> 7, r_ = q_ & 127; tsrc = p.w_og + (size_t)l_ * 512 * 1024; tdst = p.WogT + (size_t)l_ * 1024 * 512; tK = 512; tN = 1024; tkt = r_ >> 4; tnt = r_ & 15; } \
    else { const int q_ = (J) - 6656, l_ = q_ >> 8, r_ = q_ & 255; tsrc = p.w_out + (size_t)l_ * 1024 * 1024; tdst = p.WoutT + (size_t)l_ * 1024 * 1024; tK = 1024; tN = 1024; tkt = r_ >> 4; tnt = r_ & 15; }
#define TR_LOAD()                                                                                                                          \
    { const float* s_ = tsrc + (size_t)(tkt * 64 + trow) * tN + tnt * 64 + tc4;                                                            \
      f0 = *(const float4*)s_; f1 = *(const float4*)(s_ + (size_t)16 * tN); f2 = *(const float4*)(s_ + (size_t)32 * tN); f3 = *(const float4*)(s_ + (size_t)48 * tN); }
    float4 f0, f1, f2, f3;
    int j = blockIdx.x;
    if (j < 7680) { TR_DECODE(j) TR_LOAD() }
    for (; j < 7680; j += gridDim.x) {
      u16* d = (tN == 5632) ? tdst + ((size_t)(tkt * 2 + (tkseg >> 5)) * 5632 + (tnt * 64 + tn)) * 32 + (tkseg & 31)
                            : tdst + (size_t)(tnt * 64 + tn) * tK + tkt * 64 + tkseg;
      __syncthreads();
      float* w0 = tile + trow * 65 + tc4;
      w0[0] = f0.x; w0[1] = f0.y; w0[2] = f0.z; w0[3] = f0.w;
      w0[16 * 65 + 0] = f1.x; w0[16 * 65 + 1] = f1.y; w0[16 * 65 + 2] = f1.z; w0[16 * 65 + 3] = f1.w;
      w0[32 * 65 + 0] = f2.x; w0[32 * 65 + 1] = f2.y; w0[32 * 65 + 2] = f2.z; w0[32 * 65 + 3] = f2.w;
      w0[48 * 65 + 0] = f3.x; w0[48 * 65 + 1] = f3.y; w0[48 * 65 + 2] = f3.z; w0[48 * 65 + 3] = f3.w;
      __syncthreads();
      const int jn = j + gridDim.x;
      if (jn < 7680) { TR_DECODE(jn) TR_LOAD() }
      unsigned o0 = pk(tile[(tkseg + 0) * 65 + tn], tile[(tkseg + 1) * 65 + tn]), o1 = pk(tile[(tkseg + 2) * 65 + tn], tile[(tkseg + 3) * 65 + tn]);
      unsigned o2 = pk(tile[(tkseg + 4) * 65 + tn], tile[(tkseg + 5) * 65 + tn]), o3 = pk(tile[(tkseg + 6) * 65 + tn], tile[(tkseg + 7) * 65 + tn]);
      unsigned o4 = pk(tile[(tkseg + 8) * 65 + tn], tile[(tkseg + 9) * 65 + tn]), o5 = pk(tile[(tkseg + 10) * 65 + tn], tile[(tkseg + 11) * 65 + tn]);
      unsigned o6 = pk(tile[(tkseg + 12) * 65 + tn], tile[(tkseg + 13) * 65 + tn]), o7 = pk(tile[(tkseg + 14) * 65 + tn], tile[(tkseg + 15) * 65 + tn]);
      *(uint4*)d = make_uint4(o0, o1, o2, o3);
      *(uint4*)(d + 8) = make_uint4(o4, o5, o6, o7);
    }
  }
  const int gt = blockIdx.x * 256 + t, gs = gridDim.x * 256;
  for (int idx = gt; idx < MTOK * 128; idx += gs) {
    const int row = idx >> 7, c8 = (idx & 127) * 8;
    const float* src = row < SEQ ? p.x_prompt + (size_t)row * 1024 + c8 : p.x_sample + (size_t)(row - SEQ) * 1024 + c8;
    const float4 a = *(const float4*)src, b = *(const float4*)(src + 4);
    *(uint4*)(p.Xb + (size_t)row * 1024 + c8) = make_uint4(pk(a.x, a.y), pk(a.z, a.w), pk(b.x, b.y), pk(b.z, b.w));
  }
  for (int idx = gt; idx < SEQ * 32; idx += gs) {
    const int pos = idx >> 5, j = idx & 31;
    const float inv = ROPE_INV[j];
    const float ang = (float)pos * inv;
    double rev = (double)ang * 0.15915494309189535;
    rev -= rint(rev);
    const float rf = (float)rev;
    p.rope[2 * idx] = __builtin_amdgcn_cosf(rf);
    p.rope[2 * idx + 1] = __builtin_amdgcn_sinf(rf);
  }
}

constexpr int CW_STRIDE = 260;
DI void phaseA_tile(const Params& p, int layer, int mt, int nt, unsigned char* smem) {
  f32x16 acc[2][4];
#pragma unroll
  for (int a = 0; a < 2; ++a)
#pragma unroll
    for (int b = 0; b < 4; ++b)
#pragma unroll
      for (int i = 0; i < 16; ++i) acc[a][b][i] = 0.f;
  gemm_core_wide(p.Xb + (size_t)mt * 128 * 1024, 1024, p.WinT + (size_t)layer * 5632 * 1024 + (size_t)nt * 256 * 32, 5632, 1024, acc, smem);
  const int t = tid(), l = t & 63, w = t >> 6, wm = w >> 1, wn = w & 1, hb = l >> 5, r = l & 31;
  const int n0 = nt * 256, seg = n0 >> 9;
  const bool samp = mt >= 128;
  float* ct = (float*)smem;
#pragma unroll
  for (int h = 0; h < 2; ++h) {
    __syncthreads();
    if (wm == h) {
      float* base = ct + (4 * hb) * CW_STRIDE + wn * 128 + r;
#pragma unroll
      for (int tm = 0; tm < 2; ++tm)
#pragma unroll
        for (int tn = 0; tn < 4; ++tn)
#pragma unroll
          for (int i = 0; i < 16; ++i) base[(tm * 32 + (i & 3) + 8 * (i >> 2)) * CW_STRIDE + tn * 32] = acc[tm][tn][i];
    }
    __syncthreads();
    if (seg <= 1) {
      const int j = t & 15, head = j >> 2, c8 = (j & 3) * 8;
#pragma unroll
      for (int i = 0; i < 4; ++i) {
        const int rl = (t >> 4) + 16 * i;
        const int row = mt * 128 + h * 64 + rl;
        const int pos = samp ? 1024 + ((row - SEQ) & 31) : row;
        const float* cp = ct + rl * CW_STRIDE + head * 64 + c8;
        const float4 xa0 = *(const float4*)cp, xa1 = *(const float4*)(cp + 4);
        const float4 xb0 = *(const float4*)(cp + 32), xb1 = *(const float4*)(cp + 36);
        const float4* rp = (const float4*)(p.rope + ((size_t)pos * 32 + c8) * 2);
        const float4 r0 = rp[0], r1 = rp[1], r2 = rp[2], r3 = rp[3];
        float4 ya0, ya1, yb0, yb1;
        ya0.x = xa0.x * r0.x - xb0.x * r0.y; yb0.x = xb0.x * r0.x + xa0.x * r0.y;
        ya0.y = xa0.y * r0.z - xb0.y * r0.w; yb0.y = xb0.y * r0.z + xa0.y * r0.w;
        ya0.z = xa0.z * r1.x - xb0.z * r1.y; yb0.z = xb0.z * r1.x + xa0.z * r1.y;
        ya0.w = xa0.w * r1.z - xb0.w * r1.w; yb0.w = xb0.w * r1.z + xa0.w * r1.w;
        ya1.x = xa1.x * r2.x - xb1.x * r2.y; yb1.x = xb1.x * r2.x + xa1.x * r2.y;
        ya1.y = xa1.y * r2.z - xb1.y * r2.w; yb1.y = xb1.y * r2.z + xa1.y * r2.w;
        ya1.z = xa1.z * r3.x - xb1.z * r3.y; yb1.z = xb1.z * r3.x + xa1.z * r3.y;
        ya1.w = xa1.w * r3.z - xb1.w * r3.w; yb1.w = xb1.w * r3.z + xa1.w * r3.w;
        const int col = n0 + head * 64 + c8;
        u16* hp = seg == 1 ? p.Kc + ((size_t)((col - C_K) >> 7) * MTOK + row) * 128 + ((col - C_K) & 127) : p.H + (size_t)row * INW + col;
        if (seg == 0) {
          const float qs = 0.125f * 1.4426950408889634f;
          *(uint4*)hp = make_uint4(pk(ya0.x * qs, ya0.y * qs), pk(ya0.z * qs, ya0.w * qs), pk(ya1.x * qs, ya1.y * qs), pk(ya1.z * qs, ya1.w * qs));
          *(uint4*)(hp + 32) = make_uint4(pk(yb0.x * qs, yb0.y * qs), pk(yb0.z * qs, yb0.w * qs), pk(yb1.x * qs, yb1.y * qs), pk(yb1.z * qs, yb1.w * qs));
        } else {
          *(uint4*)hp = pack8(ya0, ya1);
          *(uint4*)(hp + 32) = pack8(yb0, yb1);
        }
        if (seg == 1) {
          float* o = samp ? p.out + OFF_KS + ((size_t)layer * 1024 + (row - SEQ)) * 512 + (col - C_K)
                          : p.out + OFF_KP + ((size_t)layer * SEQ + row) * 512 + (col - C_K);
          nt_store4(o, ya0); nt_store4(o + 4, ya1); nt_store4(o + 32, yb0); nt_store4(o + 36, yb1);
        }
      }
    } else {
      const int c8 = (t & 31) * 8;
#pragma unroll
      for (int i = 0; i < 8; ++i) {
        const int rl = (t >> 5) + 8 * i;
        const int row = mt * 128 + h * 64 + rl;
        const float* cp = ct + rl * CW_STRIDE + c8;
        const float4 v0 = *(const float4*)cp, v1 = *(const float4*)(cp + 4);
        const int col = n0 + c8;
        if (seg == 2) *(uint4*)(p.Vc + ((size_t)((col - C_V) >> 7) * MTOK + row) * 128 + ((col - C_V) & 127)) = pack8(v0, v1);
        else *(uint4*)(p.H + (size_t)row * INW + col) = pack8(v0, v1);
        if (seg == 2) {
          float* o = samp ? p.out + OFF_VS + ((size_t)layer * 1024 + (row - SEQ)) * 512 + (col - C_V)
                          : p.out + OFF_VP + ((size_t)layer * SEQ + row) * 512 + (col - C_V);
          nt_store4(o, v0); nt_store4(o + 4, v1);
        }
      }
    }
  }
}

constexpr int KS_STRIDE = 72;
constexpr int VS_STRIDE = 160;
constexpr int ST_K = 2 * 64 * KS_STRIDE;
constexpr int ST_BYTES = ST_K * 2 + 64 * VS_STRIDE * 2;

#define LOADV(D0, D1, D2, D3, G)                                                             \
  {                                                                                          \
    const u16* vk_ = vp + ((G) * 16) * VROW;                                                 \
    D0 = cat8(tr_read(vk_ + vo0), tr_read(vk_ + 8 * VROW + vo0));                            \
    D1 = cat8(tr_read(vk_ + vo1), tr_read(vk_ + 8 * VROW + vo1));                            \
    D2 = cat8(tr_read(vk_ + vo2), tr_read(vk_ + 8 * VROW + vo2));                            \
    D3 = cat8(tr_read(vk_ + vo3), tr_read(vk_ + 8 * VROW + vo3));                            \
  }
#define PACKP(S, U) __builtin_bit_cast(bf16x8, make_uint4(pk(S[8 * (U) + 0], S[8 * (U) + 1]), pk(S[8 * (U) + 2], S[8 * (U) + 3]), pk(S[8 * (U) + 4], S[8 * (U) + 5]), pk(S[8 * (U) + 6], S[8 * (U) + 7])))
#define PVMFMA(D0, D1, D2, D3, PB) { O[0] = MFMA(D0, PB, O[0]); O[1] = MFMA(D1, PB, O[1]); O[2] = MFMA(D2, PB, O[2]); O[3] = MFMA(D3, PB, O[3]); }
template <bool SWZ>
DI void attn_compute(const u16* Kb, const u16* Vb, const bf16x8 (&qf)[4], f32x16 (&O)[4], f32x16& Mneg, float& m_run, float& l_run, bool two, int s) {
  const int l = tid() & 63, hb = l >> 5, r = l & 31;
  f32x16 S0, S1;
  constexpr int KROW = SWZ ? 64 : KS_STRIDE, VROW = SWZ ? 128 : VS_STRIDE;
  const int q4 = (l & 15) >> 2, p4 = l & 3, blk = (l >> 4) & 1;
  const int ksw = SWZ ? ((r >> 1) & 7) : 0;
  const u16* kp = Kb + (s * 64 + r) * KROW;
  const int ko0 = ((0 + hb) ^ ksw) * 8, ko1 = ((2 + hb) ^ ksw) * 8, ko2 = ((4 + hb) ^ ksw) * 8, ko3 = ((6 + hb) ^ ksw) * 8;
  const u16* vp = Vb + (4 * hb + q4) * VROW + blk * 16 + p4 * 4;
  const int vsw = SWZ ? q4 : 0;
  const int vo0 = (0 ^ vsw) * 32, vo1 = (1 ^ vsw) * 32, vo2 = (2 ^ vsw) * 32, vo3 = (3 ^ vsw) * 32;
  bf16x8 ka0, ka1, ka2, ka3, kb0, kb1, kb2, kb3, va0, va1, va2, va3, vb0, vb1, vb2, vb3;
  ka0 = *(const bf16x8*)(kp + ko0); ka1 = *(const bf16x8*)(kp + ko1); ka2 = *(const bf16x8*)(kp + ko2); ka3 = *(const bf16x8*)(kp + ko3);
  if (two) {
    kb0 = *(const bf16x8*)(kp + 32 * KROW + ko0); kb1 = *(const bf16x8*)(kp + 32 * KROW + ko1);
    kb2 = *(const bf16x8*)(kp + 32 * KROW + ko2); kb3 = *(const bf16x8*)(kp + 32 * KROW + ko3);
  }
  LOADV(va0, va1, va2, va3, 0)
  __builtin_amdgcn_sched_barrier(0);
  S0 = MFMA(ka0, qf[0], Mneg); S0 = MFMA(ka1, qf[1], S0); S0 = MFMA(ka2, qf[2], S0); S0 = MFMA(ka3, qf[3], S0);
  if (two) { S1 = MFMA(kb0, qf[0], Mneg); S1 = MFMA(kb1, qf[1], S1); S1 = MFMA(kb2, qf[2], S1); S1 = MFMA(kb3, qf[3], S1); }
  float ls = 0.f;
#pragma unroll
  for (int i = 0; i < 16; ++i) { S0[i] = __builtin_amdgcn_exp2f(S0[i]); ls += S0[i]; }
  if (two) {
#pragma unroll
    for (int i = 0; i < 16; ++i) { S1[i] = __builtin_amdgcn_exp2f(S1[i]); ls += S1[i]; }
  }
  if (__any(!(ls <= 4194304.f))) {
    bf16x8 ra0 = *(const bf16x8*)(kp + ko0), ra1 = *(const bf16x8*)(kp + ko1), ra2 = *(const bf16x8*)(kp + ko2), ra3 = *(const bf16x8*)(kp + ko3);
#pragma unroll
    for (int i = 0; i < 16; ++i) { S0[i] = 0.f; S1[i] = 0.f; }
    S0 = MFMA(ra0, qf[0], S0); S0 = MFMA(ra1, qf[1], S0); S0 = MFMA(ra2, qf[2], S0); S0 = MFMA(ra3, qf[3], S0);
    if (two) {
      ra0 = *(const bf16x8*)(kp + 32 * KROW + ko0); ra1 = *(const bf16x8*)(kp + 32 * KROW + ko1);
      ra2 = *(const bf16x8*)(kp + 32 * KROW + ko2); ra3 = *(const bf16x8*)(kp + 32 * KROW + ko3);
      S1 = MFMA(ra0, qf[0], S1); S1 = MFMA(ra1, qf[1], S1); S1 = MFMA(ra2, qf[2], S1); S1 = MFMA(ra3, qf[3], S1);
    }
    float mx = S0[0];
#pragma unroll
    for (int i = 1; i < 16; ++i) mx = fmaxf(mx, S0[i]);
    if (two) {
#pragma unroll
      for (int i = 0; i < 16; ++i) mx = fmaxf(mx, S1[i]);
    }
    mx = fmaxf(mx, __shfl_xor(mx, 32));
    const float m_new = fmaxf(m_run, mx);
    const float alpha = __builtin_amdgcn_exp2f(m_run - m_new);
    m_run = m_new;
#pragma unroll
    for (int i = 0; i < 16; ++i) Mneg[i] = -m_new;
    l_run *= alpha;
#pragma unroll
    for (int dt = 0; dt < 4; ++dt)
#pragma unroll
      for (int i = 0; i < 16; ++i) O[dt][i] *= alpha;
    ls = 0.f;
#pragma unroll
    for (int i = 0; i < 16; ++i) { S0[i] = __builtin_amdgcn_exp2f(S0[i] - m_new); ls += S0[i]; }
    if (two) {
#pragma unroll
      for (int i = 0; i < 16; ++i) { S1[i] = __builtin_amdgcn_exp2f(S1[i] - m_new); ls += S1[i]; }
    }
  }
  l_run += ls;
  {
    const bf16x8 pb0 = PACKP(S0, 0);
    __builtin_amdgcn_sched_barrier(0);
    LOADV(vb0, vb1, vb2, vb3, 1)
    __builtin_amdgcn_sched_barrier(0);
    PVMFMA(va0, va1, va2, va3, pb0)
    const bf16x8 pb1 = PACKP(S0, 1);
    __builtin_amdgcn_sched_barrier(0);
    if (two) LOADV(va0, va1, va2, va3, 2)
    __builtin_amdgcn_sched_barrier(0);
    PVMFMA(vb0, vb1, vb2, vb3, pb1)
    if (two) {
      const bf16x8 pb2 = PACKP(S1, 0);
      __builtin_amdgcn_sched_barrier(0);
      LOADV(vb0, vb1, vb2, vb3, 3)
      __builtin_amdgcn_sched_barrier(0);
      PVMFMA(va0, va1, va2, va3, pb2)
      const bf16x8 pb3 = PACKP(S1, 1);
      __builtin_amdgcn_sched_barrier(0);
      PVMFMA(vb0, vb1, vb2, vb3, pb3)
    }
  }
}

template <bool SAMPLE>
DI void attn_item(const Params& p, int layer, int a, int h, unsigned char* smem) {
  const int t = tid(), l = t & 63, w = t >> 6, rg = w & 1, s = w >> 1, hb = l >> 5, r = l & 31;
  const int hh = 2 * h + s;
  const int qrow0 = SAMPLE ? SEQ + a * 32 : a * 64 + rg * 32;
  const bool active = SAMPLE ? (rg == 0) : true;
  const u16* H = p.H;
  bf16x8 qf[4];
  {
    const u16* qp = H + (size_t)(qrow0 + r) * INW + hh * 64 + hb * 8;
#pragma unroll
    for (int ks = 0; ks < 4; ++ks) qf[ks] = *(const bf16x8*)(qp + ks * 16);
  }
  f32x16 O[4];
#pragma unroll
  for (int dt = 0; dt < 4; ++dt)
#pragma unroll
    for (int i = 0; i < 16; ++i) O[dt][i] = 0.f;
  float m_run = -1e30f, l_run = 0.f;
  f32x16 Mneg;
#pragma unroll
  for (int i = 0; i < 16; ++i) Mneg[i] = 1e30f;
  u16* sm = (u16*)smem;

  __syncthreads();
  if (!SAMPLE) {
    const int ntiles = a + 1;
    const u16* kg = p.Kc + (size_t)h * MTOK * 128;
    const u16* vg = p.Vc + (size_t)h * MTOK * 128;
    const int krow = w * 8 + (l >> 3);
    const unsigned kqo = (unsigned)(krow * 128 + ((l & 7) ^ ((krow >> 1) & 7)) * 8) * 2u;
    const int vrow = w * 4 + (l >> 4);
    const unsigned vqo = (unsigned)(vrow * 128 + ((l & 15) ^ (((l >> 4) & 3) << 2)) * 8) * 2u;
    const unsigned lb = __builtin_amdgcn_readfirstlane(lds_addr(smem) + w * 1024);
#define ATT_STAGE(BUF, KT)                                                                                \
    {                                                                                                     \
      const unsigned sb_ = lb + (BUF) * 32768;                                                            \
      const unsigned ko_ = kqo + (unsigned)(KT) * (64u * 128u * 2u);                                      \
      const unsigned vo_ = vqo + (unsigned)(KT) * (64u * 128u * 2u);                                      \
      glds16s(kg, ko_, sb_); glds16s(kg, ko_ + 32u * 256u, sb_ + 4096);                                   \
      glds16s(kg, ko_ + 128u, sb_ + 8192); glds16s(kg, ko_ + 32u * 256u + 128u, sb_ + 12288);             \
      glds16s(vg, vo_, sb_ + 16384); glds16s(vg, vo_ + 16u * 256u, sb_ + 16384 + 4096);                   \
      glds16s(vg, vo_ + 32u * 256u, sb_ + 16384 + 8192); glds16s(vg, vo_ + 48u * 256u, sb_ + 16384 + 12288); \
    }
    ATT_STAGE(0, 0)
    asm volatile("s_waitcnt vmcnt(0)" ::: "memory");
    __syncthreads();
    for (int kt = 0; kt < ntiles; ++kt) {
      const int buf = kt & 1;
      if (kt + 1 < ntiles) ATT_STAGE(buf ^ 1, kt + 1)
      __builtin_amdgcn_sched_barrier(0);
      const u16* kb = sm + buf * 16384;
      attn_compute<true>(kb, kb + 8192, qf, O, Mneg, m_run, l_run, true, s);
      asm volatile("s_waitcnt vmcnt(0)" ::: "memory");
      __syncthreads();
    }
  } else {
    const float* ck = p.cache_k + ((size_t)(layer * 32 + a) * 1024) * 512 + (2 * h) * 64;
    const float* cv = p.cache_v + ((size_t)(layer * 32 + a) * 1024) * 512 + h * 128;
    for (int j = 0; j < 9; ++j) {
      for (int g = 0; g < 2; ++g) {
        const int kt = 2 * j + g;
        u16* kb = sm + g * (ST_BYTES / 2);
        u16* vb = kb + ST_K;
        if (kt < 16) {
#pragma unroll
          for (int i = 0; i < 8; ++i) {
            const int cc = t + 256 * i;
            const int sh = cc >> 10, key = (cc >> 4) & 63, ch = cc & 15;
            const float4 v = *(const float4*)(ck + (size_t)(kt * 64 + key) * 512 + sh * 64 + ch * 4);
            *(uint2*)(kb + (sh * 64 + key) * KS_STRIDE + ch * 4) = make_uint2(pk(v.x, v.y), pk(v.z, v.w));
            const int vkey = cc >> 5, vch = cc & 31;
            const float4 u = *(const float4*)(cv + (size_t)(kt * 64 + vkey) * 512 + vch * 4);
            *(uint2*)(vb + vkey * VS_STRIDE + vch * 4) = make_uint2(pk(u.x, u.y), pk(u.z, u.w));
          }
        } else if (kt == 16) {
          const u16* kg = p.Kc + ((size_t)h * MTOK + SEQ + a * 32) * 128;
          const u16* vg = p.Vc + ((size_t)h * MTOK + SEQ + a * 32) * 128;
#pragma unroll
          for (int i = 0; i < 2; ++i) {
            const int cc = t + 256 * i;
            const int sh = cc >> 8, key = (cc >> 3) & 31, ch = cc & 7;
            *(uint4*)(kb + (sh * 64 + key) * KS_STRIDE + ch * 8) = *(const uint4*)(kg + (size_t)key * 128 + sh * 64 + ch * 8);
            const int vkey = cc >> 4, vch = cc & 15;
            *(uint4*)(vb + vkey * VS_STRIDE + vch * 8) = *(const uint4*)(vg + (size_t)vkey * 128 + vch * 8);
          }
        }
      }
      __syncthreads();
      {
        const int kt = 2 * j + rg;
        const u16* kb = sm + rg * (ST_BYTES / 2);
        if (kt <= 16) attn_compute<false>(kb, kb + ST_K, qf, O, Mneg, m_run, l_run, kt < 16, s);
      }
      __syncthreads();
    }
    float* mgO = (float*)smem;
    float* mgML = (float*)(smem + 32768);
    if (rg == 1) {
#pragma unroll
      for (int dt = 0; dt < 4; ++dt)
#pragma unroll
        for (int i = 0; i < 16; ++i) mgO[(s * 128 + dt * 32 + crow(i, hb)) * 32 + r] = O[dt][i];
      mgML[(s * 64 + l) * 2] = m_run; mgML[(s * 64 + l) * 2 + 1] = l_run;
    }
    __syncthreads();
    if (rg == 0) {
      const float m1 = mgML[(s * 64 + l) * 2], l1 = mgML[(s * 64 + l) * 2 + 1];
      const float mm = fmaxf(m_run, m1);
      const float a0 = __builtin_amdgcn_exp2f(m_run - mm), a1 = __builtin_amdgcn_exp2f(m1 - mm);
#pragma unroll
      for (int dt = 0; dt < 4; ++dt)
#pragma unroll
        for (int i = 0; i < 16; ++i) O[dt][i] = O[dt][i] * a0 + mgO[(s * 128 + dt * 32 + crow(i, hb)) * 32 + r] * a1;
      l_run = l_run * a0 + l1 * a1;
      m_run = mm;
    }
    __syncthreads();
  }
  const int te = tid(), le = te & 63, re = le & 31, hbe = le >> 5, rge = (te >> 6) & 1, se = te >> 7;
  const bool acte = SAMPLE ? (rge == 0) : true;
  float lt = l_run + __shfl_xor(l_run, 32);
  const float inv_l = 1.f / lt;
  float* ex = (float*)smem;
  if (se == 1 && acte) {
#pragma unroll
    for (int dt = 0; dt < 4; ++dt)
#pragma unroll
      for (int i = 0; i < 16; ++i) ex[(rge * 128 + dt * 32 + crow(i, hbe)) * 32 + re] = O[dt][i] * inv_l;
  }
  __syncthreads();
  if (se == 0 && acte) {
    const float lam = __hip_atomic_load(p.lam + layer, __ATOMIC_RELAXED, __HIP_MEMORY_SCOPE_AGENT);
    const float li = __hip_atomic_load(p.lam + 4 + layer, __ATOMIC_RELAXED, __HIP_MEMORY_SCOPE_AGENT);
    float ss = 0.f;
#pragma unroll
    for (int dt = 0; dt < 4; ++dt)
#pragma unroll
      for (int i = 0; i < 16; ++i) {
        const float o = O[dt][i] * inv_l - lam * ex[(rge * 128 + dt * 32 + crow(i, hbe)) * 32 + re];
        O[dt][i] = o; ss += o * o;
      }
    ss += __shfl_xor(ss, 32);
    const float rs = rsqrtf(ss * (1.f / 128.f) + LN_EPS) * (1.f - li);
    const int row = (SAMPLE ? SEQ + a * 32 : a * 64 + rge * 32) + re;
    const u16* gp = H + (size_t)row * INW + C_GA + h * 128;
    u16* op = p.A1 + (size_t)row * 512 + h * 128;
    const float* sw = p.subln_w + layer * 128;
#pragma unroll
    for (int dt = 0; dt < 4; ++dt)
#pragma unroll
      for (int g4 = 0; g4 < 4; ++g4) {
        const int d = dt * 32 + 8 * g4 + 4 * hbe;
        const uint2 gv = *(const uint2*)(gp + d);
        const float4 wv = *(const float4*)(sw + d);
        const float y0 = O[dt][4 * g4 + 0] * rs * wv.x * siluf_(bflo(gv.x));
        const float y1 = O[dt][4 * g4 + 1] * rs * wv.y * siluf_(bfhi(gv.x));
        const float y2 = O[dt][4 * g4 + 2] * rs * wv.z * siluf_(bflo(gv.y));
        const float y3 = O[dt][4 * g4 + 3] * rs * wv.w * siluf_(bfhi(gv.y));
        *(uint2*)(op + d) = make_uint2(pk(y0, y1), pk(y2, y3));
      }
  }
}

DI void sgu_item(const Params& p, int layer, int chunk, int g, unsigned char* smem) {
  const int t = tid(), l = t & 63, w = t >> 6, wm = w >> 1, wn = w & 1, hb = l >> 5, r = l & 31;
  const int m0 = chunk * 128;
  const bool samp = chunk >= 128;
  u16* Asg = (u16*)smem;
  u16* Bsg = Asg + 128 * 72;
  float* st = (float*)(smem + 38912);
  const u16* H = p.H;
  const float* Wg = p.w_s + ((size_t)(layer * 4 + g) * 128) * 128;
  float4 wv[2][8];
  uint4 bv[2][4], puu[8], pgg[8];
#pragma unroll
  for (int kh = 0; kh < 2; ++kh) {
#pragma unroll
    for (int i8 = 0; i8 < 8; ++i8) {
      const int cc = t + 256 * i8;
      const int i = cc >> 4, j = kh * 64 + (cc & 15) * 4;
      wv[kh][i8] = samp ? *(const float4*)(Wg + (i & 31) * 128 + (j & 31)) : *(const float4*)(Wg + i * 128 + j);
    }
#pragma unroll
    for (int i4 = 0; i4 < 4; ++i4) {
      const int cc = t + 256 * i4;
      bv[kh][i4] = *(const uint4*)(H + (size_t)(m0 + kh * 64 + (cc >> 4)) * INW + C_VG + g * 128 + (cc & 15) * 8);
    }
  }
#pragma unroll
  for (int i = 0; i < 8; ++i) {
    const u16* hp = H + (size_t)(m0 + (t >> 4) + 16 * i) * INW + g * 128 + (t & 15) * 8;
    puu[i] = *(const uint4*)(hp + C_U); pgg[i] = *(const uint4*)(hp + C_GG);
  }
  __syncthreads();
#pragma unroll 8
  for (int rr = 0; rr < 32; ++rr) {
    const int row = w * 32 + rr;
    const uint4 v = *(const uint4*)(H + (size_t)(m0 + row) * INW + C_VG + l * 8);
    float x[8] = {bflo(v.x), bfhi(v.x), bflo(v.y), bfhi(v.y), bflo(v.z), bfhi(v.z), bflo(v.w), bfhi(v.w)};
    float s1 = 0.f, s2 = 0.f;
#pragma unroll
    for (int e = 0; e < 8; ++e) { s1 += x[e]; s2 += x[e] * x[e]; }
#pragma unroll
    for (int o = 32; o >= 1; o >>= 1) { s1 += __shfl_xor(s1, o); s2 += __shfl_xor(s2, o); }
    if (l == 0) {
      const float mean = s1 * (1.f / 512.f);
      const float var = fmaxf(s2 * (1.f / 512.f) - mean * mean, 0.f);
      st[row] = mean; st[128 + row] = rsqrtf(var + LN_EPS);
    }
  }
  __syncthreads();
  f32x16 acc[2][2];
  zero_acc(acc);
  const float* gam = p.sgu_g + layer * 512 + g * 128;
  const float* bet = p.sgu_b + layer * 512 + g * 128;
  const int q4 = (l & 15) >> 2, p4 = l & 3, blk = (l >> 4) & 1;
#pragma unroll
  for (int kh = 0; kh < 2; ++kh) {
#pragma unroll
    for (int i8 = 0; i8 < 8; ++i8) {
      const int cc = t + 256 * i8;
      const int i = cc >> 4, j4 = (cc & 15) * 4, j = kh * 64 + j4;
      const float4 v = wv[kh][i8];
      float e0, e1, e2, e3;
      if (!samp) {
        e0 = (j + 0 <= i) ? v.x : 0.f; e1 = (j + 1 <= i) ? v.y : 0.f; e2 = (j + 2 <= i) ? v.z : 0.f; e3 = (j + 3 <= i) ? v.w : 0.f;
      } else {
        const int i32 = i & 31, j32 = j & 31;
        const bool same = (i >> 5) == (j >> 5);
        e0 = (same && j32 + 0 <= i32) ? v.x : 0.f; e1 = (same && j32 + 1 <= i32) ? v.y : 0.f;
        e2 = (same && j32 + 2 <= i32) ? v.z : 0.f; e3 = (same && j32 + 3 <= i32) ? v.w : 0.f;
      }
      *(uint2*)(Asg + i * 72 + j4) = make_uint2(pk(e0, e1), pk(e2, e3));
    }
#pragma unroll
    for (int i4 = 0; i4 < 4; ++i4) {
      const int cc = t + 256 * i4;
      const int jj = cc >> 4, dc = (cc & 15) * 8;
      const int jrow = kh * 64 + jj;
      const uint4 v = bv[kh][i4];
      const float mean = st[jrow], rstd = st[128 + jrow];
      const float4 g0 = *(const float4*)(gam + dc), g1 = *(const float4*)(gam + dc + 4);
      const float4 b0 = *(const float4*)(bet + dc), b1 = *(const float4*)(bet + dc + 4);
      const float y0 = (bflo(v.x) - mean) * rstd * g0.x + b0.x, y1 = (bfhi(v.x) - mean) * rstd * g0.y + b0.y;
      const float y2 = (bflo(v.y) - mean) * rstd * g0.z + b0.z, y3 = (bfhi(v.y) - mean) * rstd * g0.w + b0.w;
      const float y4 = (bflo(v.z) - mean) * rstd * g1.x + b1.x, y5 = (bfhi(v.z) - mean) * rstd * g1.y + b1.y;
      const float y6 = (bflo(v.w) - mean) * rstd * g1.z + b1.z, y7 = (bfhi(v.w) - mean) * rstd * g1.w + b1.w;
      *(uint4*)(Bsg + jj * VS_STRIDE + dc) = make_uint4(pk(y0, y1), pk(y2, y3), pk(y4, y5), pk(y6, y7));
      if (samp) {
        float* o = p.out + OFF_GV + ((size_t)layer * 1024 + (m0 - SEQ) + jrow) * 512 + g * 128 + dc;
        *(float4*)o = make_float4(y0, y1, y2, y3);
        *(float4*)(o + 4) = make_float4(y4, y5, y6, y7);
      }
    }
    __syncthreads();
    const u16* as = Asg + (wm * 64 + r) * 72 + hb * 8;
    const u16* bs = Bsg + (8 * hb + q4) * VS_STRIDE + wn * 64 + blk * 16 + p4 * 4;
#pragma unroll
    for (int ks = 0; ks < 4; ++ks) {
      bf16x8 a0 = *(const bf16x8*)(as + ks * 16), a1 = *(const bf16x8*)(as + 32 * 72 + ks * 16);
      const u16* bk = bs + ks * 16 * VS_STRIDE;
      bf16x8 b0 = cat8(tr_read(bk), tr_read(bk + 4 * VS_STRIDE));
      bf16x8 b1 = cat8(tr_read(bk + 32), tr_read(bk + 4 * VS_STRIDE + 32));
      acc[0][0] = MFMA(a0, b0, acc[0][0]); acc[0][1] = MFMA(a0, b1, acc[0][1]);
      acc[1][0] = MFMA(a1, b0, acc[1][0]); acc[1][1] = MFMA(a1, b1, acc[1][1]);
    }
    __syncthreads();
  }
  const float* bsp = p.b_s + (size_t)(layer * 4 + g) * 128;
  acc_to_lds(acc, smem);
  __syncthreads();
  {
    const float* ct = (const float*)smem;
    const int c8 = (t & 15) * 8;
#pragma unroll
    for (int i = 0; i < 8; ++i) {
      const int rl = (t >> 4) + 16 * i;
      const int row = m0 + rl;
      const float* cp = ct + rl * CT_STRIDE + c8;
      const float4 v0 = *(const float4*)cp, v1 = *(const float4*)(cp + 4);
      const float bias = bsp[samp ? (rl & 31) : rl];
      const uint4 uu = puu[i], gg = pgg[i];
      float4 o0, o1;
      o0.x = (v0.x + bias) * bflo(uu.x) * siluf_(bflo(gg.x)); o0.y = (v0.y + bias) * bfhi(uu.x) * siluf_(bfhi(gg.x));
      o0.z = (v0.z + bias) * bflo(uu.y) * siluf_(bflo(gg.y)); o0.w = (v0.w + bias) * bfhi(uu.y) * siluf_(bfhi(gg.y));
      o1.x = (v1.x + bias) * bflo(uu.z) * siluf_(bflo(gg.z)); o1.y = (v1.y + bias) * bfhi(uu.z) * siluf_(bfhi(gg.z));
      o1.z = (v1.z + bias) * bflo(uu.w) * siluf_(bflo(gg.w)); o1.w = (v1.w + bias) * bfhi(uu.w) * siluf_(bfhi(gg.w));
      *(uint4*)(p.A2 + (size_t)row * 512 + g * 128 + c8) = pack8(o0, o1);
    }
  }
}

DI void phaseB(const Params& p, int layer_slot, unsigned char* smem) {
  const int layer = layer_slot & 3;
  int* s_item = (int*)(smem + 77824);
  const bool stat = gridDim.x == 512;
  const int sq = 2 * (blockIdx.x >> 3) + ((blockIdx.x >> 2) & 1), sh = blockIdx.x & 3;
  const int total = stat ? 672 : 1696;
  for (int n = 0;; ++n) {
    int kind, a, h;
    if (stat && n < 2) { kind = 1; a = n ? sq : 255 - sq; h = sh; }
    else {
      __syncthreads();
      if (threadIdx.x == 0) *s_item = atomicAdd(p.counters + layer_slot, 1);
      __syncthreads();
      const int it = *s_item;
      if (it >= total) break;
      if (it < 128) { kind = 0; a = it >> 2; h = it & 3; }
      else if (it < 672) { kind = 2; a = (it - 128) >> 2; h = (it - 128) & 3; }
      else { kind = 1; a = 255 - ((it - 672) >> 2); h = (it - 672) & 3; }
    }
    if (kind == 0) attn_item<true>(p, layer, a, h, smem);
    else if (kind == 1) attn_item<false>(p, layer, a, h, smem);
    else sgu_item(p, layer, a, h, smem);
  }
}

DI void phaseC1_tile(const Params& p, int layer, int mt, int nt, unsigned char* smem) {
  const int t = tid();
  const int c8 = (t & 15) * 8;
  const float* ct = (const float*)smem;
  f32x16 acc[2][2];
  uint4 ya[8], gma[8], gmb[8];
#pragma unroll
  for (int i = 0; i < 8; ++i) {
    const u16* hp = p.H + (size_t)(mt * 128 + (t >> 4) + 16 * i) * INW + nt * 128 + c8;
    gma[i] = *(const uint4*)(hp + C_MA); gmb[i] = *(const uint4*)(hp + C_MB);
  }
  zero_acc(acc);
  gemm_core(p.A1 + (size_t)mt * 128 * 512, 512, p.WoaT + ((size_t)layer * 1024 + nt * 128) * 512, 512, 512, acc, smem);
  acc_to_lds(acc, smem);
  __syncthreads();
#pragma unroll
  for (int i = 0; i < 8; ++i) {
    const int rl = (t >> 4) + 16 * i;
    const int row = mt * 128 + rl;
    const float* cp = ct + rl * CT_STRIDE + c8;
    const float4 v0 = *(const float4*)cp, v1 = *(const float4*)(cp + 4);
    const uint4 g = gma[i];
    ya[i] = make_uint4(pk(v0.x * sigmoidf_(bflo(g.x)), v0.y * sigmoidf_(bfhi(g.x))), pk(v0.z * sigmoidf_(bflo(g.y)), v0.w * sigmoidf_(bfhi(g.y))),
                       pk(v1.x * sigmoidf_(bflo(g.z)), v1.y * sigmoidf_(bfhi(g.z))), pk(v1.z * sigmoidf_(bflo(g.w)), v1.w * sigmoidf_(bfhi(g.w))));
  }
  zero_acc(acc);
  gemm_core(p.A2 + (size_t)mt * 128 * 512, 512, p.WogT + ((size_t)layer * 1024 + nt * 128) * 512, 512, 512, acc, smem);
  acc_to_lds(acc, smem);
  __syncthreads();
#pragma unroll
  for (int i = 0; i < 8; ++i) {
    const int rl = (t >> 4) + 16 * i;
    const int row = mt * 128 + rl;
    const float* cp = ct + rl * CT_STRIDE + c8;
    const float4 v0 = *(const float4*)cp, v1 = *(const float4*)(cp + 4);
    const uint4 g = gmb[i];
    float4 o0, o1;
    const float4 ma0 = make_float4(bflo(ya[i].x), bfhi(ya[i].x), bflo(ya[i].y), bfhi(ya[i].y));
    const float4 ma1 = make_float4(bflo(ya[i].z), bfhi(ya[i].z), bflo(ya[i].w), bfhi(ya[i].w));
    o0.x = ma0.x + v0.x * sigmoidf_(bflo(g.x)); o0.y = ma0.y + v0.y * sigmoidf_(bfhi(g.x));
    o0.z = ma0.z + v0.z * sigmoidf_(bflo(g.y)); o0.w = ma0.w + v0.w * sigmoidf_(bfhi(g.y));
    o1.x = ma1.x + v1.x * sigmoidf_(bflo(g.z)); o1.y = ma1.y + v1.y * sigmoidf_(bfhi(g.z));
    o1.z = ma1.z + v1.z * sigmoidf_(bflo(g.w)); o1.w = ma1.w + v1.w * sigmoidf_(bfhi(g.w));
    *(uint4*)(p.Mg + (size_t)row * 1024 + nt * 128 + c8) = pack8(o0, o1);
  }
}

DI void phaseC2_tile(const Params& p, int layer, int mt, int nt, unsigned char* smem) {
  const int t = tid();
  const int c8 = (t & 15) * 8;
  const float* ct = (const float*)smem;
  const float* xsrc = layer == 0 ? (mt < 128 ? p.x_prompt : p.x_sample - (size_t)SEQ * 1024) : p.Xf;
  float4 xr0[8], xr1[8];
#pragma unroll
  for (int i = 0; i < 8; ++i) {
    const float* xp = xsrc + (size_t)(mt * 128 + (t >> 4) + 16 * i) * 1024 + nt * 128 + c8;
    xr0[i] = *(const float4*)xp; xr1[i] = *(const float4*)(xp + 4);
  }
  f32x16 acc[2][2];
  zero_acc(acc);
  gemm_core(p.Mg + (size_t)mt * 128 * 1024, 1024, p.WoutT + ((size_t)layer * 1024 + nt * 128) * 1024, 1024, 1024, acc, smem);
  acc_to_lds(acc, smem);
  __syncthreads();
#pragma unroll
  for (int i = 0; i < 8; ++i) {
    const int rl = (t >> 4) + 16 * i;
    const int row = mt * 128 + rl;
    const float* cp = ct + rl * CT_STRIDE + c8;
    const float4 v0 = *(const float4*)cp, v1 = *(const float4*)(cp + 4);
    const float4 x0 = xr0[i], x1 = xr1[i];
    float* op = p.Xpre + (size_t)row * 1024 + nt * 128 + c8;
    *(float4*)op = make_float4(ALPHA_RES * x0.x + v0.x, ALPHA_RES * x0.y + v0.y, ALPHA_RES * x0.z + v0.z, ALPHA_RES * x0.w + v0.w);
    *(float4*)(op + 4) = make_float4(ALPHA_RES * x1.x + v1.x, ALPHA_RES * x1.y + v1.y, ALPHA_RES * x1.z + v1.z, ALPHA_RES * x1.w + v1.w);
  }
}

DI void phaseLN(const Params& p, int layer) {
  const int t = tid(), l = t & 63, w = t >> 6;
  const float* g = p.ln_g + layer * 1024;
  const float* b = p.ln_b + layer * 1024;
  float* dstf = layer == 3 ? p.out : p.Xf;
  for (int row = blockIdx.x * 4 + w; row < MTOK; row += gridDim.x * 4) {
    const float* src = p.Xpre + (size_t)row * 1024;
    float4 v[4];
    float s1 = 0.f;
#pragma unroll
    for (int i = 0; i < 4; ++i) { v[i] = *(const float4*)(src + i * 256 + l * 4); s1 += v[i].x + v[i].y + v[i].z + v[i].w; }
#pragma unroll
    for (int o = 32; o >= 1; o >>= 1) s1 += __shfl_xor(s1, o);
    const float mean = s1 * (1.f / 1024.f);
    float s2 = 0.f;
#pragma unroll
    for (int i = 0; i < 4; ++i) {
      v[i].x -= mean; v[i].y -= mean; v[i].z -= mean; v[i].w -= mean;
      s2 += v[i].x * v[i].x + v[i].y * v[i].y + v[i].z * v[i].z + v[i].w * v[i].w;
    }
#pragma unroll
    for (int o = 32; o >= 1; o >>= 1) s2 += __shfl_xor(s2, o);
    const float rstd = rsqrtf(s2 * (1.f / 1024.f) + LN_EPS);
#pragma unroll
    for (int i = 0; i < 4; ++i) {
      const int c = i * 256 + l * 4;
      const float4 gv = *(const float4*)(g + c), bv = *(const float4*)(b + c);
      const float y0 = v[i].x * rstd * gv.x + bv.x, y1 = v[i].y * rstd * gv.y + bv.y;
      const float y2 = v[i].z * rstd * gv.z + bv.z, y3 = v[i].w * rstd * gv.w + bv.w;
      *(float4*)(dstf + (size_t)row * 1024 + c) = make_float4(y0, y1, y2, y3);
      if (layer < 3) *(uint2*)(p.Xb + (size_t)row * 1024 + c) = make_uint2(pk(y0, y1), pk(y2, y3));
    }
  }
}

__global__ void __launch_bounds__(256, 2) fwd_megakernel(Params p) {
  __shared__ __attribute__((aligned(16))) unsigned char smem[SMEM_BYTES];
  __shared__ uint4 xb_words;
  cg::grid_group grid = cg::this_grid();
  if (threadIdx.x == 0) xb_words = make_uint4(0u, 0u, 0u, 0u);
  __syncthreads();
  XcdBarrier xb = xcd_barrier_post(p.bar, (volatile LAS unsigned*)&xb_words);
  for (int ph = p.ph_lo; ph < p.ph_hi; ++ph) {
    if (ph == 0) {
      phase0(p, smem);
    } else {
      const int layer = (ph - 1) / 5, sub = (ph - 1) % 5;
      const int nrep = (sub == PROBE_REP || (PROBE_REP == 6 && sub >= 2)) ? 2 : 1;
      for (int rep = 0; rep < nrep; ++rep) {
        if (rep) xcd_barrier(xb);
        if (sub == 0) {
          for (int tix = blockIdx.x; tix < 136 * 22; tix += gridDim.x) phaseA_tile(p, layer, tix / 22, tix % 22, smem);
        } else if (sub == 1) {
          phaseB(p, layer + 4 * rep, smem);
        } else if (sub == 2) {
          for (int tix = blockIdx.x; tix < 136 * 8; tix += gridDim.x) phaseC1_tile(p, layer, tix >> 3, tix & 7, smem);
        } else if (sub == 3) {
          for (int tix = blockIdx.x; tix < 136 * 8; tix += gridDim.x) phaseC2_tile(p, layer, tix >> 3, tix & 7, smem);
        } else {
          phaseLN(p, layer);
        }
      }
    }
    if (PROBE_REP == 5 && ph + 1 < p.ph_hi) xcd_barrier(xb);
    if (ph + 1 < p.ph_hi) { if (p.ph_hi < 0) grid.sync(); else xcd_barrier(xb); }
  }
}

extern "C" void kernel_launch(void* const* d_in, const int* in_sizes, int n_in, void* d_out, int out_size, void* d_ws, size_t ws_size, hipStream_t stream) {
  static int grid_blocks = 0;
  if (!grid_blocks) {
    int dev = 0, cus = 0, per_cu = 0;
    hipGetDevice(&dev);
    hipDeviceGetAttribute(&cus, hipDeviceAttributeMultiprocessorCount, dev);
    hipOccupancyMaxActiveBlocksPerMultiprocessor(&per_cu, fwd_megakernel, 256, 0);
    if (per_cu < 1) per_cu = 1;
    if (per_cu > 2) per_cu = 2;
    grid_blocks = cus * per_cu;
  }
  Params p{};
  const float** ins = (const float**)&p;
  for (int i = 0; i < 19; ++i) ins[i] = (const float*)d_in[i];
  p.out = (float*)d_out;
  unsigned char* ws = (unsigned char*)d_ws;
  size_t off = 0;
  auto take = [&](size_t bytes) { unsigned char* q = ws + off; off += (bytes + 255) & ~(size_t)255; return q; };
  p.WinT = (u16*)take((size_t)4 * 5632 * 1024 * 2);
  p.WoaT = (u16*)take((size_t)4 * 1024 * 512 * 2);
  p.WogT = (u16*)take((size_t)4 * 1024 * 512 * 2);
  p.WoutT = (u16*)take((size_t)4 * 1024 * 1024 * 2);
  p.Xb = (u16*)take((size_t)MTOK * 1024 * 2);
  p.H = (u16*)take((size_t)MTOK * INW * 2);
  p.A1 = (u16*)take((size_t)MTOK * 512 * 2);
  p.A2 = (u16*)take((size_t)MTOK * 512 * 2);
  p.Mg = (u16*)take((size_t)MTOK * 1024 * 2);
  p.Kc = (u16*)take((size_t)4 * MTOK * 128 * 2);
  p.Vc = (u16*)take((size_t)4 * MTOK * 128 * 2);
  p.Xf = (float*)take((size_t)MTOK * 1024 * 4);
  p.Xpre = (float*)take((size_t)MTOK * 1024 * 4);
  p.rope = (float*)take((size_t)SEQ * 32 * 2 * 4);
  p.lam = (float*)take(256);
  p.counters = (int*)take(256);
  p.bar = (unsigned*)take(XCD_BAR_WORDS * 4);
  hipMemsetAsync(p.bar, 0, XCD_BAR_WORDS * 4, stream);
#if MULTI_LAUNCH
  for (int ph = 0; ph < 21; ++ph) {
    p.ph_lo = ph; p.ph_hi = ph + 1;
    hipLaunchKernelGGL(fwd_megakernel, dim3(grid_blocks), dim3(256), 0, stream, p);
  }
#else
  p.ph_lo = 0; p.ph_hi = 21;
  void* args[] = {&p};
  hipError_t e = hipLaunchCooperativeKernel((void*)fwd_megakernel, dim3(grid_blocks), dim3(256), args, 0, stream);
  if (e != hipSuccess) fprintf(stderr, "cooperative launch failed: %s (grid %d)\n", hipGetErrorString(e), grid_blocks);
#endif
}
```
